# Optimizing an MI355X kernel written in HIP

```python
import math
import jax, jax.numpy as jnp
from jax import lax
import numpy as np


D_MODEL = 1024
BATCH = 2
SEQ = 16384
DEPTH = 4

HEAD_DIM = 64
N_RWKV_HEADS = 8
D_RWKV = N_RWKV_HEADS * HEAD_DIM
N_DIFF_HEADS = 4
D_DIFF = N_DIFF_HEADS * 2 * HEAD_DIM
DECAY_LORA = 64
AAA_LORA = 64
GATE_LORA = 128
RWKV_COLS = 3 * D_RWKV + DECAY_LORA + AAA_LORA + GATE_LORA
AB_COLS = RWKV_COLS + 3 * D_DIFF
RWKV_GN_EPS = 64e-5
ROPE_THETA = 500000.0
ROPE_DIM = HEAD_DIM // 4
Q_BLOCK = 128
CHUNK = 128
GMLP_GROUPS = 8
D_GMLP = D_MODEL
D_FF = 2816
CONV_W = 3
N_AB = (DEPTH + 1) // 2
N_C = DEPTH // 2
DEEPNORM_ALPHA = (2 * DEPTH) ** 0.25
DEEPNORM_BETA = (8 * DEPTH) ** -0.25

kernel_name = 'hybrid_rwkv7_diffattn_gmlp_convffn'


def layer_norm(x, g, b, eps=1e-5):
    xf = x.astype(jnp.float32)
    mu = jnp.mean(xf, axis=-1, keepdims=True)
    var = jnp.mean(jnp.square(xf - mu), axis=-1, keepdims=True)
    y = (xf - mu) * lax.rsqrt(var + eps)
    return (y * g.astype(jnp.float32) + b.astype(jnp.float32)).astype(x.dtype)


def rms_norm(x, g, eps=1e-5):
    xf = x.astype(jnp.float32)
    y = xf * lax.rsqrt(jnp.mean(jnp.square(xf), axis=-1, keepdims=True) + eps)
    return (y * g.astype(jnp.float32)).astype(x.dtype)


def shift_prev(t):
    return jnp.pad(t[:, :-1], ((0, 0), (1, 0), (0, 0)))


def rope_tables(seq):
    inv_freq = ROPE_THETA ** (-jnp.arange(0, ROPE_DIM, 2, dtype=jnp.float32) / ROPE_DIM)
    ang = jnp.arange(seq, dtype=jnp.float32)[:, None] * inv_freq[None, :]
    return jnp.cos(ang), jnp.sin(ang)


def apply_partial_rope(t, cos, sin):
    half = ROPE_DIM // 2
    c = cos[None, :, None, None, :].astype(t.dtype)
    s = sin[None, :, None, None, :].astype(t.dtype)
    t1, t2, rest = t[..., :half], t[..., half:ROPE_DIM], t[..., ROPE_DIM:]
    return jnp.concatenate([t1 * c - t2 * s, t1 * s + t2 * c, rest], axis=-1)


def wkv7_scan(r, decay, k, v, a_vec, b_vec):
    B, S, H, N = r.shape
    xs = tuple(jnp.moveaxis(t.astype(jnp.float32), 1, 0) for t in (r, decay, k, v, a_vec, b_vec))

    def step(state, inp):
        r_t, w_t, k_t, v_t, a_t, b_t = inp
        sa = jnp.einsum('bhvk,bhk->bhv', state, a_t)
        state = (state * w_t[:, :, None, :] + sa[..., None] * b_t[:, :, None, :]
                 + v_t[..., None] * k_t[:, :, None, :])
        y_t = jnp.einsum('bhvk,bhk->bhv', state, r_t)
        return state, y_t

    s0 = jnp.zeros((B, H, N, N), jnp.float32)
    _, y = lax.scan(step, s0, xs)
    return jnp.moveaxis(y, 0, 1)


def rwkv7_mix(pr, mu, w0, w2, a0, a2, g2, k_k, k_a, r_k, lnx_g, lnx_b):
    B, S, _ = pr.shape

    def heads(t):
        return t.reshape(B, S, N_RWKV_HEADS, HEAD_DIM)

    xs = pr + mu * (shift_prev(pr) - pr)
    r, k, v, xw, xa, xg = jnp.split(
        xs, [D_RWKV, 2 * D_RWKV, 3 * D_RWKV, 3 * D_RWKV + DECAY_LORA,
             3 * D_RWKV + DECAY_LORA + AAA_LORA], axis=-1)
    w = -jax.nn.softplus(-(w0 + jnp.tanh(xw) @ w2)) - 0.5
    decay = jnp.exp(-jnp.exp(w.astype(jnp.float32)))
    a = jax.nn.sigmoid(a0 + xa @ a2)
    g = jax.nn.sigmoid(xg) @ g2
    kk = heads(k * k_k).astype(jnp.float32)
    kk = kk / jnp.maximum(jnp.sqrt(jnp.sum(jnp.square(kk), axis=-1, keepdims=True)), 1e-12)
    k = k * (1.0 + (a - 1.0) * k_a)
    r_h, k_h, v_h, a_h = heads(r), heads(k), heads(v), heads(a)
    y = wkv7_scan(r_h, heads(decay), k_h, v_h, -kk, kk * a_h.astype(jnp.float32))
    mu_y = jnp.mean(y, axis=-1, keepdims=True)
    var_y = jnp.mean(jnp.square(y - mu_y), axis=-1, keepdims=True)
    yn = ((y - mu_y) * lax.rsqrt(var_y + RWKV_GN_EPS)).reshape(B, S, D_RWKV)
    yn = (yn * lnx_g.astype(jnp.float32) + lnx_b.astype(jnp.float32)).astype(pr.dtype)
    bonus = jnp.sum(r_h * k_h * r_k, axis=-1, keepdims=True) * v_h
    return (yn + bonus.reshape(B, S, D_RWKV)) * g


def diff_attention(pd, lam_q1, lam_k1, lam_q2, lam_k2, subln_g, lam_init, cos, sin):
    B, S, _ = pd.shape
    q, k, v = jnp.split(pd, 3, axis=-1)
    q = q.reshape(B, S, N_DIFF_HEADS, 2, HEAD_DIM)
    k = k.reshape(B, S, N_DIFF_HEADS, 2, HEAD_DIM)
    v = v.reshape(B, S, N_DIFF_HEADS, 2 * HEAD_DIM)
    q = apply_partial_rope(q, cos, sin) * (HEAD_DIM ** -0.5)
    k = apply_partial_rope(k, cos, sin)
    lam = (jnp.exp(jnp.sum(lam_q1.astype(jnp.float32) * lam_k1.astype(jnp.float32)))
           - jnp.exp(jnp.sum(lam_q2.astype(jnp.float32) * lam_k2.astype(jnp.float32)))
           + lam_init)
    n_blocks = S // Q_BLOCK
    qb = jnp.moveaxis(q.reshape(B, n_blocks, Q_BLOCK, N_DIFF_HEADS, 2, HEAD_DIM), 1, 0)
    k_pos = jnp.arange(S)

    def block(args):
        q_blk, i = args
        q_pos = i * Q_BLOCK + jnp.arange(Q_BLOCK)
        s = jnp.einsum('bqhcd,bkhcd->bhcqk', q_blk, k).astype(jnp.float32)
        mask = k_pos[None, :] <= q_pos[:, None]
        s = jnp.where(mask[None, None, None], s, -jnp.inf)
        p = jax.nn.softmax(s, axis=-1)
        attn = p[:, :, 0] - lam * p[:, :, 1]
        return jnp.einsum('bhqk,bkhd->bqhd', attn.astype(v.dtype), v)

    o = lax.map(block, (qb, jnp.arange(n_blocks)))
    o = jnp.moveaxis(o, 0, 1).reshape(B, S, N_DIFF_HEADS, 2 * HEAD_DIM)
    o = rms_norm(o, subln_g) * (1.0 - lam_init)
    return o.reshape(B, S, D_DIFF)


def chunked_spatial_gating(x, w_in, b_in, ln_g, ln_b, w_s, b_s):
    B, S, _ = x.shape
    h = jax.nn.gelu(x @ w_in + b_in, approximate=False)
    u, v = jnp.split(h, 2, axis=-1)
    v = layer_norm(v, ln_g, ln_b)
    vc = v.reshape(B, S // CHUNK, CHUNK, GMLP_GROUPS, D_GMLP // GMLP_GROUPS)
    ws = w_s * jnp.tril(jnp.ones((CHUNK, CHUNK), w_s.dtype))
    mixed = jnp.einsum('gts,bcsgd->bctgd', ws, vc) + b_s.T[None, None, :, :, None]
    return u * mixed.reshape(B, S, D_GMLP)


def conv_ffn(x, w_up, conv_w, conv_b, w_down):
    S = x.shape[1]
    gate, val = jnp.split(x @ w_up, 2, axis=-1)
    gp = jnp.pad(gate, ((0, 0), (CONV_W - 1, 0), (0, 0)))
    conv = conv_b
    for j in range(CONV_W):
        conv = conv + conv_w[j] * gp[:, j:j + S]
    return (jax.nn.silu(conv) * val) @ w_down


def setup_inputs(seed: int = 0) -> dict:
    key = jax.random.key(seed)
    keys = jax.random.split(key, 48)
    counter = [0]
    f32 = jnp.float32

    def nxt():
        kk = keys[counter[0]]
        counter[0] += 1
        return kk

    def nrm(shape, scale):
        return jax.random.normal(nxt(), shape, f32) * scale

    def unif(shape, lo, hi):
        return jax.random.uniform(nxt(), shape, f32, lo, hi)

    D = D_MODEL
    return {
        'x': nrm((BATCH, SEQ, D), 1.0),
        'ab_w_in': nrm((N_AB, D, AB_COLS), D ** -0.5),
        'ab_shift_mu': unif((N_AB, RWKV_COLS), 0.0, 1.0),
        'ab_w0': unif((N_AB, D_RWKV), -6.0, -1.0),
        'ab_w2': nrm((N_AB, DECAY_LORA, D_RWKV), 0.1),
        'ab_a0': nrm((N_AB, D_RWKV), 0.5),
        'ab_a2': nrm((N_AB, AAA_LORA, D_RWKV), AAA_LORA ** -0.5),
        'ab_g2': nrm((N_AB, GATE_LORA, D_RWKV), GATE_LORA ** -0.5),
        'ab_k_k': 0.85 + nrm((N_AB, D_RWKV), 0.05),
        'ab_k_a': 1.0 + nrm((N_AB, D_RWKV), 0.05),
        'ab_r_k': nrm((N_AB, N_RWKV_HEADS, HEAD_DIM), 0.1),
        'ab_lnx_g': 1.0 + nrm((N_AB, D_RWKV), 0.05),
        'ab_lnx_b': nrm((N_AB, D_RWKV), 0.01),
        'ab_lam_q1': nrm((N_AB, HEAD_DIM), 0.1),
        'ab_lam_k1': nrm((N_AB, HEAD_DIM), 0.1),
        'ab_lam_q2': nrm((N_AB, HEAD_DIM), 0.1),
        'ab_lam_k2': nrm((N_AB, HEAD_DIM), 0.1),
        'ab_subln_g': 1.0 + nrm((N_AB, 2 * HEAD_DIM), 0.05),
        'ab_w_out': nrm((N_AB, D_RWKV + D_DIFF, D), (D_RWKV + D_DIFF) ** -0.5 * DEEPNORM_BETA),
        'c_w_in': nrm((N_C, D, 2 * D_GMLP), D ** -0.5),
        'c_b_in': nrm((N_C, 2 * D_GMLP), 0.01),
        'c_ln_g': 1.0 + nrm((N_C, D_GMLP), 0.05),
        'c_ln_b': nrm((N_C, D_GMLP), 0.01),
        'c_w_s': nrm((N_C, GMLP_GROUPS, CHUNK, CHUNK), CHUNK ** -0.5),
        'c_b_s': 1.0 + nrm((N_C, GMLP_GROUPS, CHUNK), 0.05),
        'c_w_out': nrm((N_C, D_GMLP, D), D_GMLP ** -0.5 * DEEPNORM_BETA),
        'ln1_g': 1.0 + nrm((DEPTH, D), 0.05),
        'ln1_b': nrm((DEPTH, D), 0.01),
        'ffn_w_up': nrm((DEPTH, D, 2 * D_FF), D ** -0.5),
        'ffn_conv_w': nrm((DEPTH, CONV_W, D_FF), CONV_W ** -0.5),
        'ffn_conv_b': nrm((DEPTH, D_FF), 0.01),
        'ffn_w_down': nrm((DEPTH, D_FF, D), D_FF ** -0.5 * DEEPNORM_BETA),
        'ln2_g': 1.0 + nrm((DEPTH, D), 0.05),
        'ln2_b': nrm((DEPTH, D), 0.01),
    }


def reference(x, ab_w_in, ab_shift_mu, ab_w0, ab_w2, ab_a0, ab_a2, ab_g2, ab_k_k, ab_k_a,
              ab_r_k, ab_lnx_g, ab_lnx_b, ab_lam_q1, ab_lam_k1, ab_lam_q2, ab_lam_k2,
              ab_subln_g, ab_w_out, c_w_in, c_b_in, c_ln_g, c_ln_b, c_w_s, c_b_s, c_w_out,
              ln1_g, ln1_b, ffn_w_up, ffn_conv_w, ffn_conv_b, ffn_w_down, ln2_g, ln2_b):
    S = x.shape[1]
    cos, sin = rope_tables(S)
    for i in range(DEPTH):
        j = i // 2
        if i % 2 == 0:
            p = x @ ab_w_in[j]
            y_r = rwkv7_mix(p[..., :RWKV_COLS], ab_shift_mu[j], ab_w0[j], ab_w2[j], ab_a0[j],
                            ab_a2[j], ab_g2[j], ab_k_k[j], ab_k_a[j], ab_r_k[j],
                            ab_lnx_g[j], ab_lnx_b[j])
            lam_init = 0.8 - 0.6 * math.exp(-0.3 * i)
            y_d = diff_attention(p[..., RWKV_COLS:], ab_lam_q1[j], ab_lam_k1[j], ab_lam_q2[j],
                                 ab_lam_k2[j], ab_subln_g[j], lam_init, cos, sin)
            mix = jnp.concatenate([y_r, y_d], axis=-1) @ ab_w_out[j]
        else:
            mix = chunked_spatial_gating(x, c_w_in[j], c_b_in[j], c_ln_g[j], c_ln_b[j],
                                         c_w_s[j], c_b_s[j]) @ c_w_out[j]
        x = layer_norm(DEEPNORM_ALPHA * x + mix, ln1_g[i], ln1_b[i])
        ffn = conv_ffn(x, ffn_w_up[i], ffn_conv_w[i], ffn_conv_b[i], ffn_w_down[i])
        x = layer_norm(DEEPNORM_ALPHA * x + ffn, ln2_g[i], ln2_b[i])
    return x
```

```cpp
#include <hip/hip_runtime.h>
#include <hip/hip_cooperative_groups.h>
#include <cstdio>
#include <cstdint>
namespace cg = cooperative_groups;
namespace pg8 {
#define PG8_LAS __attribute__((address_space(3)))
typedef unsigned short bf16_t;
typedef short bf16x8 __attribute__((ext_vector_type(8)));
typedef float f32x4 __attribute__((ext_vector_type(4)));
typedef unsigned u32x4 __attribute__((ext_vector_type(4)));
constexpr int BM = 256, BK = 64, HALF = 128, HTB = HALF * BK * 2  , STAGE_BYTES = 8 * HTB, NXCD = 8, WGM = 8;

__host__ __device__ __forceinline__ int lds_byte(int r, int c) { const int st = (r >> 4) * 2 + (c >> 5), rr = r & 15, cc = c & 31, ob = rr * 64 + cc * 2; return st * 1024 + (ob ^ (((ob >> 9) & 1) << 5)); }
__host__ __device__ __forceinline__ void stage_rc(int b, int& R, int& C) { const int st = b / 1024, sb = b % 1024, swz = sb ^ (((sb >> 9) & 1) << 5); R = (st >> 1) * 16 + swz / 64; C = (st & 1) * 32 + (swz % 64) / 2; }
__host__ __device__ __forceinline__ int perm32(int rho) { const int n = rho >> 4, i = rho & 15; return 8 * (i >> 2) + 4 * n + (i & 3); }

struct Unit { int pm, pn; };
struct Gemm { const bf16_t* A; const bf16_t* Bt; int M, N, K; };

struct StaticOrder {
    int nM, nN, nwg, G, c;
    __host__ __device__ void init(int M, int N, int G_, int c_) { nM = M / BM; nN = N / BM; nwg = nM * nN; G = G_; c = c_; }
    __host__ __device__ bool next(int i, Unit& u) const {
        const long L = (long)i * G + c; if (L >= nwg) return false;
        int wgid = (int)L; { const int q = nwg / NXCD, r = nwg % NXCD, xcd = wgid % NXCD, off = wgid / NXCD; wgid = (xcd < r ? xcd * (q + 1) : r * (q + 1) + (xcd - r) * q) + off; }
        const int nig = WGM * nN, gid = wgid / nig, fm = gid * WGM, gsz = (nM - fm) < WGM ? (nM - fm) : WGM;
        u.pm = fm + ((wgid % nig) % gsz); u.pn = (wgid % nig) / gsz; return true;
    }
    __device__ __forceinline__ void a_ready(const Unit&) const {}
    __device__ __forceinline__ void done(const Unit&) const {}
};

__device__ __forceinline__ unsigned cvt_pk_bf16(float lo, float hi) { unsigned r; asm volatile("v_cvt_pk_bf16_f32 %0, %1, %2" : "=v"(r) : "v"(lo), "v"(hi)); return r; }
typedef float f32x2 __attribute__((ext_vector_type(2)));
__device__ __forceinline__ f32x2 gelu_pk(f32x2 v) {
    const f32x2 av = __builtin_elementwise_abs(v), d = av * 0.2316418882f + 1.0f;
    f32x2 t; t.x = __builtin_amdgcn_rcpf(d.x); t.y = __builtin_amdgcn_rcpf(d.y);
    f32x2 q = t * 0.5307027145f + (-0.7265760135f); q = q * t + 0.7107068705f; q = q * t + (-0.142248368f); q = q * t + 0.127414796f; q = q * t;
    const f32x2 s = (v * v) * (-0.72134752044f);
    f32x2 e; e.x = __builtin_amdgcn_exp2f(s.x); e.y = __builtin_amdgcn_exp2f(s.y);
    const f32x2 m = v * (q * e), r = v - m;
    f32x2 o; o.x = v.x < 0.f ? m.x : r.x; o.y = v.y < 0.f ? m.y : r.y; return o;
}

template <int ACT  > struct EpiBf16 {
    static constexpr bool PERM = true, AFTER_DRAIN = false; static_assert(ACT == 0 || ACT == 1, "EpiBf16: ACT is 0 (none) or 1 (gelu_pk)");
    bf16_t* O; int ldc; const float* bias; int split_cols; size_t split_stride; float scale0;
    __device__ __forceinline__ void operator()(const f32x4 (&acc)[2][2][4][2], const Unit& u, int wr, int wc, int fr, int fq) const {
        const int row0 = u.pm * BM + wr * 64 + fr; int colt = u.pn * BM; bf16_t* base = O;
        float sc = 1.f; if (split_cols) { const int t = colt / split_cols; base += (size_t)t * split_stride; colt -= t * split_cols; if (t == 0) sc = scale0; }
        const int col0 = colt + wc * 32 + 8 * fq, bcol0 = u.pn * BM + wc * 32 + 8 * fq;
        f32x4 bv[2][2];
#pragma unroll
        for (int bj = 0; bj < 2; ++bj)
#pragma unroll
            for (int n = 0; n < 2; ++n) bv[bj][n] = bias ? *(const f32x4*)(bias + bcol0 + bj * HALF + 4 * n) : (f32x4){0.f, 0.f, 0.f, 0.f};
#pragma unroll
        for (int ai = 0; ai < 2; ++ai)
#pragma unroll
            for (int m = 0; m < 4; ++m) { bf16_t* rowp = base + (size_t)(row0 + ai * HALF + m * 16) * ldc + col0;
#pragma unroll
                for (int bj = 0; bj < 2; ++bj) { f32x4 v0 = acc[ai][bj][m][0] + bv[bj][0], v1 = acc[ai][bj][m][1] + bv[bj][1];
                    if (ACT == 1) { f32x2 a = gelu_pk((f32x2){v0[0], v0[1]}), b = gelu_pk((f32x2){v0[2], v0[3]}), c = gelu_pk((f32x2){v1[0], v1[1]}), d = gelu_pk((f32x2){v1[2], v1[3]});
                        v0 = (f32x4){a.x, a.y, b.x, b.y}; v1 = (f32x4){c.x, c.y, d.x, d.y}; }
                    v0 = v0 * sc; v1 = v1 * sc; u32x4 w; w.x = cvt_pk_bf16(v0[0], v0[1]); w.y = cvt_pk_bf16(v0[2], v0[3]); w.z = cvt_pk_bf16(v1[0], v1[1]); w.w = cvt_pk_bf16(v1[2], v1[3]);
                    *(u32x4*)(rowp + bj * HALF) = w; } }
    }
};

struct PanelStats {
    unsigned* xbuf;
    unsigned* cnt;
    unsigned* tmo;
    int ntn; float eps;
    unsigned code;
    __device__ __forceinline__ bool run(const f32x4 (&v)[2][2][4][2], const Unit& u, int wr, int wc, int fr, int fq, PG8_LAS unsigned char* lds, int wid, int lane) const {
        typedef float f32x2v __attribute__((ext_vector_type(2)));
        PG8_LAS f32x2v* P = (PG8_LAS f32x2v*)lds;
        PG8_LAS f32x2v* S = (PG8_LAS f32x2v*)(lds + 8192);
        PG8_LAS unsigned* flag = (PG8_LAS unsigned*)(lds + 8192 + 2048);
#pragma unroll
        for (int ai = 0; ai < 2; ++ai)
#pragma unroll
            for (int m = 0; m < 4; ++m) {
                float s = 0.f;
#pragma unroll
                for (int bj = 0; bj < 2; ++bj)
#pragma unroll
                    for (int n = 0; n < 2; ++n) { const f32x4 x = v[ai][bj][m][n]; s += (x[0] + x[1]) + (x[2] + x[3]); }
                s += __shfl_xor(s, 16); s += __shfl_xor(s, 32);
                const float mw = s * (1.0f / 64.0f); float q = 0.f;
#pragma unroll
                for (int bj = 0; bj < 2; ++bj)
#pragma unroll
                    for (int n = 0; n < 2; ++n) { const f32x4 d = v[ai][bj][m][n] - mw; q += (d[0] * d[0] + d[1] * d[1]) + (d[2] * d[2] + d[3] * d[3]); }
                q += __shfl_xor(q, 16); q += __shfl_xor(q, 32);
                if (fq == 0) P[(ai * HALF + wr * 64 + m * 16 + fr) * 4 + wc] = (f32x2v){mw, q};
            }
        asm volatile("s_waitcnt lgkmcnt(0)" ::: "memory"); __builtin_amdgcn_s_barrier(); asm volatile("" ::: "memory");
#if defined(BROKEN_EXCHANGE_NO_WAIT)
#warning BROKEN CONTROL BUILD: the row-statistics exchange does not wait; results are wrong by design
        if (blockIdx.x >= 64) { const long long t0_ = clock64(); while (clock64() - t0_ < 60000) __builtin_amdgcn_s_sleep(8); }
#endif
        const int row = wid * 32 + (lane & 31);
        if (lane < 32) {
            const f32x2v a = P[row * 4 + 0], b = P[row * 4 + 1], c = P[row * 4 + 2], d = P[row * 4 + 3];
            const float mt = (a.x + b.x + c.x + d.x) * 0.25f;
            const float da = a.x - mt, db = b.x - mt, dc = c.x - mt, dd = d.x - mt;
            const float m2 = (a.y + b.y) + (c.y + d.y) + 64.0f * ((da * da + db * db) + (dc * dc + dd * dd));
            unsigned long long* slot = (unsigned long long*)xbuf + ((size_t)(u.pm * BM + row) * 4 + u.pn);
            __hip_atomic_store(slot, ((unsigned long long)__float_as_uint(m2) << 32) | __float_as_uint(mt), __ATOMIC_RELAXED, __HIP_MEMORY_SCOPE_AGENT);
        }
        asm volatile("s_waitcnt vmcnt(0)" ::: "memory");
        if (lane == 0) __hip_atomic_fetch_add(cnt + 64 * u.pm, 1u, __ATOMIC_RELAXED, __HIP_MEMORY_SCOPE_AGENT);
        if (wid == 0) {
            bool dead = false; const unsigned long long t0 = __builtin_amdgcn_s_memrealtime(); const unsigned want = 8u * (unsigned)ntn;
            for (;;) {
#if defined(BROKEN_EXCHANGE_NO_WAIT)
                break;
#endif
                if ((unsigned)__builtin_amdgcn_readfirstlane(__hip_atomic_load(cnt + 64 * u.pm, __ATOMIC_RELAXED, __HIP_MEMORY_SCOPE_AGENT)) >= want) break;
                if (__builtin_amdgcn_s_memrealtime() - t0 > 2000000ull) {
                    if (lane == 0) { unsigned expect = 0u; __hip_atomic_compare_exchange_strong(tmo + 1, &expect, code | (unsigned)(u.pm & 0xff), __ATOMIC_RELAXED, __ATOMIC_RELAXED, __HIP_MEMORY_SCOPE_AGENT);
                                     __hip_atomic_store(tmo, 1u, __ATOMIC_RELAXED, __HIP_MEMORY_SCOPE_AGENT); }
                    dead = true; break; }
                __builtin_amdgcn_s_sleep(2);
            }
            __builtin_amdgcn_fence(__ATOMIC_ACQUIRE, "agent");
            if (lane == 0) flag[0] = dead ? 1u : 0u;
        }
        asm volatile("s_waitcnt vmcnt(0) lgkmcnt(0)" ::: "memory"); __builtin_amdgcn_s_barrier(); asm volatile("" ::: "memory");
        const bool bad = flag[0] != 0u;
        if (lane < 32) {
            const unsigned long long* slot = (const unsigned long long*)xbuf + (size_t)(u.pm * BM + row) * 4; float mt[4], m2[4]; float ms = 0.f;
#pragma unroll
            for (int t = 0; t < 4; ++t) { if (t < ntn) { const unsigned long long w = __hip_atomic_load(slot + t, __ATOMIC_RELAXED, __HIP_MEMORY_SCOPE_AGENT); mt[t] = __uint_as_float((unsigned)w); m2[t] = __uint_as_float((unsigned)(w >> 32)); } else { mt[t] = 0.f; m2[t] = 0.f; } ms += mt[t]; }
            const float mean = ms / (float)ntn; float q = 0.f;
#pragma unroll
            for (int t = 0; t < 4; ++t) if (t < ntn) { const float dm = mt[t] - mean; q += m2[t] + 256.0f * dm * dm; }
            S[row] = (f32x2v){mean, 1.0f / sqrtf(q / (256.0f * (float)ntn) + eps)};
        }
        asm volatile("s_waitcnt lgkmcnt(0)" ::: "memory"); __builtin_amdgcn_s_barrier(); asm volatile("" ::: "memory");
        return bad;
    }
};
struct EpiLnRes {
    static constexpr bool PERM = false, AFTER_DRAIN = true;
    const float* base; float* out; int ldc; const float* bias; PanelStats st; unsigned poison;
    __device__ __forceinline__ void fused(f32x4 (&acc)[2][2][4][2], const Unit& u, int wr, int wc, int fr, int fq, PG8_LAS unsigned char* lds, int wid, int lane) const {
        typedef float f32x2v __attribute__((ext_vector_type(2)));
        const PG8_LAS f32x2v* S = (const PG8_LAS f32x2v*)(lds + 8192);
        const int col0 = u.pn * BM + wc * 32 + 4 * fq;
#pragma unroll
        for (int bj = 0; bj < 2; ++bj)
#pragma unroll
            for (int n = 0; n < 2; ++n) { const f32x4 bv = bias ? *(const f32x4*)(bias + col0 + bj * HALF + n * 16) : (f32x4){0.f, 0.f, 0.f, 0.f};
#pragma unroll
                for (int ai = 0; ai < 2; ++ai)
#pragma unroll
                    for (int m = 0; m < 4; ++m) acc[ai][bj][m][n] += bv; }
        f32x4 pre[4][2][2];
#pragma unroll
        for (int m = 0; m < 4; ++m) { const size_t off = (size_t)(u.pm * BM + wr * 64 + m * 16 + fr) * ldc + col0;
#pragma unroll
            for (int bj = 0; bj < 2; ++bj)
#pragma unroll
                for (int n = 0; n < 2; ++n) pre[m][bj][n] = *(const f32x4*)(base + off + bj * HALF + n * 16); }
        const bool bad = st.run(acc, u, wr, wc, fr, fq, lds, wid, lane) || poison != 0u;
        const float qnan = __builtin_nanf("");
#pragma unroll
        for (int ai = 0; ai < 2; ++ai)
#pragma unroll
            for (int m = 0; m < 4; ++m) { const int r = ai * HALF + wr * 64 + m * 16 + fr; const f32x2v sr = S[r]; const size_t off = (size_t)(u.pm * BM + r) * ldc + col0;
#pragma unroll
                for (int bj = 0; bj < 2; ++bj)
#pragma unroll
                    for (int n = 0; n < 2; ++n) { const f32x4 bs = ai == 0 ? pre[m][bj][n] : *(const f32x4*)(base + off + bj * HALF + n * 16); f32x4 o = bs + (acc[ai][bj][m][n] - sr.x) * sr.y;
                        if (bad) o = (f32x4){qnan, qnan, qnan, qnan}; *(f32x4*)(out + off + bj * HALF + n * 16) = o; }
                if (m & 1) asm volatile("" ::: "memory"); }
    }
};
struct EpiLnResLn {
    static constexpr bool PERM = false, AFTER_DRAIN = true;
    const float* base; float* out; bf16_t* xn; int ldc; const float* bias; PanelStats st1, st2; unsigned poison;
    __device__ __forceinline__ void fused(f32x4 (&acc)[2][2][4][2], const Unit& u, int wr, int wc, int fr, int fq, PG8_LAS unsigned char* lds, int wid, int lane) const {
        typedef float f32x2v __attribute__((ext_vector_type(2))); typedef unsigned u32x2v __attribute__((ext_vector_type(2)));
        const PG8_LAS f32x2v* S = (const PG8_LAS f32x2v*)(lds + 8192);
        const int col0 = u.pn * BM + wc * 32 + 4 * fq;
#pragma unroll
        for (int bj = 0; bj < 2; ++bj)
#pragma unroll
            for (int n = 0; n < 2; ++n) { const f32x4 bv = bias ? *(const f32x4*)(bias + col0 + bj * HALF + n * 16) : (f32x4){0.f, 0.f, 0.f, 0.f};
#pragma unroll
                for (int ai = 0; ai < 2; ++ai)
#pragma unroll
                    for (int m = 0; m < 4; ++m) acc[ai][bj][m][n] += bv; }
        bool bad = st1.run(acc, u, wr, wc, fr, fq, lds, wid, lane) || poison != 0u;
        const float qnan = __builtin_nanf("");
#pragma unroll
        for (int ai = 0; ai < 2; ++ai)
#pragma unroll
            for (int m = 0; m < 4; ++m) { const int r = ai * HALF + wr * 64 + m * 16 + fr; const f32x2v sr = S[r]; const size_t off = (size_t)(u.pm * BM + r) * ldc + col0;
#pragma unroll
                for (int bj = 0; bj < 2; ++bj)
#pragma unroll
                    for (int n = 0; n < 2; ++n) { const f32x4 bs = *(const f32x4*)(base + off + bj * HALF + n * 16); acc[ai][bj][m][n] = bs + (acc[ai][bj][m][n] - sr.x) * sr.y; }
                asm volatile("" : "+v"(acc[ai][0][m][0]), "+v"(acc[ai][0][m][1]), "+v"(acc[ai][1][m][0]), "+v"(acc[ai][1][m][1]));
                if (m & 1) asm volatile("" ::: "memory"); }
        const bool bad1 = bad;
        bad = st2.run(acc, u, wr, wc, fr, fq, lds, wid, lane) || bad;
#pragma unroll
        for (int ai = 0; ai < 2; ++ai)
#pragma unroll
            for (int m = 0; m < 4; ++m) { const int r = ai * HALF + wr * 64 + m * 16 + fr; const f32x2v sr = S[r]; const size_t off = (size_t)(u.pm * BM + r) * ldc + col0;
#pragma unroll
                for (int bj = 0; bj < 2; ++bj)
#pragma unroll
                    for (int n = 0; n < 2; ++n) { const f32x4 x1 = acc[ai][bj][m][n]; *(f32x4*)(out + off + bj * HALF + n * 16) = bad1 ? (f32x4){qnan, qnan, qnan, qnan} : x1;
                        const f32x4 o = (x1 - sr.x) * sr.y; u32x2v w; w.x = cvt_pk_bf16(o[0], o[1]); w.y = cvt_pk_bf16(o[2], o[3]);
                        if (bad) { w.x = 0x7fc07fc0u; w.y = 0x7fc07fc0u; } *(u32x2v*)(xn + off + bj * HALF + n * 16) = w; }
                asm volatile("" ::: "memory"); }
    }
};

template <class Epi, class Sched, bool ALIGN_EPI = false, bool SP2 = false>
__device__ __forceinline__ void gemm_phase(PG8_LAS unsigned char* lds, const Gemm g, const Sched& S, const Epi& E) {
    int tid_ = threadIdx.x; asm volatile("" : "+v"(tid_));
    const int tid = tid_, wid = __builtin_amdgcn_readfirstlane(tid >> 6), lane = tid & 63, wr = wid >> 2, wc = wid & 3, fr = lane & 15, fq = lane >> 4;
    const int K = g.K, nt = K / BK;
    unsigned voffA[2], voffB[2];
#pragma unroll
    for (int i = 0; i < 2; ++i) { int R, C; stage_rc(tid * 16 + i * 8192, R, C); const int Rb = Epi::PERM ? ((R & ~31) + perm32(R & 31)) : R;
        voffA[i] = (unsigned)(R * K + C) * 2u; voffB[i] = (unsigned)(Rb * K + C) * 2u; }
    const size_t kstep = (size_t)(BK * 2);
    const size_t hstep = (size_t)HALF * K * 2;
    const size_t tstep = 2 * hstep;
    const unsigned ldsw = (unsigned)wid * 1024u;
    const int aoff = lds_byte(wr * 64 + fr, fq * 8), boff = lds_byte(wc * 32 + fr, fq * 8);
#define PG8_SA(b, h) (((b) * 2 + (h)) * HTB)
#define PG8_SB(b, h) ((4 + (b) * 2 + (h)) * HTB)
#define PG8_STAGE(bufoff, gbase, voff) do { _Pragma("unroll") for (int _i = 0; _i < 2; ++_i) \
        __builtin_amdgcn_global_load_lds((const unsigned*)((const char*)(gbase) + (voff)[_i]), (PG8_LAS unsigned*)(lds + (bufoff) + ldsw + _i * 8192), 16, 0, 0); } while (0)
#define PG8_LDA(dst, b, h) do { _Pragma("unroll") for (int m = 0; m < 4; ++m) _Pragma("unroll") for (int k = 0; k < 2; ++k) dst[m][k] = *(const PG8_LAS bf16x8*)(lds + PG8_SA(b, h) + aoff + m * 2048 + k * 1024); } while (0)
#define PG8_LDB(dst, b, h) do { _Pragma("unroll") for (int n = 0; n < 2; ++n) _Pragma("unroll") for (int k = 0; k < 2; ++k) dst[n][k] = *(const PG8_LAS bf16x8*)(lds + PG8_SB(b, h) + boff + n * 2048 + k * 1024); } while (0)
#define PG8_MMA(ai, bj, At, Bt) do { __builtin_amdgcn_s_setprio(1); _Pragma("unroll") for (int m = 0; m < 4; ++m) _Pragma("unroll") for (int n = 0; n < 2; ++n) _Pragma("unroll") for (int k = 0; k < 2; ++k) \
        acc[ai][bj][m][n] = __builtin_amdgcn_mfma_f32_16x16x32_bf16(Bt[n][k], At[m][k], acc[ai][bj][m][n], 0, 0, 0); __builtin_amdgcn_s_setprio(0); } while (0)
#define PG8_WAIT_V(n) asm volatile("s_waitcnt vmcnt(" #n ")" ::: "memory")
#define PG8_WAIT_L(n) asm volatile("s_waitcnt lgkmcnt(" #n ")" ::: "memory")
#define PG8_BAR __builtin_amdgcn_s_barrier()
#define PG8_SCHED __builtin_amdgcn_sched_barrier(0)
    Unit cur, nxt; int ui = 0;
    if (!S.next(0, cur)) return;
    f32x4 acc[2][2][4][2];
#pragma unroll
    for (int a = 0; a < 2; ++a)
#pragma unroll
        for (int b = 0; b < 2; ++b)
#pragma unroll
            for (int m = 0; m < 4; ++m)
#pragma unroll
                for (int n = 0; n < 2; ++n) acc[a][b][m][n] = (f32x4){0.f, 0.f, 0.f, 0.f};
    bf16x8 At[4][2], B0[2][2], B1[2][2];
    const char* cA = (const char*)g.A + (size_t)cur.pm * tstep; const char* cB = (const char*)g.Bt + (size_t)cur.pn * tstep;
    S.a_ready(cur);
    if constexpr (SP2) {
        PG8_STAGE(PG8_SB(0, 0), cB, voffB); PG8_STAGE(PG8_SB(0, 1), cB + hstep, voffB); PG8_STAGE(PG8_SA(0, 0), cA, voffA); PG8_STAGE(PG8_SA(0, 1), cA + hstep, voffA);
        if (wr == 1) PG8_BAR;
        PG8_WAIT_V(2); PG8_BAR;
        PG8_STAGE(PG8_SB(1, 0), cB + kstep, voffB); PG8_STAGE(PG8_SA(1, 0), cA + kstep, voffA); PG8_STAGE(PG8_SB(1, 1), cB + hstep + kstep, voffB);
        PG8_WAIT_V(6); PG8_BAR;
    } else {
        PG8_STAGE(PG8_SB(0, 0), cB, voffB); PG8_STAGE(PG8_SA(0, 0), cA, voffA); PG8_STAGE(PG8_SB(0, 1), cB + hstep, voffB); PG8_STAGE(PG8_SA(0, 1), cA + hstep, voffA);
        if (wr == 1) PG8_BAR;
        PG8_WAIT_V(4); PG8_BAR;
        PG8_STAGE(PG8_SB(1, 0), cB + kstep, voffB); PG8_STAGE(PG8_SA(1, 0), cA + kstep, voffA); PG8_STAGE(PG8_SB(1, 1), cB + hstep + kstep, voffB);
        PG8_WAIT_V(6); PG8_BAR;
    }
    for (;;) {
        const bool has_next = S.next(ui + 1, nxt);
        const char* nA = has_next ? (const char*)g.A + (size_t)nxt.pm * tstep : cA; const char* nB = has_next ? (const char*)g.Bt + (size_t)nxt.pn * tstep : cB;
        for (int t = 0; t < nt; t += 2) {
            const bool last = (t == nt - 2);
            const char* a1 = cA + (size_t)(t + 1) * kstep;
            const char* a2 = last ? nA : cA + (size_t)(t + 2) * kstep; const char* b2 = last ? nB : cB + (size_t)(t + 2) * kstep;
            const char* a3 = a2 + kstep; const char* b3 = b2 + kstep;
            if (last && has_next) S.a_ready(nxt);
            if constexpr (SP2) {
            PG8_LDB(B0, 0, 0); PG8_LDB(B1, 0, 1); PG8_SCHED; PG8_LDA(At, 0, 0); PG8_STAGE(PG8_SA(1, 1), a1 + hstep, voffA);
            PG8_WAIT_V(8); PG8_WAIT_L(0); PG8_BAR; PG8_MMA(0, 0, At, B0); PG8_MMA(0, 1, At, B1); PG8_BAR; PG8_SCHED;
            PG8_LDA(At, 0, 1); PG8_STAGE(PG8_SB(0, 0), b2, voffB); PG8_STAGE(PG8_SB(0, 1), b2 + hstep, voffB); PG8_STAGE(PG8_SA(0, 0), a2, voffA);
            PG8_WAIT_V(8); PG8_WAIT_L(0); PG8_BAR; PG8_MMA(1, 0, At, B0); PG8_MMA(1, 1, At, B1); PG8_BAR; PG8_SCHED;
            PG8_LDB(B0, 1, 0); PG8_LDB(B1, 1, 1); PG8_SCHED; PG8_LDA(At, 1, 0); PG8_STAGE(PG8_SA(0, 1), a2 + hstep, voffA);
            PG8_WAIT_V(8); PG8_WAIT_L(0); PG8_BAR; PG8_MMA(0, 0, At, B0); PG8_MMA(0, 1, At, B1); PG8_BAR; PG8_SCHED;
            PG8_LDA(At, 1, 1); PG8_STAGE(PG8_SB(1, 0), b3, voffB); PG8_STAGE(PG8_SB(1, 1), b3 + hstep, voffB); PG8_STAGE(PG8_SA(1, 0), a3, voffA);
            PG8_WAIT_V(8); PG8_WAIT_L(0); PG8_BAR; PG8_MMA(1, 0, At, B0); PG8_MMA(1, 1, At, B1); PG8_BAR; PG8_SCHED;
            } else {
            PG8_LDB(B0, 0, 0); PG8_SCHED; PG8_LDA(At, 0, 0); PG8_STAGE(PG8_SA(1, 1), a1 + hstep, voffA);
            PG8_WAIT_L(8); PG8_BAR; PG8_WAIT_L(0); PG8_MMA(0, 0, At, B0); PG8_BAR; PG8_SCHED;
            PG8_LDB(B1, 0, 1); PG8_STAGE(PG8_SB(0, 0), b2, voffB);
            PG8_BAR; PG8_WAIT_L(0); PG8_MMA(0, 1, At, B1); PG8_BAR;
            PG8_LDA(At, 0, 1); PG8_STAGE(PG8_SA(0, 0), a2, voffA);
            PG8_BAR; PG8_WAIT_L(0); PG8_MMA(1, 0, At, B0); PG8_BAR; PG8_SCHED;
            PG8_STAGE(PG8_SB(0, 1), b2 + hstep, voffB);
            PG8_WAIT_V(6); PG8_BAR; PG8_MMA(1, 1, At, B1); PG8_BAR;
            PG8_LDB(B0, 1, 0); PG8_SCHED; PG8_LDA(At, 1, 0); PG8_STAGE(PG8_SA(0, 1), a2 + hstep, voffA);
            PG8_WAIT_L(8); PG8_BAR; PG8_WAIT_L(0); PG8_MMA(0, 0, At, B0); PG8_BAR; PG8_SCHED;
            PG8_LDB(B1, 1, 1); PG8_STAGE(PG8_SB(1, 0), b3, voffB);
            PG8_BAR; PG8_WAIT_L(0); PG8_MMA(0, 1, At, B1); PG8_BAR;
            PG8_LDA(At, 1, 1); PG8_STAGE(PG8_SA(1, 0), a3, voffA);
            PG8_BAR; PG8_WAIT_L(0); PG8_MMA(1, 0, At, B0); PG8_BAR; PG8_SCHED;
            PG8_STAGE(PG8_SB(1, 1), b3 + hstep, voffB);
            PG8_WAIT_V(6); PG8_BAR; PG8_MMA(1, 1, At, B1); PG8_BAR;
            }
        }
        if constexpr (ALIGN_EPI) { if (wr == 0) PG8_BAR; }
        if constexpr (!Epi::AFTER_DRAIN) { E(acc, cur, wr, wc, fr, fq); S.done(cur); }
        if (!has_next) break;
#pragma unroll
        for (int a = 0; a < 2; ++a)
#pragma unroll
            for (int b = 0; b < 2; ++b)
#pragma unroll
                for (int m = 0; m < 4; ++m)
#pragma unroll
                    for (int n = 0; n < 2; ++n) acc[a][b][m][n] = (f32x4){0.f, 0.f, 0.f, 0.f};
        cur = nxt; cA = nA; cB = nB; ++ui;
        if constexpr (ALIGN_EPI) { if (wr == 1) PG8_BAR; }
    }
    PG8_WAIT_V(0);
    if constexpr (!ALIGN_EPI) { if (wr == 0) PG8_BAR; }
    PG8_BAR;
    if constexpr (Epi::AFTER_DRAIN) { E.fused(acc, cur, wr, wc, fr, fq, lds, wid, lane); S.done(cur); }
#undef PG8_SA
#undef PG8_SB
#undef PG8_STAGE
#undef PG8_LDA
#undef PG8_LDB
#undef PG8_MMA
#undef PG8_WAIT_V
#undef PG8_WAIT_L
#undef PG8_BAR
#undef PG8_SCHED
}
}
namespace pg8 {
struct EpiResid {
    static constexpr bool PERM = false, AFTER_DRAIN = false;
    float* x; int ldc; float alpha;
    __device__ __forceinline__ void operator()(const f32x4 (&acc)[2][2][4][2], const Unit& u, int wr, int wc, int fr, int fq) const {
        const int col0 = u.pn * BM + wc * 32 + 4 * fq;
#pragma unroll
        for (int ai = 0; ai < 2; ++ai)
#pragma unroll
            for (int m = 0; m < 4; ++m) { const int r = ai * HALF + wr * 64 + m * 16 + fr; const size_t off = (size_t)(u.pm * BM + r) * ldc + col0;
#pragma unroll
                for (int bj = 0; bj < 2; ++bj)
#pragma unroll
                    for (int n = 0; n < 2; ++n) { float* p = x + off + bj * HALF + n * 16; f32x4 v = *(const f32x4*)p; v = v * alpha + acc[ai][bj][m][n]; *(f32x4*)p = v; }
                if (m & 1) asm volatile("" ::: "memory"); }
    }
};
}
#define PG8_SP2 true
#define PG8_ALIGN true
#include <hip/hip_bf16.h>
#include <cmath>
namespace attn_body {
using bf16=__hip_bfloat16;
using bf16x8=__attribute__((ext_vector_type(8)))short;
using s16x4=__attribute__((ext_vector_type(4)))short;
using f32x16=__attribute__((ext_vector_type(16)))float;
using u32x4=__attribute__((ext_vector_type(4)))unsigned;
constexpr int BATCH=2,NHEAD=16,SEQ=16384,D=64,DM=3328,DMO=1024;
constexpr int NW=8,QBLK=32,QB=QBLK*NW,KVBLK=64,NQB=SEQ/QB;
constexpr int ATTN_PITCH=DM, ATTN_UNIT_ROWS=QB;
__device__ __forceinline__ int crow(int r,int hi){return (r&3)+8*(r>>2)+4*hi;}
#define SBAR() __builtin_amdgcn_sched_barrier(0)
__device__ __forceinline__ void cmask(f32x16&p0,f32x16&p1,int jb,int qrel,int hi){
  const float NEG=-INFINITY; int kb=64*jb+4*hi;
  #pragma unroll
  for(int r=0;r<16;++r){int kv=kb+(r&3)+8*(r>>2); if(kv>qrel)p0[r]=NEG; if(kv+32>qrel)p1[r]=NEG;}
}

constexpr int NSLOT=3, SLOTB=8192;
constexpr int LDS_K=0, LDS_V=NSLOT*SLOTB, LDS_WS=2*NSLOT*SLOTB, LDS_OST=LDS_WS+NW*64*4, LDS_BYTES=LDS_OST+NW*4096;
constexpr float C2=0.125f*1.4426950408889634f;
__device__ __forceinline__ void glds16(const void*gsrc,unsigned lds_dst){unsigned keep;
  asm volatile("s_mov_b32 %0, m0\n\ts_mov_b32 m0, %2\n\ts_nop 0\n\tglobal_load_lds_dwordx4 %1, off\n\ts_mov_b32 m0, %0":"=&s"(keep):"v"(gsrc),"s"(lds_dst):"memory");}
__device__ __forceinline__ float max3f(float a,float b,float c){float r;asm("v_max3_f32 %0, %1, %2, %3":"=v"(r):"v"(a),"v"(b),"v"(c));return r;}
__device__ __forceinline__ float max2f(float a,float b){float r;asm("v_max_f32_e32 %0, %1, %2":"=v"(r):"v"(a),"v"(b));return r;}
__device__ __forceinline__ float fadd_s(float a,float b){float r;asm("v_add_f32_e32 %0, %1, %2":"=v"(r):"v"(a),"v"(b));return r;}
__device__ __forceinline__ float fsub_s(float a,float b){float r;asm("v_sub_f32_e32 %0, %1, %2":"=v"(r):"v"(a),"v"(b));return r;}
typedef float f32x2_t __attribute__((ext_vector_type(2))); typedef __bf16 bf16x2_t __attribute__((ext_vector_type(2)));
__device__ __forceinline__ unsigned cvtpk_s(float lo,float hi){f32x2_t v={lo,hi};bf16x2_t b=__builtin_convertvector(v,bf16x2_t);return __builtin_bit_cast(unsigned,b);}
#define WAIT_BAR(N) asm volatile("s_waitcnt vmcnt(" #N ") lgkmcnt(0)\n\ts_barrier":::"memory")

__device__ __forceinline__ void qkt(f32x16&p0,f32x16&p1,const char*Kslot,const bf16x8*qr,const f32x16&negm,int r32,int hi){
  const char*kb=Kslot+hi*1024+r32*16;
  #pragma unroll
  for(int d0=0;d0<4;++d0){
    const bf16x8 b0=*reinterpret_cast<const bf16x8*>(kb+d0*2048);
    const bf16x8 b1=*reinterpret_cast<const bf16x8*>(kb+d0*2048+512);
    if(d0==0){p0=__builtin_amdgcn_mfma_f32_32x32x16_bf16(b0,qr[0],negm,0,0,0);p1=__builtin_amdgcn_mfma_f32_32x32x16_bf16(b1,qr[0],negm,0,0,0);}
    else{p0=__builtin_amdgcn_mfma_f32_32x32x16_bf16(b0,qr[d0],p0,0,0,0);p1=__builtin_amdgcn_mfma_f32_32x32x16_bf16(b1,qr[d0],p1,0,0,0);}}
}
typedef __attribute__((address_space(3))) const char* lds_cptr;
typedef short v4i16_t __attribute__((ext_vector_type(4)));
__device__ __forceinline__ void kload8(bf16x8*kf,lds_cptr kp){
  kf[0]=*(const __attribute__((address_space(3))) bf16x8*)(kp);      kf[1]=*(const __attribute__((address_space(3))) bf16x8*)(kp+512);
  kf[2]=*(const __attribute__((address_space(3))) bf16x8*)(kp+2048); kf[3]=*(const __attribute__((address_space(3))) bf16x8*)(kp+2560);
  kf[4]=*(const __attribute__((address_space(3))) bf16x8*)(kp+4096); kf[5]=*(const __attribute__((address_space(3))) bf16x8*)(kp+4608);
  kf[6]=*(const __attribute__((address_space(3))) bf16x8*)(kp+6144); kf[7]=*(const __attribute__((address_space(3))) bf16x8*)(kp+6656);
}
__device__ __forceinline__ void kload2(bf16x8*kf,lds_cptr kp,int j){ kf[2*j]=*(const __attribute__((address_space(3))) bf16x8*)(kp+j*2048); kf[2*j+1]=*(const __attribute__((address_space(3))) bf16x8*)(kp+j*2048+512); }
__device__ __forceinline__ s16x4 vtr(lds_cptr p){ return __builtin_bit_cast(s16x4,__builtin_amdgcn_ds_read_tr16_b64_v4i16((__attribute__((address_space(3))) v4i16_t*)p)); }
__device__ __forceinline__ float rowmax(const f32x16&p0,const f32x16&p1){
  float a=max3f(p0[0],p0[1],p1[0]),b=max3f(p0[2],p0[3],p1[1]);a=max3f(a,p1[2],p1[3]);
  #pragma unroll
  for(int r=4;r<16;r+=4){a=max3f(a,p0[r],p0[r+1]);b=max3f(b,p0[r+2],p0[r+3]);a=max3f(a,p1[r],p1[r+1]);b=max3f(b,p1[r+2],p1[r+3]);}
  const float m=max2f(a,b);
  auto rr=__builtin_amdgcn_permlane32_swap(__float_as_uint(m),__float_as_uint(m),false,false);
  return max2f(__uint_as_float(rr[0]),__uint_as_float(rr[1]));
}
__device__ __forceinline__ void pv(f32x16*o,int vb,bf16x8 pa0,bf16x8 pa1,bf16x8 pa2,bf16x8 pa3){
  #pragma unroll
  for(int d0=0;d0<2;++d0){s16x4 lo[4],hi[4];
    #pragma unroll
    for(int ks=0;ks<4;++ks){
      asm volatile("ds_read_b64_tr_b16 %0,%1 offset:%c2":"=&v"(lo[ks]):"v"(vb),"i"(d0*4096+ks*1024):"memory");
      asm volatile("ds_read_b64_tr_b16 %0,%1 offset:%c2":"=&v"(hi[ks]):"v"(vb),"i"(d0*4096+ks*1024+512):"memory");}
    asm volatile("s_waitcnt lgkmcnt(0)":::"memory");SBAR();
    #define PK(k) (bf16x8){lo[k][0],lo[k][1],lo[k][2],lo[k][3],hi[k][0],hi[k][1],hi[k][2],hi[k][3]}
    o[d0]=__builtin_amdgcn_mfma_f32_32x32x16_bf16(pa0,PK(0),o[d0],0,0,0);
    o[d0]=__builtin_amdgcn_mfma_f32_32x32x16_bf16(pa1,PK(1),o[d0],0,0,0);
    o[d0]=__builtin_amdgcn_mfma_f32_32x32x16_bf16(pa2,PK(2),o[d0],0,0,0);
    o[d0]=__builtin_amdgcn_mfma_f32_32x32x16_bf16(pa3,PK(3),o[d0],0,0,0);
    #undef PK
  }
}

#ifndef ATTN_STORE16
#define ATTN_STORE16(p,v) (*(u32x4*)(p)=(v))
#endif
template<int THRL> __device__ __forceinline__ void attn_unit(int b,int h,int qb,const bf16*Q,const bf16*__restrict__ K,const bf16*__restrict__ V,bf16*O,char*shm){
  int tid_=threadIdx.x; asm volatile("":"+v"(tid_)); const int tid=tid_,lane=tid&63,r32=lane&31,hi=lane>>5; const int wid=__builtin_amdgcn_readfirstlane(tid>>6);
  const long rowbase=(long)b*SEQ; const int q0=qb*QB;
  const bf16*Qw=Q+(rowbase+q0+wid*QBLK)*DM+h*D;
  const bf16*Kh=K+rowbase*DM+h*D,*Vh=V+rowbase*DM+h*D;
  const unsigned lds0=(unsigned)(uintptr_t)shm;
  float*wsf=(float*)(shm+LDS_WS)+wid*64;
  const bf16*ksrc=Kh+(long)lane*DM+wid*8;
  const bf16*vsrc=Vh+(long)(16*(wid&3)+(lane>>2))*DM+(wid>>2)*32+(lane&3)*8;
  const unsigned kdst=lds0+LDS_K+wid*1024, vdst=lds0+LDS_V+wid*1024;
  #define DMA_K(t,slot) glds16(ksrc+(long)(t)*KVBLK*DM,(unsigned)__builtin_amdgcn_readfirstlane(kdst+(slot)))
  #define DMA_V(t,slot) glds16(vsrc+(long)(t)*KVBLK*DM,(unsigned)__builtin_amdgcn_readfirstlane(vdst+(slot)))
  const int vb0=(int)(lds0+LDS_V)+((lane>>4)&1)*32+(lane&3)*8+(4*hi+((lane&15)>>2))*64;
  const char*Kbase=shm+LDS_K; bf16x8 kf[8];
  const lds_cptr shm3=(lds_cptr)shm; const lds_cptr kp0=shm3+LDS_K+hi*1024+r32*16; const lds_cptr vp0=shm3+LDS_V+((lane>>4)&1)*32+(lane&3)*8+(4*hi+((lane&15)>>2))*64;
  const int NT=(q0+QB)/KVBLK;
  DMA_K(0,0);DMA_V(0,0);DMA_K(1,SLOTB);
  bf16x8 qr[4];
  #pragma unroll
  for(int d0=0;d0<4;++d0)qr[d0]=*reinterpret_cast<const bf16x8*>(&Qw[(long)r32*DM+d0*16+hi*8]);
  float mhat=0.f,l_reg=0.f;f32x16 o[2];o[0]=f32x16{};o[1]=f32x16{};f32x16 negm=f32x16{};asm volatile("":"+v"(negm));
  const int qrel=wid*QBLK+r32;
  #define CMASK(P0,P1,t) do{int jb_=(t)-(NT-4); if(jb_>=0)cmask(P0,P1,jb_,qrel,hi);}while(0)
  bool resc=false;
  #define START(P0,P1) do{ const float rm=rowmax(P0,P1); resc=false; \
    { const float dl=rm; mhat=fadd_s(mhat,dl); \
      _Pragma("unroll") for(int r=0;r<16;++r){P0[r]=fsub_s(P0[r],dl);P1[r]=fsub_s(P1[r],dl);} \
      _Pragma("unroll") for(int r=0;r<16;++r)negm[r]=-mhat; asm volatile("":"+v"(negm)); } \
    _Pragma("unroll") for(int r=0;r<16;++r)P0[r]=__builtin_amdgcn_exp2f(P0[r]); }while(0)
  #define RESC() do{ if(resc){ asm volatile("s_waitcnt lgkmcnt(0)":::"memory"); \
      _Pragma("unroll") for(int d_=0;d_<2;++d_) _Pragma("unroll") for(int r=0;r<16;++r)o[d_][r]*=wsf[crow(r,hi)]; } }while(0)
  f32x16 pA0,pA1,pB0,pB1;
  int sl_prev=0,sl_cur=0,sl_next=SLOTB;
  #define ROT() do{sl_prev=sl_cur;sl_cur=sl_next;sl_next=(sl_next==(NSLOT-1)*SLOTB)?0:sl_next+SLOTB;}while(0)
  DMA_K(2,2*SLOTB);
  WAIT_BAR(3);
  qkt(pA0,pA1,Kbase,qr,negm,r32,hi);asm volatile("s_nop 15\n\ts_nop 7":"+v"(pA0),"+v"(pA1));CMASK(pA0,pA1,0);
  START(pA0,pA1);
  _Pragma("unroll") for(int r=0;r<16;++r)pA1[r]=__builtin_amdgcn_exp2f(pA1[r]);
  WAIT_BAR(0);
  DMA_K(3,0);DMA_V(1,SLOTB);
  ROT();
  kload8(kf,kp0+sl_cur);
  WAIT_BAR(2);
  s16x4 vlo[8],vhi[8]; u32x4 pw0,pw1,pw2,pw3;
  #define PKW(P,B) cvtpk_s(P[B],P[B+1])
  #define PAF(k) __builtin_bit_cast(bf16x8,pw##k)
  #define VFR(i) (bf16x8){vlo[i][0],vlo[i][1],vlo[i][2],vlo[i][3],vhi[i][0],vhi[i][1],vhi[i][2],vhi[i][3]}
  #define PIN(x) asm volatile("":"+v"(x))
  #define MX3(a,b,c) __builtin_fmaxf(__builtin_fmaxf((a),(b)),(c))
  #define GAPA(MF,A0,A1,A2,A3,W0,W1,PW) do{ MF; sacc+=A0; sacc+=A1; sacc+=A2; sacc+=A3; PIN(sacc); W0; W1; PIN(PW); SBAR(); }while(0)
  #define EX(v) __builtin_amdgcn_exp2f(v)
  #define GAPB(MF,X,B) do{ MF; X[B]=EX(X[B]); X[B+1]=EX(X[B+1]); X[B+2]=EX(X[B+2]); X[B+3]=EX(X[B+3]); PIN(X); SBAR(); }while(0)
  #define VRD(i) do{ vlo[i]=vtr(vp_+(((i)>>2)*4096+((i)&3)*1024)); vhi[i]=vtr(vp_+(((i)>>2)*4096+((i)&3)*1024+512)); }while(0)
  #define KRD(G,j) do{ if(G){ kload2(kf,kp0+sl_next,j); SBAR(); } }while(0)
  #define STEP(C0,C1,P0,P1,t,GK,GV,GL) do{ SBAR(); \
    const lds_cptr vp_=vp0+sl_prev; \
    VRD(0); SBAR(); float sacc=(P0[0]+P0[1]); \
    GAPA(C0=__builtin_amdgcn_mfma_f32_32x32x16_bf16(kf[0],qr[0],negm,0,0,0), P0[2],P0[3],P0[4],P0[5],     pw0[0]=PKW(P0,0), pw0[1]=PKW(P0,2), pw0); \
    VRD(4); SBAR(); GAPA(C1=__builtin_amdgcn_mfma_f32_32x32x16_bf16(kf[1],qr[0],negm,0,0,0), P0[6],P0[7],P0[8],P0[9],     pw0[2]=PKW(P0,4), pw0[3]=PKW(P0,6), pw0); \
    VRD(1); SBAR(); GAPA(C0=__builtin_amdgcn_mfma_f32_32x32x16_bf16(kf[2],qr[1],C0,0,0,0),   P0[10],P0[11],P0[12],P0[13], pw1[0]=PKW(P0,8), pw1[1]=PKW(P0,10), pw1); \
    VRD(5); SBAR(); GAPA(C1=__builtin_amdgcn_mfma_f32_32x32x16_bf16(kf[3],qr[1],C1,0,0,0),   P0[14],P0[15],P1[0],P1[1],   pw1[2]=PKW(P0,12),pw1[3]=PKW(P0,14), pw1); \
    VRD(2); SBAR(); GAPA(C0=__builtin_amdgcn_mfma_f32_32x32x16_bf16(kf[4],qr[2],C0,0,0,0),   P1[2],P1[3],P1[4],P1[5],     pw2[0]=PKW(P1,0), pw2[1]=PKW(P1,2), pw2); \
    VRD(6); SBAR(); GAPA(C1=__builtin_amdgcn_mfma_f32_32x32x16_bf16(kf[5],qr[2],C1,0,0,0),   P1[6],P1[7],P1[8],P1[9],     pw2[2]=PKW(P1,4), pw2[3]=PKW(P1,6), pw2); \
    VRD(3); SBAR(); GAPA(C0=__builtin_amdgcn_mfma_f32_32x32x16_bf16(kf[6],qr[3],C0,0,0,0),   P1[10],P1[11],P1[12],P1[13], pw3[0]=PKW(P1,8), pw3[1]=PKW(P1,10), pw3); \
    VRD(7); SBAR(); GAPA(C1=__builtin_amdgcn_mfma_f32_32x32x16_bf16(kf[7],qr[3],C1,0,0,0),   P1[14],P1[15],0.f,0.f,       pw3[2]=PKW(P1,12),pw3[3]=PKW(P1,14), pw3); \
    l_reg+=sacc; \
    if(GK){DMA_K((t)+3,sl_cur);} if(GV){DMA_V((t)+1,sl_next);} \
    CMASK(C0,C1,t); \
    { float a=MX3(C0[0],C0[1],C1[0]),b=MX3(C0[2],C0[3],C1[1]); a=MX3(a,C1[2],C1[3]); \
      _Pragma("unroll") for(int r=4;r<16;r+=4){a=MX3(a,C0[r],C0[r+1]);b=MX3(b,C0[r+2],C0[r+3]);a=MX3(a,C1[r],C1[r+1]);b=MX3(b,C1[r+2],C1[r+3]);} \
      float rm=__builtin_fmaxf(a,b); { auto rr=__builtin_amdgcn_permlane32_swap(__float_as_uint(rm),__float_as_uint(rm),false,false); rm=__builtin_fmaxf(__uint_as_float(rr[0]),__uint_as_float(rr[1])); } \
      resc=false; \
      if(__builtin_expect(__any(rm>(float)THRL),0)){ const float dl=__builtin_fmaxf(rm,0.f); mhat+=dl; \
        _Pragma("unroll") for(int r=0;r<16;++r){C0[r]-=dl;C1[r]-=dl;} \
        _Pragma("unroll") for(int r=0;r<16;++r)negm[r]=-mhat; asm volatile("":"+v"(negm)); \
        const float f=__builtin_amdgcn_exp2f(-dl); l_reg*=f; if(hi==0)wsf[r32]=f; resc=true; } } \
    SBAR(); \
    GAPB(o[0]=__builtin_amdgcn_mfma_f32_32x32x16_bf16(PAF(0),VFR(0),o[0],0,0,0), C0,0); \
    GAPB(o[1]=__builtin_amdgcn_mfma_f32_32x32x16_bf16(PAF(0),VFR(4),o[1],0,0,0), C0,4); \
    KRD(GL,0); GAPB(o[0]=__builtin_amdgcn_mfma_f32_32x32x16_bf16(PAF(1),VFR(1),o[0],0,0,0), C0,8); \
    KRD(GL,1); GAPB(o[1]=__builtin_amdgcn_mfma_f32_32x32x16_bf16(PAF(1),VFR(5),o[1],0,0,0), C0,12); \
    KRD(GL,2); GAPB(o[0]=__builtin_amdgcn_mfma_f32_32x32x16_bf16(PAF(2),VFR(2),o[0],0,0,0), C1,0); \
    KRD(GL,3); GAPB(o[1]=__builtin_amdgcn_mfma_f32_32x32x16_bf16(PAF(2),VFR(6),o[1],0,0,0), C1,4); \
    GAPB(o[0]=__builtin_amdgcn_mfma_f32_32x32x16_bf16(PAF(3),VFR(3),o[0],0,0,0), C1,8); \
    GAPB(o[1]=__builtin_amdgcn_mfma_f32_32x32x16_bf16(PAF(3),VFR(7),o[1],0,0,0), C1,12); \
    }while(0)
  int t=1;
  #undef CMASK
  #define CMASK(P0,P1,t) do{}while(0)
  for(;t+5<NT;t+=2){
    STEP(pB0,pB1,pA0,pA1,t,true,true,true);     WAIT_BAR(2); RESC(); ROT();
    STEP(pA0,pA1,pB0,pB1,t+1,true,true,true);   WAIT_BAR(2); RESC(); ROT();
  }
  #undef CMASK
  #define CMASK(P0,P1,t) do{int jb_=(t)-(NT-4); if(jb_>=0)cmask(P0,P1,jb_,qrel,hi);}while(0)
  #define ENDW(tt) do{ if((tt)+3<NT){WAIT_BAR(2);} else if((tt)+2<NT){WAIT_BAR(1);} else {WAIT_BAR(0);} }while(0)
  for(;t+1<NT;t+=2){
    STEP(pB0,pB1,pA0,pA1,t,(t+3<NT),(t+1<NT),(t+1<NT));       ENDW(t);   RESC(); ROT();
    STEP(pA0,pA1,pB0,pB1,t+1,(t+4<NT),(t+2<NT),(t+2<NT));     ENDW(t+1); RESC(); ROT();
  }
  STEP(pB0,pB1,pA0,pA1,NT-1,false,false,false); RESC();
  { float sacc=pB0[0]+pB0[1]; _Pragma("unroll") for(int r=2;r<16;++r)sacc+=pB0[r]; _Pragma("unroll") for(int r=0;r<16;++r)sacc+=pB1[r]; l_reg+=sacc;
    pw0=(u32x4){PKW(pB0,0),PKW(pB0,2),PKW(pB0,4),PKW(pB0,6)};pw1=(u32x4){PKW(pB0,8),PKW(pB0,10),PKW(pB0,12),PKW(pB0,14)};pw2=(u32x4){PKW(pB1,0),PKW(pB1,2),PKW(pB1,4),PKW(pB1,6)};pw3=(u32x4){PKW(pB1,8),PKW(pB1,10),PKW(pB1,12),PKW(pB1,14)};
    SBAR(); pv(o,vb0+sl_cur,PAF(0),PAF(1),PAF(2),PAF(3)); }
  #undef PKW
  #undef PAF
  #undef VFR
  #undef PIN
  #undef MX3
  #undef GAPA
  #undef GAPB
  #undef EX
  #undef VRD
  #undef KRD
  #undef STEP
  #undef ENDW
  {auto rr=__builtin_amdgcn_permlane32_swap(__float_as_uint(l_reg),__float_as_uint(l_reg),false,false);l_reg=__uint_as_float(rr[0])+__uint_as_float(rr[1]);}
  if(hi==0)wsf[32+r32]=l_reg;asm volatile("s_waitcnt lgkmcnt(0)":::"memory");
  float rli[16];
  #pragma unroll
  for(int r=0;r<16;++r)rli[r]=__builtin_amdgcn_rcpf(wsf[32+crow(r,hi)]);
  bf16*Ow=O+(rowbase+q0+wid*QBLK)*DMO+h*D;
  { bf16*stg=(bf16*)(shm+LDS_OST)+wid*2048;
    #pragma unroll
    for(int r=0;r<16;++r){const int orow=crow(r,hi);
      #pragma unroll
      for(int d0=0;d0<2;++d0)stg[orow*64+d0*32+r32]=__float2bfloat16(o[d0][r]*rli[r]);}
    asm volatile("s_waitcnt lgkmcnt(0)":::"memory");
    #pragma unroll
    for(int i=0;i<4;++i){const int row=i*8+(lane>>3),ch=lane&7; const u32x4 v=*(const u32x4*)(stg+row*64+ch*8); ATTN_STORE16(Ow+(long)row*DMO+ch*8,v);} }
  asm volatile("s_waitcnt lgkmcnt(0)\n\ts_barrier":::"memory");
  #undef DMA_K
  #undef DMA_V
  #undef CMASK
  #undef START
  #undef RESC
  #undef ROT
}
constexpr int ATTN_LDS_BYTES=LDS_BYTES;
#undef SBAR
#undef WAIT_BAR
}
#define LAS __attribute__((address_space(3)))
typedef unsigned short bf16;
typedef unsigned v4u __attribute__((ext_vector_type(4)));
typedef unsigned v2u __attribute__((ext_vector_type(2)));
typedef float f32x4 __attribute__((ext_vector_type(4)));
typedef float f32x2 __attribute__((ext_vector_type(2)));
typedef short bf16x8 __attribute__((ext_vector_type(8)));

constexpr int NTOK = 32768, DMOD = 1024, SEQL = 16384, PW = 3328, DFF = 2816;
constexpr float ALPHA = 1.681792830507429f;
constexpr size_t MiB = 1u << 20;
constexpr size_t WS_WIN = 0, WS_WOUT = 7 * MiB, WS_WUP = 9 * MiB, WS_WDN = 20 * MiB, WS_WSP = 26 * MiB;
constexpr size_t WS_XN = 32 * MiB, WS_P = 96 * MiB, WS_GH = 304 * MiB, WS_CAT = 432 * MiB;
constexpr size_t WS_GATE = 96 * MiB, WS_VAL = 272 * MiB, WS_U = 96 * MiB, WS_V = 160 * MiB, WS_END = 496 * MiB;
constexpr int LDS_TOTAL = 147456;
constexpr int NTHR = 512;

__device__ __forceinline__ float bflo(unsigned w) { return __uint_as_float(w << 16); }
__device__ __forceinline__ float bfhi(unsigned w) { return __uint_as_float(w & 0xffff0000u); }
__device__ __forceinline__ unsigned f2bf(float f) { unsigned u = __float_as_uint(f); return (u + 0x7fffu + ((u >> 16) & 1u)) >> 16; }
__device__ __forceinline__ unsigned pk2(float lo, float hi) { return f2bf(lo) | (f2bf(hi) << 16); }
__device__ __forceinline__ void unpack8(const v4u w, float* o) { o[0] = bflo(w.x); o[1] = bfhi(w.x); o[2] = bflo(w.y); o[3] = bfhi(w.y); o[4] = bflo(w.z); o[5] = bfhi(w.z); o[6] = bflo(w.w); o[7] = bfhi(w.w); }
__device__ __forceinline__ v4u pack8(const float* o) { v4u w; w.x = pk2(o[0], o[1]); w.y = pk2(o[2], o[3]); w.z = pk2(o[4], o[5]); w.w = pk2(o[6], o[7]); return w; }
__device__ __forceinline__ float wave_sum(float v) {
#pragma unroll
    for (int o = 1; o < 64; o <<= 1) v += __shfl_xor(v, o);
    return v;
}
__device__ __forceinline__ int opaque_tid() { int t = threadIdx.x; asm volatile("" : "+v"(t)); return t; }
#define TIDS const int tid = opaque_tid(), lane = tid & 63, wave = __builtin_amdgcn_readfirstlane(tid >> 6); (void)lane; (void)wave
__device__ __forceinline__ float sigmoidf_(float x) { return 1.f / (1.f + __expf(-x)); }
__device__ __forceinline__ float tanhf_(float x) { const float e = __expf(2.f * x); return 1.f - 2.f / (e + 1.f); }

__device__ __forceinline__ void transpose_item(const float* W, int K, int N, bf16* WT, LAS float* scr, int item, int lane) {
    const int nblk = N / 32, kb = item / nblk, nb = item % nblk, k0 = 64 * kb, n0 = 32 * nb;
#pragma unroll 8
    for (int i = 0; i < 32; ++i) { const int kk = 2 * i + (lane >> 5); scr[kk * 33 + (lane & 31)] = W[(size_t)(k0 + kk) * N + n0 + (lane & 31)]; }
    asm volatile("s_waitcnt lgkmcnt(0)" ::: "memory");
    const int c = lane & 7;
#pragma unroll
    for (int j = 0; j < 4; ++j) { const int n = (lane >> 3) + 8 * j; const LAS float* s = scr + (8 * c) * 33 + n;
        v4u o; o.x = pk2(s[0 * 33], s[1 * 33]); o.y = pk2(s[2 * 33], s[3 * 33]); o.z = pk2(s[4 * 33], s[5 * 33]); o.w = pk2(s[6 * 33], s[7 * 33]);
        *(v4u*)(WT + (size_t)(n0 + n) * K + k0 + 8 * c) = o; }
    asm volatile("s_waitcnt lgkmcnt(0)" ::: "memory");
}

template <int KD, class FA, class FB>
__device__ __forceinline__ void mm_acc(f32x4& c0, f32x4& c1, int wave, int lane, FA fa, FB fb) {
    const int tm = wave >> 1, tn0 = (wave & 1) * 2, li = lane & 15, lk = lane >> 4;
#pragma unroll 4
    for (int k0 = 0; k0 < KD; k0 += 4) {
        const float a = fa(tm * 16 + li, k0 + lk);
        const float b0 = fb(k0 + lk, tn0 * 16 + li);
        const float b1 = fb(k0 + lk, tn0 * 16 + 16 + li);
        c0 = __builtin_amdgcn_mfma_f32_16x16x4f32(a, b0, c0, 0, 0, 0);
        c1 = __builtin_amdgcn_mfma_f32_16x16x4f32(a, b1, c1, 0, 0, 0);
    }
}
template <class FC>
__device__ __forceinline__ void mm_store(const f32x4& c0, const f32x4& c1, int wave, int lane, FC fc) {
    const int tm = wave >> 1, tn0 = (wave & 1) * 2, li = lane & 15, lk = lane >> 4;
#pragma unroll
    for (int r = 0; r < 4; ++r) { fc(tm * 16 + 4 * lk + r, tn0 * 16 + li, c0[r]); fc(tm * 16 + 4 * lk + r, tn0 * 16 + 16 + li, c1[r]); }
}
constexpr int LD = 68, BUFF = 64 * LD;
#define RM(B) [=](int i, int k) { return (B)[i * LD + k]; }
#define TR(B) [=](int i, int k) { return (B)[k * LD + i]; }

template <int ACT  >
__device__ __forceinline__ void load_shift(float* dst, const bf16* P, int tok0, int col0, const float* mu, bool seq_start, int tid) {
    const int row = tid >> 3, c8 = (tid & 7) * 8;
    const bf16* pr = P + (size_t)(tok0 + row) * PW + col0 + c8;
    const v4u cur = *(const v4u*)pr;
    v4u prv = (v4u){0u, 0u, 0u, 0u};
    if (!(seq_start && row == 0)) prv = *(const v4u*)(pr - PW);
    float c[8], p[8]; unpack8(cur, c); unpack8(prv, p);
    const f32x4 m0 = *(const f32x4*)(mu + col0 + c8), m1 = *(const f32x4*)(mu + col0 + c8 + 4);
    const float m[8] = {m0[0], m0[1], m0[2], m0[3], m1[0], m1[1], m1[2], m1[3]};
#pragma unroll
    for (int e = 0; e < 8; ++e) { float x = c[e] + m[e] * (p[e] - c[e]); if (ACT == 1) x = tanhf_(x); if (ACT == 2) x = sigmoidf_(x); dst[row * LD + c8 + e] = x; }
}
__device__ __forceinline__ void load_w64(float* dst, const float* W, int row0, int col0, int tid) {
    const int row = tid >> 3, c8 = (tid & 7) * 8;
    const float* s = W + (size_t)(row0 + row) * 512 + col0 + c8;
    const f32x4 a = *(const f32x4*)s, b = *(const f32x4*)(s + 4);
    *(f32x4*)(dst + row * LD + c8) = a; *(f32x4*)(dst + row * LD + c8 + 4) = b;
}
__device__ __forceinline__ void solve_col(float* X, const float* A) {
    for (int t = 1; t < 64; ++t) {
        float acc = X[t * LD];
        const float* ar = A + t * LD;
        int s = 0;
        for (; s + 4 <= t; s += 4) { const f32x4 av = *(const f32x4*)(ar + s); acc += av[0] * X[s * LD]; acc += av[1] * X[(s + 1) * LD]; acc += av[2] * X[(s + 2) * LD]; acc += av[3] * X[(s + 3) * LD]; }
        for (; s < t; ++s) acc += ar[s] * X[s * LD];
        X[t * LD] = acc;
    }
}

struct RwkvW { const float *mu, *w0, *w2, *a0, *a2, *g2, *kk, *ka, *rk, *lg, *lb; };

template <bool WITH_R>
__device__ __forceinline__ void rwkv_front(float* sm, const bf16* P, const RwkvW& w, int tok0, int h, bool ss, int tid, int wave, int lane) {
    float *B0 = sm, *B1 = sm + BUFF, *B2 = sm + 2 * BUFF, *B3 = sm + 3 * BUFF, *B4 = sm + 4 * BUFF, *B5 = sm + 5 * BUFF, *B6 = sm + 6 * BUFF, *B7 = sm + 7 * BUFF;
    float* part = sm + 8 * BUFF; float* bon = part + 512 + 64;
    load_shift<0>(B0, P, tok0, 512 + h * 64, w.mu, ss, tid);
    load_shift<0>(B1, P, tok0, 1024 + h * 64, w.mu, ss, tid);
    load_shift<1>(B2, P, tok0, 1536, w.mu, ss, tid);
    load_shift<0>(B3, P, tok0, 1600, w.mu, ss, tid);
    load_w64(B4, w.w2, 0, h * 64, tid);
    load_w64(B5, w.a2, 0, h * 64, tid);
    __syncthreads();
    { f32x4 c0 = {0.f, 0.f, 0.f, 0.f}, c1 = c0; mm_acc<64>(c0, c1, wave, lane, RM(B2), RM(B4));
      const float* w0 = w.w0 + h * 64;
      mm_store(c0, c1, wave, lane, [=](int r, int c, float v) { const float wi = v + w0[c]; const float z = -wi; const float sp = fmaxf(z, 0.f) + __logf(1.f + __expf(-fabsf(z))); B6[r * LD + c] = -__expf(-sp - 0.5f); }); }
    { f32x4 c0 = {0.f, 0.f, 0.f, 0.f}, c1 = c0; mm_acc<64>(c0, c1, wave, lane, RM(B3), RM(B5));
      const float* a0 = w.a0 + h * 64;
      mm_store(c0, c1, wave, lane, [=](int r, int c, float v) { B7[r * LD + c] = sigmoidf_(v + a0[c]); }); }
    __syncthreads();
    if (WITH_R) load_shift<0>(B4, P, tok0, h * 64, w.mu, ss, tid);
    {
        const int row = tid >> 3, c8 = (tid & 7) * 8;
        float kx[8], kkv[8]; float ssq = 0.f;
#pragma unroll
        for (int e = 0; e < 8; ++e) { kx[e] = B0[row * LD + c8 + e]; kkv[e] = kx[e] * w.kk[h * 64 + c8 + e]; ssq += kkv[e] * kkv[e]; }
        ssq += __shfl_xor(ssq, 1); ssq += __shfl_xor(ssq, 2); ssq += __shfl_xor(ssq, 4);
        const float inv = 1.f / fmaxf(sqrtf(ssq), 1e-12f);
        float bsum = 0.f;
#pragma unroll
        for (int e = 0; e < 8; ++e) { const float al = B7[row * LD + c8 + e]; const float kn = kkv[e] * inv; const float kad = kx[e] * (1.f + (al - 1.f) * w.ka[h * 64 + c8 + e]);
            B2[row * LD + c8 + e] = -kn; B3[row * LD + c8 + e] = kn * al; B0[row * LD + c8 + e] = kad;
            if (WITH_R) bsum += B4[row * LD + c8 + e] * kad * w.rk[h * 64 + c8 + e]; }
        if (WITH_R) { bsum += __shfl_xor(bsum, 1); bsum += __shfl_xor(bsum, 2); bsum += __shfl_xor(bsum, 4); if ((tid & 7) == 0) bon[row] = bsum; }
    }
    {
        const int ch = tid & 63, seg = tid >> 6; float s = 0.f;
#pragma unroll
        for (int i = 0; i < 8; ++i) s += B6[(seg * 8 + i) * LD + ch];
        part[seg * 64 + ch] = s;
    }
    __syncthreads();
    {   const int ch = tid & 63, seg = tid >> 6; float cex = 0.f;
        for (int s = 0; s < seg; ++s) cex += part[s * 64 + ch];
#pragma unroll
        for (int i = 0; i < 8; ++i) { const int t = seg * 8 + i; const float lw = B6[t * LD + ch]; B2[t * LD + ch] *= __expf(cex); cex += lw; B6[t * LD + ch] = cex; }
    }
    __syncthreads();
}

__device__ __forceinline__ void rwkv_phase1(float* sm, const bf16* P, const RwkvW& w, float* GH, int bx, int G) {
    TIDS;
    float *B0 = sm, *B1 = sm + BUFF, *B2 = sm + 2 * BUFF, *B3 = sm + 3 * BUFF, *B4 = sm + 4 * BUFF, *B5 = sm + 5 * BUFF, *B6 = sm + 6 * BUFF, *B7 = sm + 7 * BUFF;
    float* gl = sm + 8 * BUFF + 512;
    for (int unit = bx; unit < 4096; unit += G) {
        const int bh = unit >> 8, c = unit & 255, b = bh >> 3, h = bh & 7, tok0 = b * SEQL + c * 64;
        __syncthreads();
        rwkv_front<false>(sm, P, w, tok0, h, c == 0, tid, wave, lane);
        for (int idx = tid; idx < 4096; idx += NTHR) { const int t = idx >> 6, ch = idx & 63; const float cu = B6[t * LD + ch], cl = B6[63 * LD + ch];
            const float em = __expf(-cu), eh = __expf(cl - cu), bv = B3[t * LD + ch], kv = B0[t * LD + ch];
            B4[t * LD + ch] = bv * em; B5[t * LD + ch] = kv * em; B3[t * LD + ch] = bv * eh; B0[t * LD + ch] = kv * eh; }
        if (tid < 64) gl[tid] = __expf(B6[63 * LD + tid]);
        __syncthreads();
        { f32x4 c0 = {0.f, 0.f, 0.f, 0.f}, c1 = c0; mm_acc<64>(c0, c1, wave, lane, RM(B2), TR(B4)); mm_store(c0, c1, wave, lane, [=](int r, int cc, float v) { B7[r * LD + cc] = (cc < r) ? v : 0.f; }); }
        { f32x4 c0 = {0.f, 0.f, 0.f, 0.f}, c1 = c0; mm_acc<64>(c0, c1, wave, lane, RM(B2), TR(B5)); mm_store(c0, c1, wave, lane, [=](int r, int cc, float v) { B6[r * LD + cc] = (cc < r) ? v : 0.f; }); }
        __syncthreads();
        { f32x4 c0 = {0.f, 0.f, 0.f, 0.f}, c1 = c0; mm_acc<64>(c0, c1, wave, lane, RM(B6), RM(B1)); mm_store(c0, c1, wave, lane, [=](int r, int cc, float v) { B4[r * LD + cc] = v; }); }
        __syncthreads();
        if (tid < 128) solve_col(tid < 64 ? B2 + tid : B4 + (tid - 64), B7);
        __syncthreads();
        float* Gg = GH + (size_t)unit * 8192; float* Hg = Gg + 4096;
        { f32x4 c0 = {0.f, 0.f, 0.f, 0.f}, c1 = c0; mm_acc<64>(c0, c1, wave, lane, TR(B2), RM(B3)); mm_store(c0, c1, wave, lane, [=](int r, int cc, float v) { Gg[r * 64 + cc] = v + ((r == cc) ? gl[r] : 0.f); }); }
        { f32x4 c0 = {0.f, 0.f, 0.f, 0.f}, c1 = c0; mm_acc<64>(c0, c1, wave, lane, TR(B4), RM(B3)); mm_acc<64>(c0, c1, wave, lane, TR(B1), RM(B0)); mm_store(c0, c1, wave, lane, [=](int r, int cc, float v) { Hg[r * 64 + cc] = v; }); }
    }
}

__device__ __forceinline__ void rwkv_phase2(float* sm, float* GH, int wg) {
    TIDS;
    const int bh = wg >> 2, rb = wg & 3;
    float* Ss = sm; float* Gs = sm + 16 * LD; float* Hs = Gs + 64 * LD;
    for (int i = tid; i < 16 * LD; i += NTHR) Ss[i] = 0.f;
    float* base = GH + (size_t)(bh * 256) * 8192;
    const int grow = tid >> 3, gc8 = (tid & 7) * 8, hrow = tid >> 5, hc2 = (tid & 31) * 2;
    const size_t goff = (size_t)grow * 64 + gc8, hoff = 4096 + (size_t)(rb * 16 + hrow) * 64 + hc2;
    f32x4 ga[4], gb[4]; f32x2 hv[4];
#pragma unroll
    for (int i = 0; i < 4; ++i) { const float* u = base + (size_t)i * 8192; ga[i] = *(const f32x4*)(u + goff); gb[i] = *(const f32x4*)(u + goff + 4); hv[i] = *(const f32x2*)(u + hoff); }
    const int li = lane & 15, lk = lane >> 4;
    for (int c4 = 0; c4 < 256; c4 += 4) {
#pragma unroll
        for (int i = 0; i < 4; ++i) {
            const int c = c4 + i;
            *(f32x4*)(Gs + grow * LD + gc8) = ga[i]; *(f32x4*)(Gs + grow * LD + gc8 + 4) = gb[i]; *(f32x2*)(Hs + hrow * LD + hc2) = hv[i];
            __syncthreads();
            float* u = base + (size_t)c * 8192;
            if (c + 4 < 256) { const float* un = u + (size_t)4 * 8192; ga[i] = *(const f32x4*)(un + goff); gb[i] = *(const f32x4*)(un + goff + 4); hv[i] = *(const f32x2*)(un + hoff); }
            *(f32x2*)(u + hoff) = *(const f32x2*)(Ss + hrow * LD + hc2);
            f32x4 acc = {0.f, 0.f, 0.f, 0.f};
            if (wave < 4) {
#pragma unroll
                for (int r = 0; r < 4; ++r) acc[r] = Hs[(4 * lk + r) * LD + 16 * wave + li];
#pragma unroll 4
                for (int k0 = 0; k0 < 64; k0 += 4) acc = __builtin_amdgcn_mfma_f32_16x16x4f32(Ss[li * LD + k0 + lk], Gs[(k0 + lk) * LD + 16 * wave + li], acc, 0, 0, 0);
            }
            __syncthreads();
            if (wave < 4) {
#pragma unroll
                for (int r = 0; r < 4; ++r) Ss[(4 * lk + r) * LD + 16 * wave + li] = acc[r];
            }
        }
    }
    __syncthreads();
}

__device__ __forceinline__ void rwkv_phase3(float* sm, const bf16* P, const RwkvW& w, const float* GH, bf16* CAT, int bx, int G) {
    TIDS;
    float *B0 = sm, *B1 = sm + BUFF, *B2 = sm + 2 * BUFF, *B3 = sm + 3 * BUFF, *B4 = sm + 4 * BUFF, *B5 = sm + 5 * BUFF, *B6 = sm + 6 * BUFF, *B7 = sm + 7 * BUFF;
    float* bon = sm + 8 * BUFF + 512 + 64;
    for (int unit = bx; unit < 4096; unit += G) {
        const int bh = unit >> 8, c = unit & 255, b = bh >> 3, h = bh & 7, tok0 = b * SEQL + c * 64; const bool ss = (c == 0);
        __syncthreads();
        rwkv_front<true>(sm, P, w, tok0, h, ss, tid, wave, lane);
        for (int idx = tid; idx < 4096; idx += NTHR) { const int t = idx >> 6, ch = idx & 63; const float cu = B6[t * LD + ch]; const float em = __expf(-cu);
            B5[t * LD + ch] = B3[t * LD + ch] * em; B0[t * LD + ch] *= em; B4[t * LD + ch] *= __expf(cu); }
        __syncthreads();
        { f32x4 c0 = {0.f, 0.f, 0.f, 0.f}, c1 = c0; mm_acc<64>(c0, c1, wave, lane, RM(B2), TR(B5)); mm_store(c0, c1, wave, lane, [=](int r, int cc, float v) { B3[r * LD + cc] = (cc < r) ? v : 0.f; }); }
        { f32x4 c0 = {0.f, 0.f, 0.f, 0.f}, c1 = c0; mm_acc<64>(c0, c1, wave, lane, RM(B2), TR(B0)); mm_store(c0, c1, wave, lane, [=](int r, int cc, float v) { B6[r * LD + cc] = (cc < r) ? v : 0.f; }); }
        { f32x4 c0 = {0.f, 0.f, 0.f, 0.f}, c1 = c0; mm_acc<64>(c0, c1, wave, lane, RM(B4), TR(B5)); mm_store(c0, c1, wave, lane, [=](int r, int cc, float v) { B7[r * LD + cc] = (cc <= r) ? v : 0.f; }); }
        __syncthreads();
        { f32x4 c0 = {0.f, 0.f, 0.f, 0.f}, c1 = c0; mm_acc<64>(c0, c1, wave, lane, RM(B4), TR(B0)); __syncthreads(); mm_store(c0, c1, wave, lane, [=](int r, int cc, float v) { B5[r * LD + cc] = (cc <= r) ? v : 0.f; }); }
        __syncthreads();
        {   const int row = tid >> 3, c8 = (tid & 7) * 8; const float* s = GH + (size_t)unit * 8192 + 4096 + row * 64 + c8;
            *(f32x4*)(B0 + row * LD + c8) = *(const f32x4*)s; *(f32x4*)(B0 + row * LD + c8 + 4) = *(const f32x4*)(s + 4); }
        __syncthreads();
        { f32x4 c0 = {0.f, 0.f, 0.f, 0.f}, c1 = c0; mm_acc<64>(c0, c1, wave, lane, RM(B2), TR(B0)); mm_acc<64>(c0, c1, wave, lane, RM(B6), RM(B1)); __syncthreads();
          mm_store(c0, c1, wave, lane, [=](int r, int cc, float v) { B2[r * LD + cc] = v; }); }
        __syncthreads();
        if (tid < 64) solve_col(B2 + tid, B3);
        __syncthreads();
        { f32x4 c0 = {0.f, 0.f, 0.f, 0.f}, c1 = c0; mm_acc<64>(c0, c1, wave, lane, RM(B4), TR(B0)); mm_acc<64>(c0, c1, wave, lane, RM(B7), RM(B2)); mm_acc<64>(c0, c1, wave, lane, RM(B5), RM(B1));
          mm_store(c0, c1, wave, lane, [=](int r, int cc, float v) { B6[r * LD + cc] = v; }); }
        __syncthreads();
        load_shift<2>(B3, P, tok0, 1664, w.mu, ss, tid);
        load_shift<2>(B4, P, tok0, 1728, w.mu, ss, tid);
        load_w64(B5, w.g2, 0, h * 64, tid);
        load_w64(B7, w.g2, 64, h * 64, tid);
        __syncthreads();
        { f32x4 c0 = {0.f, 0.f, 0.f, 0.f}, c1 = c0; mm_acc<64>(c0, c1, wave, lane, RM(B3), RM(B5)); mm_acc<64>(c0, c1, wave, lane, RM(B4), RM(B7));
          mm_store(c0, c1, wave, lane, [=](int r, int cc, float v) { B0[r * LD + cc] = v; }); }
        __syncthreads();
        {   const int row = tid >> 3, c8 = (tid & 7) * 8; float y[8], s = 0.f;
#pragma unroll
            for (int e = 0; e < 8; ++e) { y[e] = B6[row * LD + c8 + e]; s += y[e]; }
            s += __shfl_xor(s, 1); s += __shfl_xor(s, 2); s += __shfl_xor(s, 4);
            const float mu = s * (1.f / 64.f); float q = 0.f;
#pragma unroll
            for (int e = 0; e < 8; ++e) { y[e] -= mu; q += y[e] * y[e]; }
            q += __shfl_xor(q, 1); q += __shfl_xor(q, 2); q += __shfl_xor(q, 4);
            const float rs = 1.f / sqrtf(q * (1.f / 64.f) + 64e-5f); const float bn = bon[row];
            float o[8];
#pragma unroll
            for (int e = 0; e < 8; ++e) { const int ch = h * 64 + c8 + e; const float yn = y[e] * rs * w.lg[ch] + w.lb[ch]; o[e] = (yn + bn * B1[row * LD + c8 + e]) * B0[row * LD + c8 + e]; }
            *(v4u*)(CAT + (size_t)(tok0 + row) * 1024 + h * 64 + c8) = pack8(o);
        }
    }
}

__device__ __forceinline__ void phase_rope(bf16* P, int bx, int G) {
    TIDS;
    constexpr float INVF[8] = {1.0f, 0.1939227432012558f, 0.03760603070259094f, 0.007292664609849453f, 0.0014142135623842478f, 0.00027424818836152554f, 5.318296098266728e-05f, 1.0313386155758053e-05f};
    for (int it = bx * NTHR + tid; it < NTOK * 16; it += G * NTHR) {
        const int tok = it >> 4, hh = it & 15, s = tok & (SEQL - 1);
        bf16* p = P + (size_t)tok * PW + 1792 + hh * 64;
        float x1[8], x2[8]; unpack8(*(const v4u*)p, x1); unpack8(*(const v4u*)(p + 8), x2);
        const float sc = (hh < 8) ? attn_body::C2 : 1.f;
        float o1[8], o2[8];
#pragma unroll
        for (int d = 0; d < 8; ++d) { const float ang = (float)s * INVF[d]; double rev = (double)ang * 0.15915494309189535; rev -= rint(rev); const float fr = (float)rev;
            const float sn = __builtin_amdgcn_sinf(fr), cs = __builtin_amdgcn_cosf(fr);
            o1[d] = (x1[d] * cs - x2[d] * sn) * sc; o2[d] = (x1[d] * sn + x2[d] * cs) * sc; }
        *(v4u*)p = pack8(o1); *(v4u*)(p + 8) = pack8(o2);
        if (hh < 8) {
#pragma unroll
            for (int q = 2; q < 8; ++q) { float x[8]; unpack8(*(const v4u*)(p + 8 * q), x);
#pragma unroll
                for (int e = 0; e < 8; ++e) x[e] *= sc;
                *(v4u*)(p + 8 * q) = pack8(x); }
        }
    }
}

__device__ __forceinline__ void phase_attn_post(const bf16* OB, bf16* CAT, const float* q1, const float* k1, const float* q2, const float* k2, const float* sg, float lam_init, int bx, int G) {
    TIDS; const int gw = bx * 8 + wave, NGW = G * 8;
    const float d1 = wave_sum(q1[lane] * k1[lane]), d2 = wave_sum(q2[lane] * k2[lane]);
    const float lam = expf(d1) - expf(d2) + lam_init;
    const int h = lane >> 4, d0 = (lane & 15) * 8, vhalf = d0 >> 6, dd = d0 & 63;
    float g[8];
#pragma unroll
    for (int e = 0; e < 8; ++e) g[e] = sg[d0 + e] * (1.f - lam_init);
    for (int tok = gw; tok < NTOK; tok += NGW) {
        const bf16* r = OB + (size_t)tok * 1024;
        float a[8], b[8]; unpack8(*(const v4u*)(r + ((h * 2 + 0) * 2 + vhalf) * 64 + dd), a); unpack8(*(const v4u*)(r + ((h * 2 + 1) * 2 + vhalf) * 64 + dd), b);
        float o[8], q = 0.f;
#pragma unroll
        for (int e = 0; e < 8; ++e) { o[e] = a[e] - lam * b[e]; q += o[e] * o[e]; }
        q += __shfl_xor(q, 1); q += __shfl_xor(q, 2); q += __shfl_xor(q, 4); q += __shfl_xor(q, 8);
        const float rs = 1.f / sqrtf(q * (1.f / 128.f) + 1e-5f);
#pragma unroll
        for (int e = 0; e < 8; ++e) o[e] = o[e] * rs * g[e];
        *(v4u*)(CAT + (size_t)tok * 1024 + 512 + h * 128 + d0) = pack8(o);
    }
}

__device__ __forceinline__ void phase_ln(float* X, bf16* XN, const float* g, const float* b, int bx, int G) {
    TIDS; const int gw = bx * 8 + wave, NGW = G * 8;
    for (int m = gw; m < NTOK; m += NGW) {
        f32x4* xr = (f32x4*)(X + (size_t)m * 1024) + lane;
        f32x4 v[4]; float s = 0.f;
#pragma unroll
        for (int j = 0; j < 4; ++j) { v[j] = xr[64 * j]; s += (v[j][0] + v[j][1]) + (v[j][2] + v[j][3]); }
        const float mean = wave_sum(s) * (1.f / 1024.f); float s2 = 0.f;
#pragma unroll
        for (int j = 0; j < 4; ++j) { v[j] = v[j] - mean; s2 += (v[j][0] * v[j][0] + v[j][1] * v[j][1]) + (v[j][2] * v[j][2] + v[j][3] * v[j][3]); }
        const float rstd = 1.f / sqrtf(wave_sum(s2) * (1.f / 1024.f) + 1e-5f);
        v2u* o8 = (v2u*)(XN + (size_t)m * 1024) + lane;
#pragma unroll
        for (int j = 0; j < 4; ++j) { const f32x4 gg = *(const f32x4*)(g + 4 * lane + 256 * j), bb = *(const f32x4*)(b + 4 * lane + 256 * j);
            const f32x4 o = v[j] * rstd * gg + bb; xr[64 * j] = o; v2u w; w.x = pk2(o[0], o[1]); w.y = pk2(o[2], o[3]); o8[64 * j] = w; }
    }
}
__device__ __forceinline__ void phase_lnv(bf16* V, const float* g, const float* b, int bx, int G) {
    TIDS; const int gw = bx * 8 + wave, NGW = G * 8;
    for (int m = gw; m < NTOK; m += NGW) {
        bf16* r = V + (size_t)m * 1024;
        float x[16]; unpack8(*(const v4u*)(r + lane * 8), x); unpack8(*(const v4u*)(r + 512 + lane * 8), x + 8);
        float s = 0.f;
#pragma unroll
        for (int e = 0; e < 16; ++e) s += x[e];
        const float mean = wave_sum(s) * (1.f / 1024.f); float s2 = 0.f;
#pragma unroll
        for (int e = 0; e < 16; ++e) { x[e] -= mean; s2 += x[e] * x[e]; }
        const float rstd = 1.f / sqrtf(wave_sum(s2) * (1.f / 1024.f) + 1e-5f);
#pragma unroll
        for (int e = 0; e < 16; ++e) { const int col = (e < 8) ? lane * 8 + e : 512 + lane * 8 + (e - 8); x[e] = x[e] * rstd * g[col] + b[col]; }
        *(v4u*)(r + lane * 8) = pack8(x); *(v4u*)(r + 512 + lane * 8) = pack8(x + 8);
    }
}

__device__ __forceinline__ void phase_conv(const bf16* GATE, bf16* VAL, const float* cw, const float* cb, int bx, int G) {
    TIDS;
    constexpr int NCG = DFF / 8, NIT = (NTOK / 16) * NCG;
    for (int it = bx * NTHR + tid; it < NIT; it += G * NTHR) {
        const int rb = it / NCG, c0 = (it % NCG) * 8, t0 = rb * 16;
        float w0[8], w1[8], w2[8], bb[8];
#pragma unroll
        for (int e = 0; e < 8; ++e) { w0[e] = cw[c0 + e]; w1[e] = cw[DFF + c0 + e]; w2[e] = cw[2 * DFF + c0 + e]; bb[e] = cb[c0 + e]; }
        float g1[8], g2[8];
        if ((t0 & (SEQL - 1)) == 0) {
#pragma unroll
            for (int e = 0; e < 8; ++e) { g1[e] = 0.f; g2[e] = 0.f; }
        } else { unpack8(*(const v4u*)(GATE + (size_t)(t0 - 1) * DFF + c0), g1); unpack8(*(const v4u*)(GATE + (size_t)(t0 - 2) * DFF + c0), g2); }
        for (int r = 0; r < 16; ++r) {
            const size_t off = (size_t)(t0 + r) * DFF + c0;
            float gg[8], vv[8], o[8]; unpack8(*(const v4u*)(GATE + off), gg); unpack8(*(const v4u*)(VAL + off), vv);
#pragma unroll
            for (int e = 0; e < 8; ++e) { const float cv = bb[e] + w0[e] * g2[e] + w1[e] * g1[e] + w2[e] * gg[e]; o[e] = cv * sigmoidf_(cv) * vv[e]; g2[e] = g1[e]; g1[e] = gg[e]; }
            *(v4u*)(VAL + off) = pack8(o);
        }
    }
}

__device__ __forceinline__ void phase_mix(unsigned char* ldsb, bf16* U, const bf16* V, const bf16* WSP, const float* bs, int bx, int G) {
    TIDS;
    bf16* Vt = (bf16*)ldsb;
    for (int unit = bx; unit < 2048; unit += G) {
        const int cidx = unit >> 3, g = unit & 7, tok0 = cidx * 128;
        __syncthreads();
        {   const int s = tid >> 2, q = tid & 3;
#pragma unroll
            for (int i = 0; i < 4; ++i) { const v4u w = *(const v4u*)(V + (size_t)(tok0 + s) * 1024 + g * 128 + q * 32 + i * 8); const int d0 = q * 32 + i * 8;
                Vt[(d0 + 0) * 136 + s] = (bf16)(w.x & 0xffffu); Vt[(d0 + 1) * 136 + s] = (bf16)(w.x >> 16); Vt[(d0 + 2) * 136 + s] = (bf16)(w.y & 0xffffu); Vt[(d0 + 3) * 136 + s] = (bf16)(w.y >> 16);
                Vt[(d0 + 4) * 136 + s] = (bf16)(w.z & 0xffffu); Vt[(d0 + 5) * 136 + s] = (bf16)(w.z >> 16); Vt[(d0 + 6) * 136 + s] = (bf16)(w.w & 0xffffu); Vt[(d0 + 7) * 136 + s] = (bf16)(w.w >> 16); }
        }
        __syncthreads();
        f32x4 acc[8];
#pragma unroll
        for (int tn = 0; tn < 8; ++tn) acc[tn] = (f32x4){0.f, 0.f, 0.f, 0.f};
        const int li = lane & 15, lk = lane >> 4, nks = (16 * wave + 15) / 32 + 1;
        for (int ks = 0; ks < nks; ++ks) {
            const bf16x8 a = *(const bf16x8*)(WSP + (size_t)g * 16384 + (16 * wave + li) * 128 + ks * 32 + lk * 8);
#pragma unroll
            for (int tn = 0; tn < 8; ++tn) { const bf16x8 bq = *(const bf16x8*)(Vt + (16 * tn + li) * 136 + ks * 32 + lk * 8); acc[tn] = __builtin_amdgcn_mfma_f32_16x16x32_bf16(a, bq, acc[tn], 0, 0, 0); }
        }
#pragma unroll
        for (int r = 0; r < 4; ++r) { const int t = 16 * wave + 4 * lk + r; const float bias = bs[g * 128 + t];
#pragma unroll
            for (int tn = 0; tn < 8; ++tn) { bf16* up = U + (size_t)(tok0 + t) * 1024 + g * 128 + 16 * tn + li; const float u = __uint_as_float(((unsigned)*up) << 16); *up = (bf16)f2bf(u * (acc[tn][r] + bias)); } }
    }
}

#ifndef PHASE_SEL
#define PHASE_SEL 0xffffffffu
#endif
#define ON(k) (((PHASE_SEL) >> (k)) & 1u)
struct Args { const float* in[34]; float* out; unsigned char* ws; };

__global__ void __launch_bounds__(NTHR, 2) mega_fwd(Args a) {
    extern __shared__ __attribute__((aligned(16))) unsigned char lds[];
    cg::grid_group grid = cg::this_grid();
    const int G = gridDim.x, bx = blockIdx.x;
    for (int layer = 0; layer < 4; ++layer) {
        const int j = layer >> 1; const bool even = (layer & 1) == 0;
        int z = 0; asm volatile("" : "+s"(z));
        unsigned char* ws = a.ws + z; float* out = a.out + z;
        bf16 *W_in = (bf16*)(ws + WS_WIN), *W_out = (bf16*)(ws + WS_WOUT), *W_up = (bf16*)(ws + WS_WUP), *W_dn = (bf16*)(ws + WS_WDN), *WSP = (bf16*)(ws + WS_WSP);
        bf16 *XN = (bf16*)(ws + WS_XN), *P = (bf16*)(ws + WS_P), *CAT = (bf16*)(ws + WS_CAT), *GATE = (bf16*)(ws + WS_GATE), *VAL = (bf16*)(ws + WS_VAL), *U = (bf16*)(ws + WS_U), *V = (bf16*)(ws + WS_V);
        float* GH = (float*)(ws + WS_GH);
        LAS unsigned char* ldsl = (LAS unsigned char*)lds;
        float* sm = (float*)lds;

        if (ON(0)) {
            TIDS; const int gw = bx * 8 + wave, NGW = G * 8;
            LAS float* scr = (LAS float*)(ldsl + wave * 16384);
            const float* wi = even ? a.in[1 + z] + (size_t)j * 1024 * 3328 : a.in[19 + z] + (size_t)j * 1024 * 2048;
            const int Nin = even ? 3328 : 2048;
            const float* wo = even ? a.in[18 + z] + (size_t)j * 1024 * 1024 : a.in[25 + z] + (size_t)j * 1024 * 1024;
            const float* wu = a.in[28 + z] + (size_t)layer * 1024 * 5632;
            const float* wd = a.in[31 + z] + (size_t)layer * 2816 * 1024;
            const int I_in = 16 * (Nin / 32), I_out = 16 * 32, I_up = 16 * 176, I_dn = 44 * 32, NIT = I_in + I_out + I_up + I_dn;
            for (int it = gw; it < NIT; it += NGW) {
                int r = it;
                if (r < I_in) { transpose_item(wi, 1024, Nin, W_in, scr, r, lane); continue; } r -= I_in;
                if (r < I_out) { transpose_item(wo, 1024, 1024, W_out, scr, r, lane); continue; } r -= I_out;
                if (r < I_up) { transpose_item(wu, 1024, 5632, W_up, scr, r, lane); continue; } r -= I_up;
                transpose_item(wd, 2816, 1024, W_dn, scr, r, lane);
            }
            if (!even) { const float* wsrc = a.in[23 + z] + (size_t)j * 8 * 128 * 128;
                for (int i = bx * NTHR + tid; i < 8 * 128 * 128; i += G * NTHR) { const int t = (i >> 7) & 127, s = i & 127; WSP[i] = (bf16)f2bf(s <= t ? wsrc[i] : 0.f); } }
            if (layer == 0) { const f32x4* xs = (const f32x4*)a.in[0 + z]; f32x4* xo = (f32x4*)out; v2u* xn = (v2u*)XN;
                for (int i = bx * NTHR + tid; i < NTOK * 1024 / 4; i += G * NTHR) { const f32x4 v = xs[i]; xo[i] = v; v2u w; w.x = pk2(v[0], v[1]); w.y = pk2(v[2], v[3]); xn[i] = w; } }
        }
        grid.sync();
        if (even) {
            RwkvW rw{a.in[2 + z] + j * 1792, a.in[3 + z] + j * 512, a.in[4 + z] + (size_t)j * 64 * 512, a.in[5 + z] + j * 512, a.in[6 + z] + (size_t)j * 64 * 512, a.in[7 + z] + (size_t)j * 128 * 512,
                     a.in[8 + z] + j * 512, a.in[9 + z] + j * 512, a.in[10 + z] + j * 512, a.in[11 + z] + j * 512, a.in[12 + z] + j * 512};
            if (ON(1)) {   pg8::Gemm g{XN, W_in, NTOK, 3328, 1024}; pg8::StaticOrder S; S.init(NTOK, 3328, G, bx);
                pg8::EpiBf16<0> E{P, 3328, nullptr, 0, 0, 1.f};
                pg8::gemm_phase<pg8::EpiBf16<0>, pg8::StaticOrder, PG8_ALIGN, PG8_SP2>(ldsl, g, S, E); }
            grid.sync();
            if (ON(2)) rwkv_phase1(sm, P, rw, GH, bx, G);
            if (ON(3)) phase_rope(P, bx, G);
            grid.sync();
            if (ON(4)) if (bx < 64) rwkv_phase2(sm, GH, bx);
            grid.sync();
            if (ON(5)) {
                __syncthreads();
                const int nun = (G == 256) ? 8 : (2048 - bx + G - 1) / G;
                for (int i = 0; i < nun; ++i) {
                    int bhv, qb;
                    if (G == 256) { const int vcu = (bx % 8) * (G / 8) + bx / 8, s = vcu & 7, grp = i >> 1; bhv = vcu >> 3; qb = (i & 1) ? (16 * grp + 15 - s) : (16 * grp + s); }
                    else { const int u = bx + i * G; bhv = u & 31; qb = 63 - (u >> 5); }
                    const int b = bhv >> 4, vh = bhv & 15, hd = vh >> 2, cm = (vh >> 1) & 1, vhalf = vh & 1;
                    const attn_body::bf16* Q = (const attn_body::bf16*)(P + 1792 + (hd * 2 + cm) * 64); const attn_body::bf16* K = (const attn_body::bf16*)(P + 2304 + (hd * 2 + cm) * 64);
                    const attn_body::bf16* Vv = (const attn_body::bf16*)(P + 2816 + hd * 128 + vhalf * 64); attn_body::bf16* O = (attn_body::bf16*)(XN + vh * 64);
                    attn_body::attn_unit<8>(b, 0, qb, Q, K, Vv, O, (char*)lds);
                }
            }
            grid.sync();
            if (ON(6)) rwkv_phase3(sm, P, rw, GH, CAT, bx, G);
            if (ON(7)) phase_attn_post(XN, CAT, a.in[13 + z] + j * 64, a.in[14 + z] + j * 64, a.in[15 + z] + j * 64, a.in[16 + z] + j * 64, a.in[17 + z] + j * 128, layer == 0 ? 0.2f : 0.4707130183435842f, bx, G);
            grid.sync();
            if (ON(8)) {   pg8::Gemm g{CAT, W_out, NTOK, 1024, 1024}; pg8::StaticOrder S; S.init(NTOK, 1024, G, bx);
                pg8::EpiResid E{out, 1024, ALPHA};
                pg8::gemm_phase<pg8::EpiResid, pg8::StaticOrder, PG8_ALIGN, PG8_SP2>(ldsl, g, S, E); }
        } else {
            if (ON(9)) {   pg8::Gemm g{XN, W_in, NTOK, 2048, 1024}; pg8::StaticOrder S; S.init(NTOK, 2048, G, bx);
                pg8::EpiBf16<1> E{U, 1024, a.in[20 + z] + j * 2048, 1024, (size_t)(WS_V - WS_U) / 2, 1.f};
                pg8::gemm_phase<pg8::EpiBf16<1>, pg8::StaticOrder, PG8_ALIGN, PG8_SP2>(ldsl, g, S, E); }
            grid.sync();
            if (ON(10)) phase_lnv(V, a.in[21 + z] + j * 1024, a.in[22 + z] + j * 1024, bx, G);
            grid.sync();
            if (ON(11)) phase_mix(lds, U, V, WSP, a.in[24 + z] + j * 1024, bx, G);
            grid.sync();
            if (ON(12)) {   pg8::Gemm g{U, W_out, NTOK, 1024, 1024}; pg8::StaticOrder S; S.init(NTOK, 1024, G, bx);
                pg8::EpiResid E{out, 1024, ALPHA};
                pg8::gemm_phase<pg8::EpiResid, pg8::StaticOrder, PG8_ALIGN, PG8_SP2>(ldsl, g, S, E); }
        }
        grid.sync();
        if (ON(13)) phase_ln(out, XN, a.in[26 + z] + layer * 1024, a.in[27 + z] + layer * 1024, bx, G);
        grid.sync();
        if (ON(14)) {   pg8::Gemm g{XN, W_up, NTOK, 5632, 1024}; pg8::StaticOrder S; S.init(NTOK, 5632, G, bx);
            pg8::EpiBf16<0> E{GATE, 2816, nullptr, 2816, (size_t)(WS_VAL - WS_GATE) / 2, 1.f};
            pg8::gemm_phase<pg8::EpiBf16<0>, pg8::StaticOrder, PG8_ALIGN, PG8_SP2>(ldsl, g, S, E); }
        grid.sync();
        if (ON(15)) phase_conv(GATE, VAL, a.in[29 + z] + (size_t)layer * 3 * DFF, a.in[30 + z] + layer * DFF, bx, G);
        grid.sync();
        if (ON(16)) {   pg8::Gemm g{VAL, W_dn, NTOK, 1024, 2816}; pg8::StaticOrder S; S.init(NTOK, 1024, G, bx);
            pg8::EpiResid E{out, 1024, ALPHA};
            pg8::gemm_phase<pg8::EpiResid, pg8::StaticOrder, PG8_ALIGN, PG8_SP2>(ldsl, g, S, E); }
        grid.sync();
        if (ON(17)) phase_ln(out, XN, a.in[32 + z] + layer * 1024, a.in[33 + z] + layer * 1024, bx, G);
        grid.sync();
    }
}

extern "C" void kernel_launch(void* const* d_in, const int* in_sizes, int n_in, void* d_out, int out_size, void* d_ws, size_t ws_size, hipStream_t stream) {
    static int grid = 0;
    if (grid == 0) {
        if (n_in != 34 || out_size != NTOK * 1024 || ws_size < WS_END) { fprintf(stderr, "kernel_launch: unexpected shapes (n_in %d out %d ws %zu)\n", n_in, out_size, ws_size); grid = -1; return; }
        int dev = 0, cus = 0, per_cu = 0;
        hipGetDevice(&dev); hipDeviceGetAttribute(&cus, hipDeviceAttributeMultiprocessorCount, dev);
        if (hipFuncSetAttribute((const void*)mega_fwd, hipFuncAttributeMaxDynamicSharedMemorySize, LDS_TOTAL) != hipSuccess) { fprintf(stderr, "kernel_launch: hipFuncSetAttribute failed\n"); grid = -1; return; }
        if (hipOccupancyMaxActiveBlocksPerMultiprocessor(&per_cu, (const void*)mega_fwd, NTHR, LDS_TOTAL) != hipSuccess || per_cu < 1) per_cu = 1;
        (void)hipGetLastError();
        grid = cus * per_cu;
        fprintf(stderr, "kernel_launch: grid %d (cus %d x %d)\n", grid, cus, per_cu);
    }
    if (grid < 0) return;
    Args a{};
    for (int i = 0; i < 34; ++i) a.in[i] = (const float*)d_in[i];
    a.out = (float*)d_out; a.ws = (unsigned char*)d_ws;
    void* args[] = {&a};
    hipError_t e = hipLaunchCooperativeKernel((const void*)mega_fwd, dim3(grid), dim3(NTHR), args, LDS_TOTAL, stream);
    if (e != hipSuccess) fprintf(stderr, "kernel_launch: cooperative launch failed: %s (grid %d)\n", hipGetErrorString(e), grid);
}
```

```cpp
#include <hip/hip_runtime.h>
#include <hip/hip_cooperative_groups.h>
#include <cstdio>
#include <cstdint>
namespace cg = cooperative_groups;
namespace pg8 {
#define PG8_LAS __attribute__((address_space(3)))
typedef unsigned short bf16_t;
typedef short bf16x8 __attribute__((ext_vector_type(8)));
typedef float f32x4 __attribute__((ext_vector_type(4)));
typedef unsigned u32x4 __attribute__((ext_vector_type(4)));
constexpr int BM = 256, BK = 64, HALF = 128, HTB = HALF * BK * 2  , STAGE_BYTES = 8 * HTB, NXCD = 8, WGM = 8;

__host__ __device__ __forceinline__ int lds_byte(int r, int c) { const int st = (r >> 4) * 2 + (c >> 5), rr = r & 15, cc = c & 31, ob = rr * 64 + cc * 2; return st * 1024 + (ob ^ (((ob >> 9) & 1) << 5)); }
__host__ __device__ __forceinline__ void stage_rc(int b, int& R, int& C) { const int st = b / 1024, sb = b % 1024, swz = sb ^ (((sb >> 9) & 1) << 5); R = (st >> 1) * 16 + swz / 64; C = (st & 1) * 32 + (swz % 64) / 2; }
__host__ __device__ __forceinline__ int perm32(int rho) { const int n = rho >> 4, i = rho & 15; return 8 * (i >> 2) + 4 * n + (i & 3); }

struct Unit { int pm, pn; };
struct Gemm { const bf16_t* A; const bf16_t* Bt; int M, N, K; };

struct StaticOrder {
    int nM, nN, nwg, G, c;
    __host__ __device__ void init(int M, int N, int G_, int c_) { nM = M / BM; nN = N / BM; nwg = nM * nN; G = G_; c = c_; }
    __host__ __device__ bool next(int i, Unit& u) const {
        const long L = (long)i * G + c; if (L >= nwg) return false;
        int wgid = (int)L; { const int q = nwg / NXCD, r = nwg % NXCD, xcd = wgid % NXCD, off = wgid / NXCD; wgid = (xcd < r ? xcd * (q + 1) : r * (q + 1) + (xcd - r) * q) + off; }
        const int nig = WGM * nN, gid = wgid / nig, fm = gid * WGM, gsz = (nM - fm) < WGM ? (nM - fm) : WGM;
        u.pm = fm + ((wgid % nig) % gsz); u.pn = (wgid % nig) / gsz; return true;
    }
    __device__ __forceinline__ void a_ready(const Unit&) const {}
    __device__ __forceinline__ void done(const Unit&) const {}
};

__device__ __forceinline__ unsigned cvt_pk_bf16(float lo, float hi) { unsigned r; asm volatile("v_cvt_pk_bf16_f32 %0, %1, %2" : "=v"(r) : "v"(lo), "v"(hi)); return r; }
typedef float f32x2 __attribute__((ext_vector_type(2)));
__device__ __forceinline__ f32x2 gelu_pk(f32x2 v) {
    const f32x2 av = __builtin_elementwise_abs(v), d = av * 0.2316418882f + 1.0f;
    f32x2 t; t.x = __builtin_amdgcn_rcpf(d.x); t.y = __builtin_amdgcn_rcpf(d.y);
    f32x2 q = t * 0.5307027145f + (-0.7265760135f); q = q * t + 0.7107068705f; q = q * t + (-0.142248368f); q = q * t + 0.127414796f; q = q * t;
    const f32x2 s = (v * v) * (-0.72134752044f);
    f32x2 e; e.x = __builtin_amdgcn_exp2f(s.x); e.y = __builtin_amdgcn_exp2f(s.y);
    const f32x2 m = v * (q * e), r = v - m;
    f32x2 o; o.x = v.x < 0.f ? m.x : r.x; o.y = v.y < 0.f ? m.y : r.y; return o;
}

template <int ACT  > struct EpiBf16 {
    static constexpr bool PERM = true, AFTER_DRAIN = false; static_assert(ACT == 0 || ACT == 1, "EpiBf16: ACT is 0 (none) or 1 (gelu_pk)");
    bf16_t* O; int ldc; const float* bias; int split_cols; size_t split_stride; float scale0;
    __device__ __forceinline__ void operator()(const f32x4 (&acc)[2][2][4][2], const Unit& u, int wr, int wc, int fr, int fq) const {
        const int row0 = u.pm * BM + wr * 64 + fr; int colt = u.pn * BM; bf16_t* base = O;
        float sc = 1.f; if (split_cols) { const int t = colt / split_cols; base += (size_t)t * split_stride; colt -= t * split_cols; if (t == 0) sc = scale0; }
        const int col0 = colt + wc * 32 + 8 * fq, bcol0 = u.pn * BM + wc * 32 + 8 * fq;
        f32x4 bv[2][2];
#pragma unroll
        for (int bj = 0; bj < 2; ++bj)
#pragma unroll
            for (int n = 0; n < 2; ++n) bv[bj][n] = bias ? *(const f32x4*)(bias + bcol0 + bj * HALF + 4 * n) : (f32x4){0.f, 0.f, 0.f, 0.f};
#pragma unroll
        for (int ai = 0; ai < 2; ++ai)
#pragma unroll
            for (int m = 0; m < 4; ++m) { bf16_t* rowp = base + (size_t)(row0 + ai * HALF + m * 16) * ldc + col0;
#pragma unroll
                for (int bj = 0; bj < 2; ++bj) { f32x4 v0 = acc[ai][bj][m][0] + bv[bj][0], v1 = acc[ai][bj][m][1] + bv[bj][1];
                    if (ACT == 1) { f32x2 a = gelu_pk((f32x2){v0[0], v0[1]}), b = gelu_pk((f32x2){v0[2], v0[3]}), c = gelu_pk((f32x2){v1[0], v1[1]}), d = gelu_pk((f32x2){v1[2], v1[3]});
                        v0 = (f32x4){a.x, a.y, b.x, b.y}; v1 = (f32x4){c.x, c.y, d.x, d.y}; }
                    v0 = v0 * sc; v1 = v1 * sc; u32x4 w; w.x = cvt_pk_bf16(v0[0], v0[1]); w.y = cvt_pk_bf16(v0[2], v0[3]); w.z = cvt_pk_bf16(v1[0], v1[1]); w.w = cvt_pk_bf16(v1[2], v1[3]);
                    *(u32x4*)(rowp + bj * HALF) = w; } }
    }
};

struct PanelStats {
    unsigned* xbuf;
    unsigned* cnt;
    unsigned* tmo;
    int ntn; float eps;
    unsigned code;
    __device__ __forceinline__ bool run(const f32x4 (&v)[2][2][4][2], const Unit& u, int wr, int wc, int fr, int fq, PG8_LAS unsigned char* lds, int wid, int lane) const {
        typedef float f32x2v __attribute__((ext_vector_type(2)));
        PG8_LAS f32x2v* P = (PG8_LAS f32x2v*)lds;
        PG8_LAS f32x2v* S = (PG8_LAS f32x2v*)(lds + 8192);
        PG8_LAS unsigned* flag = (PG8_LAS unsigned*)(lds + 8192 + 2048);
#pragma unroll
        for (int ai = 0; ai < 2; ++ai)
#pragma unroll
            for (int m = 0; m < 4; ++m) {
                float s = 0.f;
#pragma unroll
                for (int bj = 0; bj < 2; ++bj)
#pragma unroll
                    for (int n = 0; n < 2; ++n) { const f32x4 x = v[ai][bj][m][n]; s += (x[0] + x[1]) + (x[2] + x[3]); }
                s += __shfl_xor(s, 16); s += __shfl_xor(s, 32);
                const float mw = s * (1.0f / 64.0f); float q = 0.f;
#pragma unroll
                for (int bj = 0; bj < 2; ++bj)
#pragma unroll
                    for (int n = 0; n < 2; ++n) { const f32x4 d = v[ai][bj][m][n] - mw; q += (d[0] * d[0] + d[1] * d[1]) + (d[2] * d[2] + d[3] * d[3]); }
                q += __shfl_xor(q, 16); q += __shfl_xor(q, 32);
                if (fq == 0) P[(ai * HALF + wr * 64 + m * 16 + fr) * 4 + wc] = (f32x2v){mw, q};
            }
        asm volatile("s_waitcnt lgkmcnt(0)" ::: "memory"); __builtin_amdgcn_s_barrier(); asm volatile("" ::: "memory");
#if defined(BROKEN_EXCHANGE_NO_WAIT)
#warning BROKEN CONTROL BUILD: the row-statistics exchange does not wait; results are wrong by design
        if (blockIdx.x >= 64) { const long long t0_ = clock64(); while (clock64() - t0_ < 60000) __builtin_amdgcn_s_sleep(8); }
#endif
        const int row = wid * 32 + (lane & 31);
        if (lane < 32) {
            const f32x2v a = P[row * 4 + 0], b = P[row * 4 + 1], c = P[row * 4 + 2], d = P[row * 4 + 3];
            const float mt = (a.x + b.x + c.x + d.x) * 0.25f;
            const float da = a.x - mt, db = b.x - mt, dc = c.x - mt, dd = d.x - mt;
            const float m2 = (a.y + b.y) + (c.y + d.y) + 64.0f * ((da * da + db * db) + (dc * dc + dd * dd));
            unsigned long long* slot = (unsigned long long*)xbuf + ((size_t)(u.pm * BM + row) * 4 + u.pn);
            __hip_atomic_store(slot, ((unsigned long long)__float_as_uint(m2) << 32) | __float_as_uint(mt), __ATOMIC_RELAXED, __HIP_MEMORY_SCOPE_AGENT);
        }
        asm volatile("s_waitcnt vmcnt(0)" ::: "memory");
        if (lane == 0) __hip_atomic_fetch_add(cnt + 64 * u.pm, 1u, __ATOMIC_RELAXED, __HIP_MEMORY_SCOPE_AGENT);
        if (wid == 0) {
            bool dead = false; const unsigned long long t0 = __builtin_amdgcn_s_memrealtime(); const unsigned want = 8u * (unsigned)ntn;
            for (;;) {
#if defined(BROKEN_EXCHANGE_NO_WAIT)
                break;
#endif
                if ((unsigned)__builtin_amdgcn_readfirstlane(__hip_atomic_load(cnt + 64 * u.pm, __ATOMIC_RELAXED, __HIP_MEMORY_SCOPE_AGENT)) >= want) break;
                if (__builtin_amdgcn_s_memrealtime() - t0 > 2000000ull) {
                    if (lane == 0) { unsigned expect = 0u; __hip_atomic_compare_exchange_strong(tmo + 1, &expect, code | (unsigned)(u.pm & 0xff), __ATOMIC_RELAXED, __ATOMIC_RELAXED, __HIP_MEMORY_SCOPE_AGENT);
                                     __hip_atomic_store(tmo, 1u, __ATOMIC_RELAXED, __HIP_MEMORY_SCOPE_AGENT); }
                    dead = true; break; }
                __builtin_amdgcn_s_sleep(2);
            }
            __builtin_amdgcn_fence(__ATOMIC_ACQUIRE, "agent");
            if (lane == 0) flag[0] = dead ? 1u : 0u;
        }
        asm volatile("s_waitcnt vmcnt(0) lgkmcnt(0)" ::: "memory"); __builtin_amdgcn_s_barrier(); asm volatile("" ::: "memory");
        const bool bad = flag[0] != 0u;
        if (lane < 32) {
            const unsigned long long* slot = (const unsigned long long*)xbuf + (size_t)(u.pm * BM + row) * 4; float mt[4], m2[4]; float ms = 0.f;
#pragma unroll
            for (int t = 0; t < 4; ++t) { if (t < ntn) { const unsigned long long w = __hip_atomic_load(slot + t, __ATOMIC_RELAXED, __HIP_MEMORY_SCOPE_AGENT); mt[t] = __uint_as_float((unsigned)w); m2[t] = __uint_as_float((unsigned)(w >> 32)); } else { mt[t] = 0.f; m2[t] = 0.f; } ms += mt[t]; }
            const float mean = ms / (float)ntn; float q = 0.f;
#pragma unroll
            for (int t = 0; t < 4; ++t) if (t < ntn) { const float dm = mt[t] - mean; q += m2[t] + 256.0f * dm * dm; }
            S[row] = (f32x2v){mean, 1.0f / sqrtf(q / (256.0f * (float)ntn) + eps)};
        }
        asm volatile("s_waitcnt lgkmcnt(0)" ::: "memory"); __builtin_amdgcn_s_barrier(); asm volatile("" ::: "memory");
        return bad;
    }
};
struct EpiLnRes {
    static constexpr bool PERM = false, AFTER_DRAIN = true;
    const float* base; float* out; int ldc; const float* bias; PanelStats st; unsigned poison;
    __device__ __forceinline__ void fused(f32x4 (&acc)[2][2][4][2], const Unit& u, int wr, int wc, int fr, int fq, PG8_LAS unsigned char* lds, int wid, int lane) const {
        typedef float f32x2v __attribute__((ext_vector_type(2)));
        const PG8_LAS f32x2v* S = (const PG8_LAS f32x2v*)(lds + 8192);
        const int col0 = u.pn * BM + wc * 32 + 4 * fq;
#pragma unroll
        for (int bj = 0; bj < 2; ++bj)
#pragma unroll
            for (int n = 0; n < 2; ++n) { const f32x4 bv = bias ? *(const f32x4*)(bias + col0 + bj * HALF + n * 16) : (f32x4){0.f, 0.f, 0.f, 0.f};
#pragma unroll
                for (int ai = 0; ai < 2; ++ai)
#pragma unroll
                    for (int m = 0; m < 4; ++m) acc[ai][bj][m][n] += bv; }
        f32x4 pre[4][2][2];
#pragma unroll
        for (int m = 0; m < 4; ++m) { const size_t off = (size_t)(u.pm * BM + wr * 64 + m * 16 + fr) * ldc + col0;
#pragma unroll
            for (int bj = 0; bj < 2; ++bj)
#pragma unroll
                for (int n = 0; n < 2; ++n) pre[m][bj][n] = *(const f32x4*)(base + off + bj * HALF + n * 16); }
        const bool bad = st.run(acc, u, wr, wc, fr, fq, lds, wid, lane) || poison != 0u;
        const float qnan = __builtin_nanf("");
#pragma unroll
        for (int ai = 0; ai < 2; ++ai)
#pragma unroll
            for (int m = 0; m < 4; ++m) { const int r = ai * HALF + wr * 64 + m * 16 + fr; const f32x2v sr = S[r]; const size_t off = (size_t)(u.pm * BM + r) * ldc + col0;
#pragma unroll
                for (int bj = 0; bj < 2; ++bj)
#pragma unroll
                    for (int n = 0; n < 2; ++n) { const f32x4 bs = ai == 0 ? pre[m][bj][n] : *(const f32x4*)(base + off + bj * HALF + n * 16); f32x4 o = bs + (acc[ai][bj][m][n] - sr.x) * sr.y;
                        if (bad) o = (f32x4){qnan, qnan, qnan, qnan}; *(f32x4*)(out + off + bj * HALF + n * 16) = o; }
                if (m & 1) asm volatile("" ::: "memory"); }
    }
};
struct EpiLnResLn {
    static constexpr bool PERM = false, AFTER_DRAIN = true;
    const float* base; float* out; bf16_t* xn; int ldc; const float* bias; PanelStats st1, st2; unsigned poison;
    __device__ __forceinline__ void fused(f32x4 (&acc)[2][2][4][2], const Unit& u, int wr, int wc, int fr, int fq, PG8_LAS unsigned char* lds, int wid, int lane) const {
        typedef float f32x2v __attribute__((ext_vector_type(2))); typedef unsigned u32x2v __attribute__((ext_vector_type(2)));
        const PG8_LAS f32x2v* S = (const PG8_LAS f32x2v*)(lds + 8192);
        const int col0 = u.pn * BM + wc * 32 + 4 * fq;
#pragma unroll
        for (int bj = 0; bj < 2; ++bj)
#pragma unroll
            for (int n = 0; n < 2; ++n) { const f32x4 bv = bias ? *(const f32x4*)(bias + col0 + bj * HALF + n * 16) : (f32x4){0.f, 0.f, 0.f, 0.f};
#pragma unroll
                for (int ai = 0; ai < 2; ++ai)
#pragma unroll
                    for (int m = 0; m < 4; ++m) acc[ai][bj][m][n] += bv; }
        bool bad = st1.run(acc, u, wr, wc, fr, fq, lds, wid, lane) || poison != 0u;
        const float qnan = __builtin_nanf("");
#pragma unroll
        for (int ai = 0; ai < 2; ++ai)
#pragma unroll
            for (int m = 0; m < 4; ++m) { const int r = ai * HALF + wr * 64 + m * 16 + fr; const f32x2v sr = S[r]; const size_t off = (size_t)(u.pm * BM + r) * ldc + col0;
#pragma unroll
                for (int bj = 0; bj < 2; ++bj)
#pragma unroll
                    for (int n = 0; n < 2; ++n) { const f32x4 bs = *(const f32x4*)(base + off + bj * HALF + n * 16); acc[ai][bj][m][n] = bs + (acc[ai][bj][m][n] - sr.x) * sr.y; }
                asm volatile("" : "+v"(acc[ai][0][m][0]), "+v"(acc[ai][0][m][1]), "+v"(acc[ai][1][m][0]), "+v"(acc[ai][1][m][1]));
                if (m & 1) asm volatile("" ::: "memory"); }
        const bool bad1 = bad;
        bad = st2.run(acc, u, wr, wc, fr, fq, lds, wid, lane) || bad;
#pragma unroll
        for (int ai = 0; ai < 2; ++ai)
#pragma unroll
            for (int m = 0; m < 4; ++m) { const int r = ai * HALF + wr * 64 + m * 16 + fr; const f32x2v sr = S[r]; const size_t off = (size_t)(u.pm * BM + r) * ldc + col0;
#pragma unroll
                for (int bj = 0; bj < 2; ++bj)
#pragma unroll
                    for (int n = 0; n < 2; ++n) { const f32x4 x1 = acc[ai][bj][m][n]; *(f32x4*)(out + off + bj * HALF + n * 16) = bad1 ? (f32x4){qnan, qnan, qnan, qnan} : x1;
                        const f32x4 o = (x1 - sr.x) * sr.y; u32x2v w; w.x = cvt_pk_bf16(o[0], o[1]); w.y = cvt_pk_bf16(o[2], o[3]);
                        if (bad) { w.x = 0x7fc07fc0u; w.y = 0x7fc07fc0u; } *(u32x2v*)(xn + off + bj * HALF + n * 16) = w; }
                asm volatile("" ::: "memory"); }
    }
};

template <class Epi, class Sched, bool ALIGN_EPI = false, bool SP2 = false>
__device__ __forceinline__ void gemm_phase(PG8_LAS unsigned char* lds, const Gemm g, const Sched& S, const Epi& E) {
    int tid_ = threadIdx.x; asm volatile("" : "+v"(tid_));
    const int tid = tid_, wid = __builtin_amdgcn_readfirstlane(tid >> 6), lane = tid & 63, wr = wid >> 2, wc = wid & 3, fr = lane & 15, fq = lane >> 4;
    const int K = g.K, nt = K / BK;
    unsigned voffA[2], voffB[2];
#pragma unroll
    for (int i = 0; i < 2; ++i) { int R, C; stage_rc(tid * 16 + i * 8192, R, C); const int Rb = Epi::PERM ? ((R & ~31) + perm32(R & 31)) : R;
        voffA[i] = (unsigned)(R * K + C) * 2u; voffB[i] = (unsigned)(Rb * K + C) * 2u; }
    const size_t kstep = (size_t)(BK * 2);
    const size_t hstep = (size_t)HALF * K * 2;
    const size_t tstep = 2 * hstep;
    const unsigned ldsw = (unsigned)wid * 1024u;
    const int aoff = lds_byte(wr * 64 + fr, fq * 8), boff = lds_byte(wc * 32 + fr, fq * 8);
#define PG8_SA(b, h) (((b) * 2 + (h)) * HTB)
#define PG8_SB(b, h) ((4 + (b) * 2 + (h)) * HTB)
#define PG8_STAGE(bufoff, gbase, voff) do { _Pragma("unroll") for (int _i = 0; _i < 2; ++_i) \
        __builtin_amdgcn_global_load_lds((const unsigned*)((const char*)(gbase) + (voff)[_i]), (PG8_LAS unsigned*)(lds + (bufoff) + ldsw + _i * 8192), 16, 0, 0); } while (0)
#define PG8_LDA(dst, b, h) do { _Pragma("unroll") for (int m = 0; m < 4; ++m) _Pragma("unroll") for (int k = 0; k < 2; ++k) dst[m][k] = *(const PG8_LAS bf16x8*)(lds + PG8_SA(b, h) + aoff + m * 2048 + k * 1024); } while (0)
#define PG8_LDB(dst, b, h) do { _Pragma("unroll") for (int n = 0; n < 2; ++n) _Pragma("unroll") for (int k = 0; k < 2; ++k) dst[n][k] = *(const PG8_LAS bf16x8*)(lds + PG8_SB(b, h) + boff + n * 2048 + k * 1024); } while (0)
#define PG8_MMA(ai, bj, At, Bt) do { __builtin_amdgcn_s_setprio(1); _Pragma("unroll") for (int m = 0; m < 4; ++m) _Pragma("unroll") for (int n = 0; n < 2; ++n) _Pragma("unroll") for (int k = 0; k < 2; ++k) \
        acc[ai][bj][m][n] = __builtin_amdgcn_mfma_f32_16x16x32_bf16(Bt[n][k], At[m][k], acc[ai][bj][m][n], 0, 0, 0); __builtin_amdgcn_s_setprio(0); } while (0)
#define PG8_WAIT_V(n) asm volatile("s_waitcnt vmcnt(" #n ")" ::: "memory")
#define PG8_WAIT_L(n) asm volatile("s_waitcnt lgkmcnt(" #n ")" ::: "memory")
#define PG8_BAR __builtin_amdgcn_s_barrier()
#define PG8_SCHED __builtin_amdgcn_sched_barrier(0)
    Unit cur, nxt; int ui = 0;
    if (!S.next(0, cur)) return;
    f32x4 acc[2][2][4][2];
#pragma unroll
    for (int a = 0; a < 2; ++a)
#pragma unroll
        for (int b = 0; b < 2; ++b)
#pragma unroll
            for (int m = 0; m < 4; ++m)
#pragma unroll
                for (int n = 0; n < 2; ++n) acc[a][b][m][n] = (f32x4){0.f, 0.f, 0.f, 0.f};
    bf16x8 At[4][2], B0[2][2], B1[2][2];
    const char* cA = (const char*)g.A + (size_t)cur.pm * tstep; const char* cB = (const char*)g.Bt + (size_t)cur.pn * tstep;
    S.a_ready(cur);
    if constexpr (SP2) {
        PG8_STAGE(PG8_SB(0, 0), cB, voffB); PG8_STAGE(PG8_SB(0, 1), cB + hstep, voffB); PG8_STAGE(PG8_SA(0, 0), cA, voffA); PG8_STAGE(PG8_SA(0, 1), cA + hstep, voffA);
        if (wr == 1) PG8_BAR;
        PG8_WAIT_V(2); PG8_BAR;
        PG8_STAGE(PG8_SB(1, 0), cB + kstep, voffB); PG8_STAGE(PG8_SA(1, 0), cA + kstep, voffA); PG8_STAGE(PG8_SB(1, 1), cB + hstep + kstep, voffB);
        PG8_WAIT_V(6); PG8_BAR;
    } else {
        PG8_STAGE(PG8_SB(0, 0), cB, voffB); PG8_STAGE(PG8_SA(0, 0), cA, voffA); PG8_STAGE(PG8_SB(0, 1), cB + hstep, voffB); PG8_STAGE(PG8_SA(0, 1), cA + hstep, voffA);
        if (wr == 1) PG8_BAR;
        PG8_WAIT_V(4); PG8_BAR;
        PG8_STAGE(PG8_SB(1, 0), cB + kstep, voffB); PG8_STAGE(PG8_SA(1, 0), cA + kstep, voffA); PG8_STAGE(PG8_SB(1, 1), cB + hstep + kstep, voffB);
        PG8_WAIT_V(6); PG8_BAR;
    }
    for (;;) {
        const bool has_next = S.next(ui + 1, nxt);
        const char* nA = has_next ? (const char*)g.A + (size_t)nxt.pm * tstep : cA; const char* nB = has_next ? (const char*)g.Bt + (size_t)nxt.pn * tstep : cB;
        for (int t = 0; t < nt; t += 2) {
            const bool last = (t == nt - 2);
            const char* a1 = cA + (size_t)(t + 1) * kstep;
            const char* a2 = last ? nA : cA + (size_t)(t + 2) * kstep; const char* b2 = last ? nB : cB + (size_t)(t + 2) * kstep;
            const char* a3 = a2 + kstep; const char* b3 = b2 + kstep;
            if (last && has_next) S.a_ready(nxt);
            if constexpr (SP2) {
            PG8_LDB(B0, 0, 0); PG8_LDB(B1, 0, 1); PG8_SCHED; PG8_LDA(At, 0, 0); PG8_STAGE(PG8_SA(1, 1), a1 + hstep, voffA);
            PG8_WAIT_V(8); PG8_WAIT_L(0); PG8_BAR; PG8_MMA(0, 0, At, B0); PG8_MMA(0, 1, At, B1); PG8_BAR; PG8_SCHED;
            PG8_LDA(At, 0, 1); PG8_STAGE(PG8_SB(0, 0), b2, voffB); PG8_STAGE(PG8_SB(0, 1), b2 + hstep, voffB); PG8_STAGE(PG8_SA(0, 0), a2, voffA);
            PG8_WAIT_V(8); PG8_WAIT_L(0); PG8_BAR; PG8_MMA(1, 0, At, B0); PG8_MMA(1, 1, At, B1); PG8_BAR; PG8_SCHED;
            PG8_LDB(B0, 1, 0); PG8_LDB(B1, 1, 1); PG8_SCHED; PG8_LDA(At, 1, 0); PG8_STAGE(PG8_SA(0, 1), a2 + hstep, voffA);
            PG8_WAIT_V(8); PG8_WAIT_L(0); PG8_BAR; PG8_MMA(0, 0, At, B0); PG8_MMA(0, 1, At, B1); PG8_BAR; PG8_SCHED;
            PG8_LDA(At, 1, 1); PG8_STAGE(PG8_SB(1, 0), b3, voffB); PG8_STAGE(PG8_SB(1, 1), b3 + hstep, voffB); PG8_STAGE(PG8_SA(1, 0), a3, voffA);
            PG8_WAIT_V(8); PG8_WAIT_L(0); PG8_BAR; PG8_MMA(1, 0, At, B0); PG8_MMA(1, 1, At, B1); PG8_BAR; PG8_SCHED;
            } else {
            PG8_LDB(B0, 0, 0); PG8_SCHED; PG8_LDA(At, 0, 0); PG8_STAGE(PG8_SA(1, 1), a1 + hstep, voffA);
            PG8_WAIT_L(8); PG8_BAR; PG8_WAIT_L(0); PG8_MMA(0, 0, At, B0); PG8_BAR; PG8_SCHED;
            PG8_LDB(B1, 0, 1); PG8_STAGE(PG8_SB(0, 0), b2, voffB);
            PG8_BAR; PG8_WAIT_L(0); PG8_MMA(0, 1, At, B1); PG8_BAR;
            PG8_LDA(At, 0, 1); PG8_STAGE(PG8_SA(0, 0), a2, voffA);
            PG8_BAR; PG8_WAIT_L(0); PG8_MMA(1, 0, At, B0); PG8_BAR; PG8_SCHED;
            PG8_STAGE(PG8_SB(0, 1), b2 + hstep, voffB);
            PG8_WAIT_V(6); PG8_BAR; PG8_MMA(1, 1, At, B1); PG8_BAR;
            PG8_LDB(B0, 1, 0); PG8_SCHED; PG8_LDA(At, 1, 0); PG8_STAGE(PG8_SA(0, 1), a2 + hstep, voffA);
            PG8_WAIT_L(8); PG8_BAR; PG8_WAIT_L(0); PG8_MMA(0, 0, At, B0); PG8_BAR; PG8_SCHED;
            PG8_LDB(B1, 1, 1); PG8_STAGE(PG8_SB(1, 0), b3, voffB);
            PG8_BAR; PG8_WAIT_L(0); PG8_MMA(0, 1, At, B1); PG8_BAR;
            PG8_LDA(At, 1, 1); PG8_STAGE(PG8_SA(1, 0), a3, voffA);
            PG8_BAR; PG8_WAIT_L(0); PG8_MMA(1, 0, At, B0); PG8_BAR; PG8_SCHED;
            PG8_STAGE(PG8_SB(1, 1), b3 + hstep, voffB);
            PG8_WAIT_V(6); PG8_BAR; PG8_MMA(1, 1, At, B1); PG8_BAR;
            }
        }
        if constexpr (ALIGN_EPI) { if (wr == 0) PG8_BAR; }
        if constexpr (!Epi::AFTER_DRAIN) { E(acc, cur, wr, wc, fr, fq); S.done(cur); }
        if (!has_next) break;
#pragma unroll
        for (int a = 0; a < 2; ++a)
#pragma unroll
            for (int b = 0; b < 2; ++b)
#pragma unroll
                for (int m = 0; m < 4; ++m)
#pragma unroll
                    for (int n = 0; n < 2; ++n) acc[a][b][m][n] = (f32x4){0.f, 0.f, 0.f, 0.f};
        cur = nxt; cA = nA; cB = nB; ++ui;
        if constexpr (ALIGN_EPI) { if (wr == 1) PG8_BAR; }
    }
    PG8_WAIT_V(0);
    if constexpr (!ALIGN_EPI) { if (wr == 0) PG8_BAR; }
    PG8_BAR;
    if constexpr (Epi::AFTER_DRAIN) { E.fused(acc, cur, wr, wc, fr, fq, lds, wid, lane); S.done(cur); }
#undef PG8_SA
#undef PG8_SB
#undef PG8_STAGE
#undef PG8_LDA
#undef PG8_LDB
#undef PG8_MMA
#undef PG8_WAIT_V
#undef PG8_WAIT_L
#undef PG8_BAR
#undef PG8_SCHED
}
}
namespace pg8 {
struct EpiResid {
    static constexpr bool PERM = false, AFTER_DRAIN = false;
    float* x; int ldc; float alpha;
    __device__ __forceinline__ void operator()(const f32x4 (&acc)[2][2][4][2], const Unit& u, int wr, int wc, int fr, int fq) const {
        const int col0 = u.pn * BM + wc * 32 + 4 * fq;
#pragma unroll
        for (int ai = 0; ai < 2; ++ai)
#pragma unroll
            for (int m = 0; m < 4; ++m) { const int r = ai * HALF + wr * 64 + m * 16 + fr; const size_t off = (size_t)(u.pm * BM + r) * ldc + col0;
#pragma unroll
                for (int bj = 0; bj < 2; ++bj)
#pragma unroll
                    for (int n = 0; n < 2; ++n) { float* p = x + off + bj * HALF + n * 16; f32x4 v = *(const f32x4*)p; v = v * alpha + acc[ai][bj][m][n]; *(f32x4*)p = v; }
                if (m & 1) asm volatile("" ::: "memory"); }
    }
};
}
#define PG8_SP2 true
#define PG8_ALIGN true
#include <hip/hip_bf16.h>
#include <cmath>
namespace attn_body {
using bf16=__hip_bfloat16;
using bf16x8=__attribute__((ext_vector_type(8)))short;
using s16x4=__attribute__((ext_vector_type(4)))short;
using f32x16=__attribute__((ext_vector_type(16)))float;
using u32x4=__attribute__((ext_vector_type(4)))unsigned;
constexpr int BATCH=2,NHEAD=16,SEQ=16384,D=64,DM=3328,DMO=1024;
constexpr int NW=8,QBLK=32,QB=QBLK*NW,KVBLK=64,NQB=SEQ/QB;
constexpr int ATTN_PITCH=DM, ATTN_UNIT_ROWS=QB;
__device__ __forceinline__ int crow(int r,int hi){return (r&3)+8*(r>>2)+4*hi;}
#define SBAR() __builtin_amdgcn_sched_barrier(0)
__device__ __forceinline__ void cmask(f32x16&p0,f32x16&p1,int jb,int qrel,int hi){
  const float NEG=-INFINITY; int kb=64*jb+4*hi;
  #pragma unroll
  for(int r=0;r<16;++r){int kv=kb+(r&3)+8*(r>>2); if(kv>qrel)p0[r]=NEG; if(kv+32>qrel)p1[r]=NEG;}
}

constexpr int NSLOT=3, SLOTB=8192;
constexpr int LDS_K=0, LDS_V=NSLOT*SLOTB, LDS_WS=2*NSLOT*SLOTB, LDS_OST=LDS_WS+NW*64*4, LDS_BYTES=LDS_OST+NW*4096;
constexpr float C2=0.125f*1.4426950408889634f;
__device__ __forceinline__ void glds16(const void*gsrc,unsigned lds_dst){unsigned keep;
  asm volatile("s_mov_b32 %0, m0\n\ts_mov_b32 m0, %2\n\ts_nop 0\n\tglobal_load_lds_dwordx4 %1, off\n\ts_mov_b32 m0, %0":"=&s"(keep):"v"(gsrc),"s"(lds_dst):"memory");}
__device__ __forceinline__ float max3f(float a,float b,float c){float r;asm("v_max3_f32 %0, %1, %2, %3":"=v"(r):"v"(a),"v"(b),"v"(c));return r;}
__device__ __forceinline__ float max2f(float a,float b){float r;asm("v_max_f32_e32 %0, %1, %2":"=v"(r):"v"(a),"v"(b));return r;}
__device__ __forceinline__ float fadd_s(float a,float b){float r;asm("v_add_f32_e32 %0, %1, %2":"=v"(r):"v"(a),"v"(b));return r;}
__device__ __forceinline__ float fsub_s(float a,float b){float r;asm("v_sub_f32_e32 %0, %1, %2":"=v"(r):"v"(a),"v"(b));return r;}
typedef float f32x2_t __attribute__((ext_vector_type(2))); typedef __bf16 bf16x2_t __attribute__((ext_vector_type(2)));
__device__ __forceinline__ unsigned cvtpk_s(float lo,float hi){f32x2_t v={lo,hi};bf16x2_t b=__builtin_convertvector(v,bf16x2_t);return __builtin_bit_cast(unsigned,b);}
#define WAIT_BAR(N) asm volatile("s_waitcnt vmcnt(" #N ") lgkmcnt(0)\n\ts_barrier":::"memory")

__device__ __forceinline__ void qkt(f32x16&p0,f32x16&p1,const char*Kslot,const bf16x8*qr,const f32x16&negm,int r32,int hi){
  const char*kb=Kslot+hi*1024+r32*16;
  #pragma unroll
  for(int d0=0;d0<4;++d0){
    const bf16x8 b0=*reinterpret_cast<const bf16x8*>(kb+d0*2048);
    const bf16x8 b1=*reinterpret_cast<const bf16x8*>(kb+d0*2048+512);
    if(d0==0){p0=__builtin_amdgcn_mfma_f32_32x32x16_bf16(b0,qr[0],negm,0,0,0);p1=__builtin_amdgcn_mfma_f32_32x32x16_bf16(b1,qr[0],negm,0,0,0);}
    else{p0=__builtin_amdgcn_mfma_f32_32x32x16_bf16(b0,qr[d0],p0,0,0,0);p1=__builtin_amdgcn_mfma_f32_32x32x16_bf16(b1,qr[d0],p1,0,0,0);}}
}
typedef __attribute__((address_space(3))) const char* lds_cptr;
typedef short v4i16_t __attribute__((ext_vector_type(4)));
__device__ __forceinline__ void kload8(bf16x8*kf,lds_cptr kp){
  kf[0]=*(const __attribute__((address_space(3))) bf16x8*)(kp);      kf[1]=*(const __attribute__((address_space(3))) bf16x8*)(kp+512);
  kf[2]=*(const __attribute__((address_space(3))) bf16x8*)(kp+2048); kf[3]=*(const __attribute__((address_space(3))) bf16x8*)(kp+2560);
  kf[4]=*(const __attribute__((address_space(3))) bf16x8*)(kp+4096); kf[5]=*(const __attribute__((address_space(3))) bf16x8*)(kp+4608);
  kf[6]=*(const __attribute__((address_space(3))) bf16x8*)(kp+6144); kf[7]=*(const __attribute__((address_space(3))) bf16x8*)(kp+6656);
}
__device__ __forceinline__ void kload2(bf16x8*kf,lds_cptr kp,int j){ kf[2*j]=*(const __attribute__((address_space(3))) bf16x8*)(kp+j*2048); kf[2*j+1]=*(const __attribute__((address_space(3))) bf16x8*)(kp+j*2048+512); }
__device__ __forceinline__ s16x4 vtr(lds_cptr p){ return __builtin_bit_cast(s16x4,__builtin_amdgcn_ds_read_tr16_b64_v4i16((__attribute__((address_space(3))) v4i16_t*)p)); }
__device__ __forceinline__ float rowmax(const f32x16&p0,const f32x16&p1){
  float a=max3f(p0[0],p0[1],p1[0]),b=max3f(p0[2],p0[3],p1[1]);a=max3f(a,p1[2],p1[3]);
  #pragma unroll
  for(int r=4;r<16;r+=4){a=max3f(a,p0[r],p0[r+1]);b=max3f(b,p0[r+2],p0[r+3]);a=max3f(a,p1[r],p1[r+1]);b=max3f(b,p1[r+2],p1[r+3]);}
  const float m=max2f(a,b);
  auto rr=__builtin_amdgcn_permlane32_swap(__float_as_uint(m),__float_as_uint(m),false,false);
  return max2f(__uint_as_float(rr[0]),__uint_as_float(rr[1]));
}
__device__ __forceinline__ void pv(f32x16*o,int vb,bf16x8 pa0,bf16x8 pa1,bf16x8 pa2,bf16x8 pa3){
  #pragma unroll
  for(int d0=0;d0<2;++d0){s16x4 lo[4],hi[4];
    #pragma unroll
    for(int ks=0;ks<4;++ks){
      asm volatile("ds_read_b64_tr_b16 %0,%1 offset:%c2":"=&v"(lo[ks]):"v"(vb),"i"(d0*4096+ks*1024):"memory");
      asm volatile("ds_read_b64_tr_b16 %0,%1 offset:%c2":"=&v"(hi[ks]):"v"(vb),"i"(d0*4096+ks*1024+512):"memory");}
    asm volatile("s_waitcnt lgkmcnt(0)":::"memory");SBAR();
    #define PK(k) (bf16x8){lo[k][0],lo[k][1],lo[k][2],lo[k][3],hi[k][0],hi[k][1],hi[k][2],hi[k][3]}
    o[d0]=__builtin_amdgcn_mfma_f32_32x32x16_bf16(pa0,PK(0),o[d0],0,0,0);
    o[d0]=__builtin_amdgcn_mfma_f32_32x32x16_bf16(pa1,PK(1),o[d0],0,0,0);
    o[d0]=__builtin_amdgcn_mfma_f32_32x32x16_bf16(pa2,PK(2),o[d0],0,0,0);
    o[d0]=__builtin_amdgcn_mfma_f32_32x32x16_bf16(pa3,PK(3),o[d0],0,0,0);
    #undef PK
  }
}

#ifndef ATTN_STORE16
#define ATTN_STORE16(p,v) (*(u32x4*)(p)=(v))
#endif
template<int THRL> __device__ __forceinline__ void attn_unit(int b,int h,int qb,const bf16*Q,const bf16*__restrict__ K,const bf16*__restrict__ V,bf16*O,char*shm){
  int tid_=threadIdx.x; asm volatile("":"+v"(tid_)); const int tid=tid_,lane=tid&63,r32=lane&31,hi=lane>>5; const int wid=__builtin_amdgcn_readfirstlane(tid>>6);
  const long rowbase=(long)b*SEQ; const int q0=qb*QB;
  const bf16*Qw=Q+(rowbase+q0+wid*QBLK)*DM+h*D;
  const bf16*Kh=K+rowbase*DM+h*D,*Vh=V+rowbase*DM+h*D;
  const unsigned lds0=(unsigned)(uintptr_t)shm;
  float*wsf=(float*)(shm+LDS_WS)+wid*64;
  const bf16*ksrc=Kh+(long)lane*DM+wid*8;
  const bf16*vsrc=Vh+(long)(16*(wid&3)+(lane>>2))*DM+(wid>>2)*32+(lane&3)*8;
  const unsigned kdst=lds0+LDS_K+wid*1024, vdst=lds0+LDS_V+wid*1024;
  #define DMA_K(t,slot) glds16(ksrc+(long)(t)*KVBLK*DM,(unsigned)__builtin_amdgcn_readfirstlane(kdst+(slot)))
  #define DMA_V(t,slot) glds16(vsrc+(long)(t)*KVBLK*DM,(unsigned)__builtin_amdgcn_readfirstlane(vdst+(slot)))
  const int vb0=(int)(lds0+LDS_V)+((lane>>4)&1)*32+(lane&3)*8+(4*hi+((lane&15)>>2))*64;
  const char*Kbase=shm+LDS_K; bf16x8 kf[8];
  const lds_cptr shm3=(lds_cptr)shm; const lds_cptr kp0=shm3+LDS_K+hi*1024+r32*16; const lds_cptr vp0=shm3+LDS_V+((lane>>4)&1)*32+(lane&3)*8+(4*hi+((lane&15)>>2))*64;
  const int NT=(q0+QB)/KVBLK;
  DMA_K(0,0);DMA_V(0,0);DMA_K(1,SLOTB);
  bf16x8 qr[4];
  #pragma unroll
  for(int d0=0;d0<4;++d0)qr[d0]=*reinterpret_cast<const bf16x8*>(&Qw[(long)r32*DM+d0*16+hi*8]);
  float mhat=0.f,l_reg=0.f;f32x16 o[2];o[0]=f32x16{};o[1]=f32x16{};f32x16 negm=f32x16{};asm volatile("":"+v"(negm));
  const int qrel=wid*QBLK+r32;
  #define CMASK(P0,P1,t) do{int jb_=(t)-(NT-4); if(jb_>=0)cmask(P0,P1,jb_,qrel,hi);}while(0)
  bool resc=false;
  #define START(P0,P1) do{ const float rm=rowmax(P0,P1); resc=false; \
    { const float dl=rm; mhat=fadd_s(mhat,dl); \
      _Pragma("unroll") for(int r=0;r<16;++r){P0[r]=fsub_s(P0[r],dl);P1[r]=fsub_s(P1[r],dl);} \
      _Pragma("unroll") for(int r=0;r<16;++r)negm[r]=-mhat; asm volatile("":"+v"(negm)); } \
    _Pragma("unroll") for(int r=0;r<16;++r)P0[r]=__builtin_amdgcn_exp2f(P0[r]); }while(0)
  #define RESC() do{ if(resc){ asm volatile("s_waitcnt lgkmcnt(0)":::"memory"); \
      _Pragma("unroll") for(int d_=0;d_<2;++d_) _Pragma("unroll") for(int r=0;r<16;++r)o[d_][r]*=wsf[crow(r,hi)]; } }while(0)
  f32x16 pA0,pA1,pB0,pB1;
  int sl_prev=0,sl_cur=0,sl_next=SLOTB;
  #define ROT() do{sl_prev=sl_cur;sl_cur=sl_next;sl_next=(sl_next==(NSLOT-1)*SLOTB)?0:sl_next+SLOTB;}while(0)
  DMA_K(2,2*SLOTB);
  WAIT_BAR(3);
  qkt(pA0,pA1,Kbase,qr,negm,r32,hi);asm volatile("s_nop 15\n\ts_nop 7":"+v"(pA0),"+v"(pA1));CMASK(pA0,pA1,0);
  START(pA0,pA1);
  _Pragma("unroll") for(int r=0;r<16;++r)pA1[r]=__builtin_amdgcn_exp2f(pA1[r]);
  WAIT_BAR(0);
  DMA_K(3,0);DMA_V(1,SLOTB);
  ROT();
  kload8(kf,kp0+sl_cur);
  WAIT_BAR(2);
  s16x4 vlo[8],vhi[8]; u32x4 pw0,pw1,pw2,pw3;
  #define PKW(P,B) cvtpk_s(P[B],P[B+1])
  #define PAF(k) __builtin_bit_cast(bf16x8,pw##k)
  #define VFR(i) (bf16x8){vlo[i][0],vlo[i][1],vlo[i][2],vlo[i][3],vhi[i][0],vhi[i][1],vhi[i][2],vhi[i][3]}
  #define PIN(x) asm volatile("":"+v"(x))
  #define MX3(a,b,c) __builtin_fmaxf(__builtin_fmaxf((a),(b)),(c))
  #define GAPA(MF,A0,A1,A2,A3,W0,W1,PW) do{ MF; sacc+=A0; sacc+=A1; sacc+=A2; sacc+=A3; PIN(sacc); W0; W1; PIN(PW); SBAR(); }while(0)
  #define EX(v) __builtin_amdgcn_exp2f(v)
  #define GAPB(MF,X,B) do{ MF; X[B]=EX(X[B]); X[B+1]=EX(X[B+1]); X[B+2]=EX(X[B+2]); X[B+3]=EX(X[B+3]); PIN(X); SBAR(); }while(0)
  #define VRD(i) do{ vlo[i]=vtr(vp_+(((i)>>2)*4096+((i)&3)*1024)); vhi[i]=vtr(vp_+(((i)>>2)*4096+((i)&3)*1024+512)); }while(0)
  #define KRD(G,j) do{ if(G){ kload2(kf,kp0+sl_next,j); SBAR(); } }while(0)
  #define STEP(C0,C1,P0,P1,t,GK,GV,GL) do{ SBAR(); \
    const lds_cptr vp_=vp0+sl_prev; \
    VRD(0); SBAR(); float sacc=(P0[0]+P0[1]); \
    GAPA(C0=__builtin_amdgcn_mfma_f32_32x32x16_bf16(kf[0],qr[0],negm,0,0,0), P0[2],P0[3],P0[4],P0[5],     pw0[0]=PKW(P0,0), pw0[1]=PKW(P0,2), pw0); \
    VRD(4); SBAR(); GAPA(C1=__builtin_amdgcn_mfma_f32_32x32x16_bf16(kf[1],qr[0],negm,0,0,0), P0[6],P0[7],P0[8],P0[9],     pw0[2]=PKW(P0,4), pw0[3]=PKW(P0,6), pw0); \
    VRD(1); SBAR(); GAPA(C0=__builtin_amdgcn_mfma_f32_32x32x16_bf16(kf[2],qr[1],C0,0,0,0),   P0[10],P0[11],P0[12],P0[13], pw1[0]=PKW(P0,8), pw1[1]=PKW(P0,10), pw1); \
    VRD(5); SBAR(); GAPA(C1=__builtin_amdgcn_mfma_f32_32x32x16_bf16(kf[3],qr[1],C1,0,0,0),   P0[14],P0[15],P1[0],P1[1],   pw1[2]=PKW(P0,12),pw1[3]=PKW(P0,14), pw1); \
    VRD(2); SBAR(); GAPA(C0=__builtin_amdgcn_mfma_f32_32x32x16_bf16(kf[4],qr[2],C0,0,0,0),   P1[2],P1[3],P1[4],P1[5],     pw2[0]=PKW(P1,0), pw2[1]=PKW(P1,2), pw2); \
    VRD(6); SBAR(); GAPA(C1=__builtin_amdgcn_mfma_f32_32x32x16_bf16(kf[5],qr[2],C1,0,0,0),   P1[6],P1[7],P1[8],P1[9],     pw2[2]=PKW(P1,4), pw2[3]=PKW(P1,6), pw2); \
    VRD(3); SBAR(); GAPA(C0=__builtin_amdgcn_mfma_f32_32x32x16_bf16(kf[6],qr[3],C0,0,0,0),   P1[10],P1[11],P1[12],P1[13], pw3[0]=PKW(P1,8), pw3[1]=PKW(P1,10), pw3); \
    VRD(7); SBAR(); GAPA(C1=__builtin_amdgcn_mfma_f32_32x32x16_bf16(kf[7],qr[3],C1,0,0,0),   P1[14],P1[15],0.f,0.f,       pw3[2]=PKW(P1,12),pw3[3]=PKW(P1,14), pw3); \
    l_reg+=sacc; \
    if(GK){DMA_K((t)+3,sl_cur);} if(GV){DMA_V((t)+1,sl_next);} \
    CMASK(C0,C1,t); \
    { float a=MX3(C0[0],C0[1],C1[0]),b=MX3(C0[2],C0[3],C1[1]); a=MX3(a,C1[2],C1[3]); \
      _Pragma("unroll") for(int r=4;r<16;r+=4){a=MX3(a,C0[r],C0[r+1]);b=MX3(b,C0[r+2],C0[r+3]);a=MX3(a,C1[r],C1[r+1]);b=MX3(b,C1[r+2],C1[r+3]);} \
      float rm=__builtin_fmaxf(a,b); { auto rr=__builtin_amdgcn_permlane32_swap(__float_as_uint(rm),__float_as_uint(rm),false,false); rm=__builtin_fmaxf(__uint_as_float(rr[0]),__uint_as_float(rr[1])); } \
      resc=false; \
      if(__builtin_expect(__any(rm>(float)THRL),0)){ const float dl=__builtin_fmaxf(rm,0.f); mhat+=dl; \
        _Pragma("unroll") for(int r=0;r<16;++r){C0[r]-=dl;C1[r]-=dl;} \
        _Pragma("unroll") for(int r=0;r<16;++r)negm[r]=-mhat; asm volatile("":"+v"(negm)); \
        const float f=__builtin_amdgcn_exp2f(-dl); l_reg*=f; if(hi==0)wsf[r32]=f; resc=true; } } \
    SBAR(); \
    GAPB(o[0]=__builtin_amdgcn_mfma_f32_32x32x16_bf16(PAF(0),VFR(0),o[0],0,0,0), C0,0); \
    GAPB(o[1]=__builtin_amdgcn_mfma_f32_32x32x16_bf16(PAF(0),VFR(4),o[1],0,0,0), C0,4); \
    KRD(GL,0); GAPB(o[0]=__builtin_amdgcn_mfma_f32_32x32x16_bf16(PAF(1),VFR(1),o[0],0,0,0), C0,8); \
    KRD(GL,1); GAPB(o[1]=__builtin_amdgcn_mfma_f32_32x32x16_bf16(PAF(1),VFR(5),o[1],0,0,0), C0,12); \
    KRD(GL,2); GAPB(o[0]=__builtin_amdgcn_mfma_f32_32x32x16_bf16(PAF(2),VFR(2),o[0],0,0,0), C1,0); \
    KRD(GL,3); GAPB(o[1]=__builtin_amdgcn_mfma_f32_32x32x16_bf16(PAF(2),VFR(6),o[1],0,0,0), C1,4); \
    GAPB(o[0]=__builtin_amdgcn_mfma_f32_32x32x16_bf16(PAF(3),VFR(3),o[0],0,0,0), C1,8); \
    GAPB(o[1]=__builtin_amdgcn_mfma_f32_32x32x16_bf16(PAF(3),VFR(7),o[1],0,0,0), C1,12); \
    }while(0)
  int t=1;
  #undef CMASK
  #define CMASK(P0,P1,t) do{}while(0)
  for(;t+5<NT;t+=2){
    STEP(pB0,pB1,pA0,pA1,t,true,true,true);     WAIT_BAR(2); RESC(); ROT();
    STEP(pA0,pA1,pB0,pB1,t+1,true,true,true);   WAIT_BAR(2); RESC(); ROT();
  }
  #undef CMASK
  #define CMASK(P0,P1,t) do{int jb_=(t)-(NT-4); if(jb_>=0)cmask(P0,P1,jb_,qrel,hi);}while(0)
  #define ENDW(tt) do{ if((tt)+3<NT){WAIT_BAR(2);} else if((tt)+2<NT){WAIT_BAR(1);} else {WAIT_BAR(0);} }while(0)
  for(;t+1<NT;t+=2){
    STEP(pB0,pB1,pA0,pA1,t,(t+3<NT),(t+1<NT),(t+1<NT));       ENDW(t);   RESC(); ROT();
    STEP(pA0,pA1,pB0,pB1,t+1,(t+4<NT),(t+2<NT),(t+2<NT));     ENDW(t+1); RESC(); ROT();
  }
  STEP(pB0,pB1,pA0,pA1,NT-1,false,false,false); RESC();
  { float sacc=pB0[0]+pB0[1]; _Pragma("unroll") for(int r=2;r<16;++r)sacc+=pB0[r]; _Pragma("unroll") for(int r=0;r<16;++r)sacc+=pB1[r]; l_reg+=sacc;
    pw0=(u32x4){PKW(pB0,0),PKW(pB0,2),PKW(pB0,4),PKW(pB0,6)};pw1=(u32x4){PKW(pB0,8),PKW(pB0,10),PKW(pB0,12),PKW(pB0,14)};pw2=(u32x4){PKW(pB1,0),PKW(pB1,2),PKW(pB1,4),PKW(pB1,6)};pw3=(u32x4){PKW(pB1,8),PKW(pB1,10),PKW(pB1,12),PKW(pB1,14)};
    SBAR(); pv(o,vb0+sl_cur,PAF(0),PAF(1),PAF(2),PAF(3)); }
  #undef PKW
  #undef PAF
  #undef VFR
  #undef PIN
  #undef MX3
  #undef GAPA
  #undef GAPB
  #undef EX
  #undef VRD
  #undef KRD
  #undef STEP
  #undef ENDW
  {auto rr=__builtin_amdgcn_permlane32_swap(__float_as_uint(l_reg),__float_as_uint(l_reg),false,false);l_reg=__uint_as_float(rr[0])+__uint_as_float(rr[1]);}
  if(hi==0)wsf[32+r32]=l_reg;asm volatile("s_waitcnt lgkmcnt(0)":::"memory");
  float rli[16];
  #pragma unroll
  for(int r=0;r<16;++r)rli[r]=__builtin_amdgcn_rcpf(wsf[32+crow(r,hi)]);
  bf16*Ow=O+(rowbase+q0+wid*QBLK)*DMO+h*D;
  { bf16*stg=(bf16*)(shm+LDS_OST)+wid*2048;
    #pragma unroll
    for(int r=0;r<16;++r){const int orow=crow(r,hi);
      #pragma unroll
      for(int d0=0;d0<2;++d0)stg[orow*64+d0*32+r32]=__float2bfloat16(o[d0][r]*rli[r]);}
    asm volatile("s_waitcnt lgkmcnt(0)":::"memory");
    #pragma unroll
    for(int i=0;i<4;++i){const int row=i*8+(lane>>3),ch=lane&7; const u32x4 v=*(const u32x4*)(stg+row*64+ch*8); ATTN_STORE16(Ow+(long)row*DMO+ch*8,v);} }
  asm volatile("s_waitcnt lgkmcnt(0)\n\ts_barrier":::"memory");
  #undef DMA_K
  #undef DMA_V
  #undef CMASK
  #undef START
  #undef RESC
  #undef ROT
}
constexpr int ATTN_LDS_BYTES=LDS_BYTES;
#undef SBAR
#undef WAIT_BAR
}
#define LAS __attribute__((address_space(3)))
typedef unsigned short bf16;
typedef unsigned v4u __attribute__((ext_vector_type(4)));
typedef unsigned v2u __attribute__((ext_vector_type(2)));
typedef float f32x4 __attribute__((ext_vector_type(4)));
typedef float f32x2 __attribute__((ext_vector_type(2)));
typedef short bf16x8 __attribute__((ext_vector_type(8)));

constexpr int NTOK = 32768, DMOD = 1024, SEQL = 16384, PW = 3328, DFF = 2816;
constexpr float ALPHA = 1.681792830507429f;
constexpr size_t MiB = 1u << 20;
constexpr size_t WS_WIN = 0, WS_WOUT = 7 * MiB, WS_WUP = 9 * MiB, WS_WDN = 20 * MiB, WS_WSP = 26 * MiB;
constexpr size_t WS_XN = 32 * MiB, WS_P = 96 * MiB, WS_GH = 304 * MiB, WS_CAT = 432 * MiB;
constexpr size_t WS_GATE = 96 * MiB, WS_VAL = 272 * MiB, WS_U = 96 * MiB, WS_V = 160 * MiB, WS_END = 496 * MiB;
constexpr int LDS_TOTAL = 147456;
constexpr int NTHR = 512;

__device__ __forceinline__ float bflo(unsigned w) { return __uint_as_float(w << 16); }
__device__ __forceinline__ float bfhi(unsigned w) { return __uint_as_float(w & 0xffff0000u); }
__device__ __forceinline__ unsigned f2bf(float f) { unsigned u = __float_as_uint(f); return (u + 0x7fffu + ((u >> 16) & 1u)) >> 16; }
__device__ __forceinline__ unsigned pk2(float lo, float hi) { return f2bf(lo) | (f2bf(hi) << 16); }
__device__ __forceinline__ void unpack8(const v4u w, float* o) { o[0] = bflo(w.x); o[1] = bfhi(w.x); o[2] = bflo(w.y); o[3] = bfhi(w.y); o[4] = bflo(w.z); o[5] = bfhi(w.z); o[6] = bflo(w.w); o[7] = bfhi(w.w); }
__device__ __forceinline__ v4u pack8(const float* o) { v4u w; w.x = pk2(o[0], o[1]); w.y = pk2(o[2], o[3]); w.z = pk2(o[4], o[5]); w.w = pk2(o[6], o[7]); return w; }
__device__ __forceinline__ float wave_sum(float v) {
#pragma unroll
    for (int o = 1; o < 64; o <<= 1) v += __shfl_xor(v, o);
    return v;
}
__device__ __forceinline__ int opaque_tid() { int t = threadIdx.x; asm volatile("" : "+v"(t)); return t; }
#define TIDS const int tid = opaque_tid(), lane = tid & 63, wave = __builtin_amdgcn_readfirstlane(tid >> 6); (void)lane; (void)wave
__device__ __forceinline__ float sigmoidf_(float x) { return 1.f / (1.f + __expf(-x)); }
__device__ __forceinline__ float tanhf_(float x) { const float e = __expf(2.f * x); return 1.f - 2.f / (e + 1.f); }

__device__ __forceinline__ void transpose_item(const float* W, int K, int N, bf16* WT, LAS float* scr, int item, int lane) {
    const int nblk = N / 32, kb = item / nblk, nb = item % nblk, k0 = 64 * kb, n0 = 32 * nb;
#pragma unroll 8
    for (int i = 0; i < 32; ++i) { const int kk = 2 * i + (lane >> 5); scr[kk * 33 + (lane & 31)] = W[(size_t)(k0 + kk) * N + n0 + (lane & 31)]; }
    asm volatile("s_waitcnt lgkmcnt(0)" ::: "memory");
    const int c = lane & 7;
#pragma unroll
    for (int j = 0; j < 4; ++j) { const int n = (lane >> 3) + 8 * j; const LAS float* s = scr + (8 * c) * 33 + n;
        v4u o; o.x = pk2(s[0 * 33], s[1 * 33]); o.y = pk2(s[2 * 33], s[3 * 33]); o.z = pk2(s[4 * 33], s[5 * 33]); o.w = pk2(s[6 * 33], s[7 * 33]);
        *(v4u*)(WT + (size_t)(n0 + n) * K + k0 + 8 * c) = o; }
    asm volatile("s_waitcnt lgkmcnt(0)" ::: "memory");
}

__device__ __forceinline__ int mm_tm(int wave) { return wave < 4 ? (wave >> 1) : 3 - ((wave - 4) >> 1); }
template <int KD, bool TRI  , class FA, class FB>
__device__ __forceinline__ void mm_acc_t(f32x4& c0, f32x4& c1, int wave, int lane, FA fa, FB fb) {
    const int tm = mm_tm(wave), tn0 = (wave & 1) * 2, li = lane & 15, lk = lane >> 4;
    const int kend = TRI ? 16 * (tm + 1) : KD;
#pragma nounroll
    for (int kb = 0; kb < kend; kb += 16) {
#pragma unroll
        for (int k0 = kb; k0 < kb + 16; k0 += 4) {
            const float a = fa(tm * 16 + li, k0 + lk);
            const float b0 = fb(k0 + lk, tn0 * 16 + li);
            const float b1 = fb(k0 + lk, tn0 * 16 + 16 + li);
            c0 = __builtin_amdgcn_mfma_f32_16x16x4f32(a, b0, c0, 0, 0, 0);
            c1 = __builtin_amdgcn_mfma_f32_16x16x4f32(a, b1, c1, 0, 0, 0);
        }
    }
}
template <int KD, class FA, class FB>
__device__ __forceinline__ void mm_acc(f32x4& c0, f32x4& c1, int wave, int lane, FA fa, FB fb) { mm_acc_t<KD, false>(c0, c1, wave, lane, fa, fb); }
template <class FC>
__device__ __forceinline__ void mm_store(const f32x4& c0, const f32x4& c1, int wave, int lane, FC fc) {
    const int tm = mm_tm(wave), tn0 = (wave & 1) * 2, li = lane & 15, lk = lane >> 4;
#pragma unroll
    for (int r = 0; r < 4; ++r) { fc(tm * 16 + 4 * lk + r, tn0 * 16 + li, c0[r]); fc(tm * 16 + 4 * lk + r, tn0 * 16 + 16 + li, c1[r]); }
}
constexpr int LD = 68, BUFF = 64 * LD;
#define RM(B) [=](int i, int k) { return (B)[i * LD + k]; }
#define TR(B) [=](int i, int k) { return (B)[k * LD + i]; }

struct LsRaw { v4u cur, prv; };
__device__ __forceinline__ LsRaw ls_issue(const bf16* P, int tok0, int col0, bool seq_start, int tid) {
    const int row = tid >> 3, c8 = (tid & 7) * 8;
    const bf16* pr = P + (size_t)(tok0 + row) * PW + col0 + c8;
    LsRaw r; r.cur = *(const v4u*)pr; r.prv = (v4u){0u, 0u, 0u, 0u};
    if (!(seq_start && row == 0)) r.prv = *(const v4u*)(pr - PW);
    return r;
}
template <int ACT  >
__device__ __forceinline__ void ls_commit(float* dst, const LsRaw& r, int col0, const float* mu, int tid) {
    const int row = tid >> 3, c8 = (tid & 7) * 8;
    float c[8], p[8]; unpack8(r.cur, c); unpack8(r.prv, p);
    const f32x4 m0 = *(const f32x4*)(mu + col0 + c8), m1 = *(const f32x4*)(mu + col0 + c8 + 4);
    const float m[8] = {m0[0], m0[1], m0[2], m0[3], m1[0], m1[1], m1[2], m1[3]};
    float x[8];
#pragma unroll
    for (int e = 0; e < 8; ++e) { x[e] = c[e] + m[e] * (p[e] - c[e]); if (ACT == 1) x[e] = tanhf_(x[e]); if (ACT == 2) x[e] = sigmoidf_(x[e]); }
    *(f32x4*)(dst + row * LD + c8) = (f32x4){x[0], x[1], x[2], x[3]}; *(f32x4*)(dst + row * LD + c8 + 4) = (f32x4){x[4], x[5], x[6], x[7]};
}
struct WRaw { f32x4 a, b; };
__device__ __forceinline__ WRaw w_issue(const float* W, int ldw, int row0, int col0, int tid) {
    const int row = tid >> 3, c8 = (tid & 7) * 8; const float* s = W + (size_t)(row0 + row) * ldw + col0 + c8;
    WRaw r; r.a = *(const f32x4*)s; r.b = *(const f32x4*)(s + 4); return r;
}
__device__ __forceinline__ void w_commit(float* dst, const WRaw& r, int tid) {
    const int row = tid >> 3, c8 = (tid & 7) * 8; *(f32x4*)(dst + row * LD + c8) = r.a; *(f32x4*)(dst + row * LD + c8 + 4) = r.b;
}
template <int K, class FA, class FB>
__device__ __forceinline__ f32x4 tile_mm(int lane, FA fa, FB fb) {
    const int li = lane & 15, lk = lane >> 4; f32x4 acc = {0.f, 0.f, 0.f, 0.f};
#pragma unroll
    for (int k0 = 0; k0 < K; k0 += 4) acc = __builtin_amdgcn_mfma_f32_16x16x4f32(fa(li, k0 + lk), fb(k0 + lk, li), acc, 0, 0, 0);
    return acc;
}
__device__ __forceinline__ void tri_inverse(float* T, const float* A, float* M, int tid, int wave, int lane) {
    for (int i = tid; i < 64 * LD; i += NTHR) T[i] = 0.f;
    __syncthreads();
    if (tid < 64) { const int d = tid >> 4, j = tid & 15; const float* Ad = A + (16 * d) * LD + 16 * d; float x[16];
#pragma unroll
        for (int t = 0; t < 16; ++t) { float acc = (t == j) ? 1.f : 0.f;
            f32x4 rw[4];
#pragma unroll
            for (int q4 = 0; q4 < 4; ++q4) if (4 * q4 < t) rw[q4] = *(const f32x4*)(Ad + t * LD + 4 * q4);
#pragma unroll
            for (int q = 0; q < t; ++q) acc += rw[q >> 2][q & 3] * x[q];
            x[t] = acc; asm volatile("" ::: "memory"); }
#pragma unroll
        for (int t = 0; t < 16; ++t) T[(16 * d + t) * LD + 16 * d + j] = x[t];
    }
    __syncthreads();
    const int li = lane & 15, lk = lane >> 4;
    if (wave < 2) { const int r0 = 16 * (2 * wave + 1), c0 = 16 * (2 * wave);
        const f32x4 acc = tile_mm<16>(lane, [=](int i, int k) { return A[(r0 + i) * LD + c0 + k]; }, [=](int k, int jj) { return T[(c0 + k) * LD + c0 + jj]; });
#pragma unroll
        for (int r = 0; r < 4; ++r) M[(r0 + 4 * lk + r) * LD + c0 + li] = acc[r]; }
    __syncthreads();
    if (wave < 2) { const int r0 = 16 * (2 * wave + 1), c0 = 16 * (2 * wave);
        const f32x4 acc = tile_mm<16>(lane, [=](int i, int k) { return T[(r0 + i) * LD + r0 + k]; }, [=](int k, int jj) { return M[(r0 + k) * LD + c0 + jj]; });
#pragma unroll
        for (int r = 0; r < 4; ++r) T[(r0 + 4 * lk + r) * LD + c0 + li] = acc[r]; }
    __syncthreads();
    if (wave < 4) { const int r0 = 32 + 16 * (wave >> 1), c0 = 16 * (wave & 1);
        const f32x4 acc = tile_mm<32>(lane, [=](int i, int k) { return A[(r0 + i) * LD + k]; }, [=](int k, int jj) { return T[k * LD + c0 + jj]; });
#pragma unroll
        for (int r = 0; r < 4; ++r) M[(r0 + 4 * lk + r) * LD + c0 + li] = acc[r]; }
    __syncthreads();
    if (wave < 4) { const int r0 = 32 + 16 * (wave >> 1), c0 = 16 * (wave & 1);
        const f32x4 acc = tile_mm<32>(lane, [=](int i, int k) { return T[(r0 + i) * LD + 32 + k]; }, [=](int k, int jj) { return M[(32 + k) * LD + c0 + jj]; });
#pragma unroll
        for (int r = 0; r < 4; ++r) T[(r0 + 4 * lk + r) * LD + c0 + li] = acc[r]; }
    __syncthreads();
}

struct RwkvW { const float *mu, *w0, *w2, *a0, *a2, *g2, *kk, *ka, *rk, *lg, *lb; };

template <bool WITH_R>
__device__ __forceinline__ void rwkv_front(float* sm, const bf16* P, const RwkvW& w, int tok0, int h, bool ss, int tid, int wave, int lane) {
    float *B0 = sm, *B1 = sm + BUFF, *B2 = sm + 2 * BUFF, *B3 = sm + 3 * BUFF, *B4 = sm + 4 * BUFF, *B5 = sm + 5 * BUFF, *B6 = sm + 6 * BUFF, *B7 = sm + 7 * BUFF;
    float* part = sm + 8 * BUFF; float* bon = part + 512 + 64;
    {
        const LsRaw rk = ls_issue(P, tok0, 512 + h * 64, ss, tid), rv = ls_issue(P, tok0, 1024 + h * 64, ss, tid), rxw = ls_issue(P, tok0, 1536, ss, tid), rxa = ls_issue(P, tok0, 1600, ss, tid);
        const WRaw ww = w_issue(w.w2, 512, 0, h * 64, tid), wa = w_issue(w.a2, 512, 0, h * 64, tid);
        ls_commit<0>(B0, rk, 512 + h * 64, w.mu, tid); ls_commit<0>(B1, rv, 1024 + h * 64, w.mu, tid); ls_commit<1>(B2, rxw, 1536, w.mu, tid); ls_commit<0>(B3, rxa, 1600, w.mu, tid);
        w_commit(B4, ww, tid); w_commit(B5, wa, tid);
    }
    LsRaw rr; if (WITH_R) rr = ls_issue(P, tok0, h * 64, ss, tid);
    __syncthreads();
    { f32x4 c0 = {0.f, 0.f, 0.f, 0.f}, c1 = c0; mm_acc<64>(c0, c1, wave, lane, RM(B2), RM(B4));
      const float* w0 = w.w0 + h * 64;
      mm_store(c0, c1, wave, lane, [=](int r, int c, float v) { const float wi = v + w0[c]; const float z = -wi; const float sp = fmaxf(z, 0.f) + __logf(1.f + __expf(-fabsf(z))); B6[r * LD + c] = -__expf(-sp - 0.5f); }); }
    { f32x4 c0 = {0.f, 0.f, 0.f, 0.f}, c1 = c0; mm_acc<64>(c0, c1, wave, lane, RM(B3), RM(B5));
      const float* a0 = w.a0 + h * 64;
      mm_store(c0, c1, wave, lane, [=](int r, int c, float v) { B7[r * LD + c] = sigmoidf_(v + a0[c]); }); }
    __syncthreads();
    if (WITH_R) ls_commit<0>(B4, rr, h * 64, w.mu, tid);
    {
        const int row = tid >> 3, c8 = (tid & 7) * 8;
        float kx[8], kkv[8]; float ssq = 0.f;
#pragma unroll
        for (int e = 0; e < 8; ++e) { kx[e] = B0[row * LD + c8 + e]; kkv[e] = kx[e] * w.kk[h * 64 + c8 + e]; ssq += kkv[e] * kkv[e]; }
        ssq += __shfl_xor(ssq, 1); ssq += __shfl_xor(ssq, 2); ssq += __shfl_xor(ssq, 4);
        const float inv = 1.f / fmaxf(sqrtf(ssq), 1e-12f);
        float bsum = 0.f;
#pragma unroll
        for (int e = 0; e < 8; ++e) { const float al = B7[row * LD + c8 + e]; const float kn = kkv[e] * inv; const float kad = kx[e] * (1.f + (al - 1.f) * w.ka[h * 64 + c8 + e]);
            B2[row * LD + c8 + e] = -kn; B3[row * LD + c8 + e] = kn * al; B0[row * LD + c8 + e] = kad;
            if (WITH_R) bsum += B4[row * LD + c8 + e] * kad * w.rk[h * 64 + c8 + e]; }
        if (WITH_R) { bsum += __shfl_xor(bsum, 1); bsum += __shfl_xor(bsum, 2); bsum += __shfl_xor(bsum, 4); if ((tid & 7) == 0) bon[row] = bsum; }
    }
    {
        const int ch = tid & 63, seg = tid >> 6; float s = 0.f;
#pragma unroll
        for (int i = 0; i < 8; ++i) s += B6[(seg * 8 + i) * LD + ch];
        part[seg * 64 + ch] = s;
    }
    __syncthreads();
    {   const int ch = tid & 63, seg = tid >> 6; float cex = 0.f;
        for (int s = 0; s < seg; ++s) cex += part[s * 64 + ch];
#pragma unroll
        for (int i = 0; i < 8; ++i) { const int t = seg * 8 + i; const float lw = B6[t * LD + ch]; B2[t * LD + ch] *= __expf(cex); cex += lw; B6[t * LD + ch] = cex; }
    }
    __syncthreads();
}

__device__ __forceinline__ void rwkv_phase1(float* sm, const bf16* P, const RwkvW& w, float* GH, int bx, int G) {
    TIDS;
    float *B0 = sm, *B1 = sm + BUFF, *B2 = sm + 2 * BUFF, *B3 = sm + 3 * BUFF, *B4 = sm + 4 * BUFF, *B5 = sm + 5 * BUFF, *B6 = sm + 6 * BUFF, *B7 = sm + 7 * BUFF;
    float* gl = sm + 8 * BUFF + 512;
    for (int unit = bx; unit < 4096; unit += G) {
        const int bh = unit >> 8, c = unit & 255, b = bh >> 3, h = bh & 7, tok0 = b * SEQL + c * 64;
        __syncthreads();
        rwkv_front<false>(sm, P, w, tok0, h, c == 0, tid, wave, lane);
        for (int idx = tid; idx < 4096; idx += NTHR) { const int t = idx >> 6, ch = idx & 63; const float cu = B6[t * LD + ch], cl = B6[63 * LD + ch];
            const float em = __expf(-cu), eh = __expf(cl - cu), bv = B3[t * LD + ch], kv = B0[t * LD + ch];
            B4[t * LD + ch] = bv * em; B5[t * LD + ch] = kv * em; B3[t * LD + ch] = bv * eh; B0[t * LD + ch] = kv * eh; }
        if (tid < 64) gl[tid] = __expf(B6[63 * LD + tid]);
        __syncthreads();
        { f32x4 c0 = {0.f, 0.f, 0.f, 0.f}, c1 = c0; mm_acc<64>(c0, c1, wave, lane, RM(B2), TR(B4)); mm_store(c0, c1, wave, lane, [=](int r, int cc, float v) { B7[r * LD + cc] = (cc < r) ? v : 0.f; }); }
        { f32x4 c0 = {0.f, 0.f, 0.f, 0.f}, c1 = c0; mm_acc<64>(c0, c1, wave, lane, RM(B2), TR(B5)); mm_store(c0, c1, wave, lane, [=](int r, int cc, float v) { B6[r * LD + cc] = (cc < r) ? v : 0.f; }); }
        __syncthreads();
        { f32x4 c0 = {0.f, 0.f, 0.f, 0.f}, c1 = c0; mm_acc_t<64, true>(c0, c1, wave, lane, RM(B6), RM(B1)); mm_store(c0, c1, wave, lane, [=](int r, int cc, float v) { B4[r * LD + cc] = v; }); }
        tri_inverse(B5, B7, B6, tid, wave, lane);
        { f32x4 c0 = {0.f, 0.f, 0.f, 0.f}, c1 = c0; mm_acc_t<64, true>(c0, c1, wave, lane, RM(B5), RM(B2)); mm_store(c0, c1, wave, lane, [=](int r, int cc, float v) { B6[r * LD + cc] = v; }); }
        { f32x4 c0 = {0.f, 0.f, 0.f, 0.f}, c1 = c0; mm_acc_t<64, true>(c0, c1, wave, lane, RM(B5), RM(B4)); mm_store(c0, c1, wave, lane, [=](int r, int cc, float v) { B7[r * LD + cc] = v; }); }
        __syncthreads();
        float* Gg = GH + (size_t)unit * 8192; float* Hg = Gg + 4096;
        { f32x4 c0 = {0.f, 0.f, 0.f, 0.f}, c1 = c0; mm_acc<64>(c0, c1, wave, lane, TR(B6), RM(B3)); mm_store(c0, c1, wave, lane, [=](int r, int cc, float v) { Gg[r * 64 + cc] = v + ((r == cc) ? gl[r] : 0.f); }); }
        { f32x4 c0 = {0.f, 0.f, 0.f, 0.f}, c1 = c0; mm_acc<64>(c0, c1, wave, lane, TR(B7), RM(B3)); mm_acc<64>(c0, c1, wave, lane, TR(B1), RM(B0)); mm_store(c0, c1, wave, lane, [=](int r, int cc, float v) { Hg[r * 64 + cc] = v; }); }
    }
}

__device__ __forceinline__ void rwkv_phase2(float* sm, float* GH, int wg) {
    TIDS;
    const int bh = wg >> 2, rb = wg & 3;
    float* Ss = sm; float* Gs = sm + 16 * LD; float* Hs = Gs + 64 * LD;
    for (int i = tid; i < 16 * LD; i += NTHR) Ss[i] = 0.f;
    float* base = GH + (size_t)(bh * 256) * 8192;
    const int grow = tid >> 3, gc8 = (tid & 7) * 8, hrow = tid >> 5, hc2 = (tid & 31) * 2;
    const size_t goff = (size_t)grow * 64 + gc8, hoff = 4096 + (size_t)(rb * 16 + hrow) * 64 + hc2;
    f32x4 ga[4], gb[4]; f32x2 hv[4];
#pragma unroll
    for (int i = 0; i < 4; ++i) { const float* u = base + (size_t)i * 8192; ga[i] = *(const f32x4*)(u + goff); gb[i] = *(const f32x4*)(u + goff + 4); hv[i] = *(const f32x2*)(u + hoff); }
    const int li = lane & 15, lk = lane >> 4;
    for (int c4 = 0; c4 < 256; c4 += 4) {
#pragma unroll
        for (int i = 0; i < 4; ++i) {
            const int c = c4 + i;
            *(f32x4*)(Gs + grow * LD + gc8) = ga[i]; *(f32x4*)(Gs + grow * LD + gc8 + 4) = gb[i]; *(f32x2*)(Hs + hrow * LD + hc2) = hv[i];
            __syncthreads();
            float* u = base + (size_t)c * 8192;
            if (c + 4 < 256) { const float* un = u + (size_t)4 * 8192; ga[i] = *(const f32x4*)(un + goff); gb[i] = *(const f32x4*)(un + goff + 4); hv[i] = *(const f32x2*)(un + hoff); }
            *(f32x2*)(u + hoff) = *(const f32x2*)(Ss + hrow * LD + hc2);
            f32x4 acc = {0.f, 0.f, 0.f, 0.f};
            if (wave < 4) {
#pragma unroll
                for (int r = 0; r < 4; ++r) acc[r] = Hs[(4 * lk + r) * LD + 16 * wave + li];
#pragma unroll 4
                for (int k0 = 0; k0 < 64; k0 += 4) acc = __builtin_amdgcn_mfma_f32_16x16x4f32(Ss[li * LD + k0 + lk], Gs[(k0 + lk) * LD + 16 * wave + li], acc, 0, 0, 0);
            }
            __syncthreads();
            if (wave < 4) {
#pragma unroll
                for (int r = 0; r < 4; ++r) Ss[(4 * lk + r) * LD + 16 * wave + li] = acc[r];
            }
        }
    }
    __syncthreads();
}

__device__ __forceinline__ void rwkv_phase3(float* sm, const bf16* P, const RwkvW& w, const float* GH, bf16* CAT, int bx, int G) {
    TIDS;
    float *B0 = sm, *B1 = sm + BUFF, *B2 = sm + 2 * BUFF, *B3 = sm + 3 * BUFF, *B4 = sm + 4 * BUFF, *B5 = sm + 5 * BUFF, *B6 = sm + 6 * BUFF, *B7 = sm + 7 * BUFF;
    float* bon = sm + 8 * BUFF + 512 + 64;
    for (int unit = bx; unit < 4096; unit += G) {
        const int bh = unit >> 8, c = unit & 255, b = bh >> 3, h = bh & 7, tok0 = b * SEQL + c * 64; const bool ss = (c == 0);
        __syncthreads();
        rwkv_front<true>(sm, P, w, tok0, h, ss, tid, wave, lane);
        const WRaw s0raw = w_issue(GH + (size_t)unit * 8192 + 4096, 64, 0, 0, tid);
        const LsRaw xg0 = ls_issue(P, tok0, 1664, ss, tid), xg1 = ls_issue(P, tok0, 1728, ss, tid);
        const WRaw g2a = w_issue(w.g2, 512, 0, h * 64, tid), g2b = w_issue(w.g2, 512, 64, h * 64, tid);
        for (int idx = tid; idx < 4096; idx += NTHR) { const int t = idx >> 6, ch = idx & 63; const float cu = B6[t * LD + ch]; const float em = __expf(-cu);
            B5[t * LD + ch] = B3[t * LD + ch] * em; B0[t * LD + ch] *= em; B4[t * LD + ch] *= __expf(cu); }
        __syncthreads();
        { f32x4 c0 = {0.f, 0.f, 0.f, 0.f}, c1 = c0; mm_acc<64>(c0, c1, wave, lane, RM(B2), TR(B5)); mm_store(c0, c1, wave, lane, [=](int r, int cc, float v) { B3[r * LD + cc] = (cc < r) ? v : 0.f; }); }
        { f32x4 c0 = {0.f, 0.f, 0.f, 0.f}, c1 = c0; mm_acc<64>(c0, c1, wave, lane, RM(B2), TR(B0)); mm_store(c0, c1, wave, lane, [=](int r, int cc, float v) { B6[r * LD + cc] = (cc < r) ? v : 0.f; }); }
        { f32x4 c0 = {0.f, 0.f, 0.f, 0.f}, c1 = c0; mm_acc<64>(c0, c1, wave, lane, RM(B4), TR(B5)); mm_store(c0, c1, wave, lane, [=](int r, int cc, float v) { B7[r * LD + cc] = (cc <= r) ? v : 0.f; }); }
        __syncthreads();
        { f32x4 c0 = {0.f, 0.f, 0.f, 0.f}, c1 = c0; mm_acc<64>(c0, c1, wave, lane, RM(B4), TR(B0)); mm_store(c0, c1, wave, lane, [=](int r, int cc, float v) { B5[r * LD + cc] = (cc <= r) ? v : 0.f; }); }
        __syncthreads();
        w_commit(B0, s0raw, tid);
        __syncthreads();
        { f32x4 c0 = {0.f, 0.f, 0.f, 0.f}, c1 = c0; mm_acc<64>(c0, c1, wave, lane, RM(B2), TR(B0)); mm_acc_t<64, true>(c0, c1, wave, lane, RM(B6), RM(B1)); __syncthreads();
          mm_store(c0, c1, wave, lane, [=](int r, int cc, float v) { B2[r * LD + cc] = v; }); }
        __syncthreads();
        f32x4 y0 = {0.f, 0.f, 0.f, 0.f}, y1 = y0;
        mm_acc<64>(y0, y1, wave, lane, RM(B4), TR(B0)); mm_acc_t<64, true>(y0, y1, wave, lane, RM(B5), RM(B1));
        tri_inverse(B6, B3, B0, tid, wave, lane);
        { f32x4 c0 = {0.f, 0.f, 0.f, 0.f}, c1 = c0; mm_acc_t<64, true>(c0, c1, wave, lane, RM(B6), RM(B2)); mm_store(c0, c1, wave, lane, [=](int r, int cc, float v) { B4[r * LD + cc] = v; }); }
        __syncthreads();
        mm_acc_t<64, true>(y0, y1, wave, lane, RM(B7), RM(B4));
        ls_commit<2>(B3, xg0, 1664, w.mu, tid); ls_commit<2>(B5, xg1, 1728, w.mu, tid); w_commit(B0, g2a, tid); w_commit(B2, g2b, tid);
        mm_store(y0, y1, wave, lane, [=](int r, int cc, float v) { B6[r * LD + cc] = v; });
        __syncthreads();
        { f32x4 c0 = {0.f, 0.f, 0.f, 0.f}, c1 = c0; mm_acc<64>(c0, c1, wave, lane, RM(B3), RM(B0)); mm_acc<64>(c0, c1, wave, lane, RM(B5), RM(B2));
          mm_store(c0, c1, wave, lane, [=](int r, int cc, float v) { B4[r * LD + cc] = v; }); }
        __syncthreads();
        {   const int row = tid >> 3, c8 = (tid & 7) * 8; float y[8], s = 0.f;
#pragma unroll
            for (int e = 0; e < 8; ++e) { y[e] = B6[row * LD + c8 + e]; s += y[e]; }
            s += __shfl_xor(s, 1); s += __shfl_xor(s, 2); s += __shfl_xor(s, 4);
            const float mu = s * (1.f / 64.f); float q = 0.f;
#pragma unroll
            for (int e = 0; e < 8; ++e) { y[e] -= mu; q += y[e] * y[e]; }
            q += __shfl_xor(q, 1); q += __shfl_xor(q, 2); q += __shfl_xor(q, 4);
            const float rs = 1.f / sqrtf(q * (1.f / 64.f) + 64e-5f); const float bn = bon[row];
            float o[8];
#pragma unroll
            for (int e = 0; e < 8; ++e) { const int ch = h * 64 + c8 + e; const float yn = y[e] * rs * w.lg[ch] + w.lb[ch]; o[e] = (yn + bn * B1[row * LD + c8 + e]) * B4[row * LD + c8 + e]; }
            *(v4u*)(CAT + (size_t)(tok0 + row) * 1024 + h * 64 + c8) = pack8(o);
        }
    }
}

__device__ __forceinline__ void phase_rope(bf16* P, int bx, int G) {
    TIDS;
    constexpr float INVF[8] = {1.0f, 0.1939227432012558f, 0.03760603070259094f, 0.007292664609849453f, 0.0014142135623842478f, 0.00027424818836152554f, 5.318296098266728e-05f, 1.0313386155758053e-05f};
    for (int it = bx * NTHR + tid; it < NTOK * 16; it += G * NTHR) {
        const int tok = it >> 4, hh = it & 15, s = tok & (SEQL - 1);
        bf16* p = P + (size_t)tok * PW + 1792 + hh * 64;
        float x1[8], x2[8]; unpack8(*(const v4u*)p, x1); unpack8(*(const v4u*)(p + 8), x2);
        const float sc = (hh < 8) ? attn_body::C2 : 1.f;
        float o1[8], o2[8];
#pragma unroll
        for (int d = 0; d < 8; ++d) { const float ang = (float)s * INVF[d]; double rev = (double)ang * 0.15915494309189535; rev -= rint(rev); const float fr = (float)rev;
            const float sn = __builtin_amdgcn_sinf(fr), cs = __builtin_amdgcn_cosf(fr);
            o1[d] = (x1[d] * cs - x2[d] * sn) * sc; o2[d] = (x1[d] * sn + x2[d] * cs) * sc; }
        *(v4u*)p = pack8(o1); *(v4u*)(p + 8) = pack8(o2);
        if (hh < 8) {
#pragma unroll
            for (int q = 2; q < 8; ++q) { float x[8]; unpack8(*(const v4u*)(p + 8 * q), x);
#pragma unroll
                for (int e = 0; e < 8; ++e) x[e] *= sc;
                *(v4u*)(p + 8 * q) = pack8(x); }
        }
    }
}

__device__ __forceinline__ void phase_attn_post(const bf16* OB, bf16* CAT, const float* q1, const float* k1, const float* q2, const float* k2, const float* sg, float lam_init, int bx, int G) {
    TIDS; const int gw = bx * 8 + wave, NGW = G * 8;
    const float d1 = wave_sum(q1[lane] * k1[lane]), d2 = wave_sum(q2[lane] * k2[lane]);
    const float lam = expf(d1) - expf(d2) + lam_init;
    const int h = lane >> 4, d0 = (lane & 15) * 8, vhalf = d0 >> 6, dd = d0 & 63;
    float g[8];
#pragma unroll
    for (int e = 0; e < 8; ++e) g[e] = sg[d0 + e] * (1.f - lam_init);
    for (int tok = gw; tok < NTOK; tok += NGW) {
        const bf16* r = OB + (size_t)tok * 1024;
        float a[8], b[8]; unpack8(*(const v4u*)(r + ((h * 2 + 0) * 2 + vhalf) * 64 + dd), a); unpack8(*(const v4u*)(r + ((h * 2 + 1) * 2 + vhalf) * 64 + dd), b);
        float o[8], q = 0.f;
#pragma unroll
        for (int e = 0; e < 8; ++e) { o[e] = a[e] - lam * b[e]; q += o[e] * o[e]; }
        q += __shfl_xor(q, 1); q += __shfl_xor(q, 2); q += __shfl_xor(q, 4); q += __shfl_xor(q, 8);
        const float rs = 1.f / sqrtf(q * (1.f / 128.f) + 1e-5f);
#pragma unroll
        for (int e = 0; e < 8; ++e) o[e] = o[e] * rs * g[e];
        *(v4u*)(CAT + (size_t)tok * 1024 + 512 + h * 128 + d0) = pack8(o);
    }
}

__device__ __forceinline__ void phase_ln(float* X, bf16* XN, const float* g, const float* b, int bx, int G) {
    TIDS; const int gw = bx * 8 + wave, NGW = G * 8;
    for (int m = gw; m < NTOK; m += NGW) {
        f32x4* xr = (f32x4*)(X + (size_t)m * 1024) + lane;
        f32x4 v[4]; float s = 0.f;
#pragma unroll
        for (int j = 0; j < 4; ++j) { v[j] = xr[64 * j]; s += (v[j][0] + v[j][1]) + (v[j][2] + v[j][3]); }
        const float mean = wave_sum(s) * (1.f / 1024.f); float s2 = 0.f;
#pragma unroll
        for (int j = 0; j < 4; ++j) { v[j] = v[j] - mean; s2 += (v[j][0] * v[j][0] + v[j][1] * v[j][1]) + (v[j][2] * v[j][2] + v[j][3] * v[j][3]); }
        const float rstd = 1.f / sqrtf(wave_sum(s2) * (1.f / 1024.f) + 1e-5f);
        v2u* o8 = (v2u*)(XN + (size_t)m * 1024) + lane;
#pragma unroll
        for (int j = 0; j < 4; ++j) { const f32x4 gg = *(const f32x4*)(g + 4 * lane + 256 * j), bb = *(const f32x4*)(b + 4 * lane + 256 * j);
            const f32x4 o = v[j] * rstd * gg + bb; xr[64 * j] = o; v2u w; w.x = pk2(o[0], o[1]); w.y = pk2(o[2], o[3]); o8[64 * j] = w; }
    }
}
__device__ __forceinline__ void phase_lnv(bf16* V, const float* g, const float* b, int bx, int G) {
    TIDS; const int gw = bx * 8 + wave, NGW = G * 8;
    for (int m = gw; m < NTOK; m += NGW) {
        bf16* r = V + (size_t)m * 1024;
        float x[16]; unpack8(*(const v4u*)(r + lane * 8), x); unpack8(*(const v4u*)(r + 512 + lane * 8), x + 8);
        float s = 0.f;
#pragma unroll
        for (int e = 0; e < 16; ++e) s += x[e];
        const float mean = wave_sum(s) * (1.f / 1024.f); float s2 = 0.f;
#pragma unroll
        for (int e = 0; e < 16; ++e) { x[e] -= mean; s2 += x[e] * x[e]; }
        const float rstd = 1.f / sqrtf(wave_sum(s2) * (1.f / 1024.f) + 1e-5f);
#pragma unroll
        for (int e = 0; e < 16; ++e) { const int col = (e < 8) ? lane * 8 + e : 512 + lane * 8 + (e - 8); x[e] = x[e] * rstd * g[col] + b[col]; }
        *(v4u*)(r + lane * 8) = pack8(x); *(v4u*)(r + 512 + lane * 8) = pack8(x + 8);
    }
}

__device__ __forceinline__ void phase_conv(const bf16* GATE, bf16* VAL, const float* cw, const float* cb, int bx, int G) {
    TIDS;
    constexpr int NCG = DFF / 8, NIT = (NTOK / 16) * NCG;
    for (int it = bx * NTHR + tid; it < NIT; it += G * NTHR) {
        const int rb = it / NCG, c0 = (it % NCG) * 8, t0 = rb * 16;
        float w0[8], w1[8], w2[8], bb[8];
#pragma unroll
        for (int e = 0; e < 8; ++e) { w0[e] = cw[c0 + e]; w1[e] = cw[DFF + c0 + e]; w2[e] = cw[2 * DFF + c0 + e]; bb[e] = cb[c0 + e]; }
        float g1[8], g2[8];
        if ((t0 & (SEQL - 1)) == 0) {
#pragma unroll
            for (int e = 0; e < 8; ++e) { g1[e] = 0.f; g2[e] = 0.f; }
        } else { unpack8(*(const v4u*)(GATE + (size_t)(t0 - 1) * DFF + c0), g1); unpack8(*(const v4u*)(GATE + (size_t)(t0 - 2) * DFF + c0), g2); }
        for (int r = 0; r < 16; ++r) {
            const size_t off = (size_t)(t0 + r) * DFF + c0;
            float gg[8], vv[8], o[8]; unpack8(*(const v4u*)(GATE + off), gg); unpack8(*(const v4u*)(VAL + off), vv);
#pragma unroll
            for (int e = 0; e < 8; ++e) { const float cv = bb[e] + w0[e] * g2[e] + w1[e] * g1[e] + w2[e] * gg[e]; o[e] = cv * sigmoidf_(cv) * vv[e]; g2[e] = g1[e]; g1[e] = gg[e]; }
            *(v4u*)(VAL + off) = pack8(o);
        }
    }
}

__device__ __forceinline__ void phase_mix(unsigned char* ldsb, bf16* U, const bf16* V, const bf16* WSP, const float* bs, int bx, int G) {
    TIDS;
    bf16* Vt = (bf16*)ldsb;
    for (int unit = bx; unit < 2048; unit += G) {
        const int cidx = unit >> 3, g = unit & 7, tok0 = cidx * 128;
        __syncthreads();
        {   const int s = tid >> 2, q = tid & 3;
#pragma unroll
            for (int i = 0; i < 4; ++i) { const v4u w = *(const v4u*)(V + (size_t)(tok0 + s) * 1024 + g * 128 + q * 32 + i * 8); const int d0 = q * 32 + i * 8;
                Vt[(d0 + 0) * 136 + s] = (bf16)(w.x & 0xffffu); Vt[(d0 + 1) * 136 + s] = (bf16)(w.x >> 16); Vt[(d0 + 2) * 136 + s] = (bf16)(w.y & 0xffffu); Vt[(d0 + 3) * 136 + s] = (bf16)(w.y >> 16);
                Vt[(d0 + 4) * 136 + s] = (bf16)(w.z & 0xffffu); Vt[(d0 + 5) * 136 + s] = (bf16)(w.z >> 16); Vt[(d0 + 6) * 136 + s] = (bf16)(w.w & 0xffffu); Vt[(d0 + 7) * 136 + s] = (bf16)(w.w >> 16); }
        }
        __syncthreads();
        f32x4 acc[8];
#pragma unroll
        for (int tn = 0; tn < 8; ++tn) acc[tn] = (f32x4){0.f, 0.f, 0.f, 0.f};
        const int li = lane & 15, lk = lane >> 4, nks = (16 * wave + 15) / 32 + 1;
        for (int ks = 0; ks < nks; ++ks) {
            const bf16x8 a = *(const bf16x8*)(WSP + (size_t)g * 16384 + (16 * wave + li) * 128 + ks * 32 + lk * 8);
#pragma unroll
            for (int tn = 0; tn < 8; ++tn) { const bf16x8 bq = *(const bf16x8*)(Vt + (16 * tn + li) * 136 + ks * 32 + lk * 8); acc[tn] = __builtin_amdgcn_mfma_f32_16x16x32_bf16(a, bq, acc[tn], 0, 0, 0); }
        }
#pragma unroll
        for (int r = 0; r < 4; ++r) { const int t = 16 * wave + 4 * lk + r; const float bias = bs[g * 128 + t];
#pragma unroll
            for (int tn = 0; tn < 8; ++tn) { bf16* up = U + (size_t)(tok0 + t) * 1024 + g * 128 + 16 * tn + li; const float u = __uint_as_float(((unsigned)*up) << 16); *up = (bf16)f2bf(u * (acc[tn][r] + bias)); } }
    }
}

#ifndef PHASE_SEL
#define PHASE_SEL 0xffffffffu
#endif
#define ON(k) (((PHASE_SEL) >> (k)) & 1u)
struct Args { const float* in[34]; float* out; unsigned char* ws; };

__global__ void __launch_bounds__(NTHR, 2) mega_fwd(Args a) {
    extern __shared__ __attribute__((aligned(16))) unsigned char lds[];
    cg::grid_group grid = cg::this_grid();
    const int G = gridDim.x, bx = blockIdx.x;
#ifdef PROBE_MASK
    unsigned long long tacc = 0, tmark = 0;
#define PB(k) do { if ((PROBE_MASK >> (k)) & 1u) tmark = __builtin_amdgcn_s_memrealtime(); } while (0)
#define PE(k) do { if ((PROBE_MASK >> (k)) & 1u) tacc += __builtin_amdgcn_s_memrealtime() - tmark; } while (0)
#else
#define PB(k) do {} while (0)
#define PE(k) do {} while (0)
#endif
    for (int layer = 0; layer < 4; ++layer) {
        const int j = layer >> 1; const bool even = (layer & 1) == 0;
        int z = 0; asm volatile("" : "+s"(z));
        unsigned char* ws = a.ws + z; float* out = a.out + z;
        bf16 *W_in = (bf16*)(ws + WS_WIN), *W_out = (bf16*)(ws + WS_WOUT), *W_up = (bf16*)(ws + WS_WUP), *W_dn = (bf16*)(ws + WS_WDN), *WSP = (bf16*)(ws + WS_WSP);
        bf16 *XN = (bf16*)(ws + WS_XN), *P = (bf16*)(ws + WS_P), *CAT = (bf16*)(ws + WS_CAT), *GATE = (bf16*)(ws + WS_GATE), *VAL = (bf16*)(ws + WS_VAL), *U = (bf16*)(ws + WS_U), *V = (bf16*)(ws + WS_V);
        float* GH = (float*)(ws + WS_GH);
        LAS unsigned char* ldsl = (LAS unsigned char*)lds;
        float* sm = (float*)lds;

        PB(0);
        if (ON(0)) {
            TIDS; const int gw = bx * 8 + wave, NGW = G * 8;
            LAS float* scr = (LAS float*)(ldsl + wave * 16384);
            const float* wi = even ? a.in[1 + z] + (size_t)j * 1024 * 3328 : a.in[19 + z] + (size_t)j * 1024 * 2048;
            const int Nin = even ? 3328 : 2048;
            const float* wo = even ? a.in[18 + z] + (size_t)j * 1024 * 1024 : a.in[25 + z] + (size_t)j * 1024 * 1024;
            const float* wu = a.in[28 + z] + (size_t)layer * 1024 * 5632;
            const float* wd = a.in[31 + z] + (size_t)layer * 2816 * 1024;
            const int I_in = 16 * (Nin / 32), I_out = 16 * 32, I_up = 16 * 176, I_dn = 44 * 32, NIT = I_in + I_out + I_up + I_dn;
            for (int it = gw; it < NIT; it += NGW) {
                int r = it;
                if (r < I_in) { transpose_item(wi, 1024, Nin, W_in, scr, r, lane); continue; } r -= I_in;
                if (r < I_out) { transpose_item(wo, 1024, 1024, W_out, scr, r, lane); continue; } r -= I_out;
                if (r < I_up) { transpose_item(wu, 1024, 5632, W_up, scr, r, lane); continue; } r -= I_up;
                transpose_item(wd, 2816, 1024, W_dn, scr, r, lane);
            }
            if (!even) { const float* wsrc = a.in[23 + z] + (size_t)j * 8 * 128 * 128;
                for (int i = bx * NTHR + tid; i < 8 * 128 * 128; i += G * NTHR) { const int t = (i >> 7) & 127, s = i & 127; WSP[i] = (bf16)f2bf(s <= t ? wsrc[i] : 0.f); } }
            if (layer == 0) { const f32x4* xs = (const f32x4*)a.in[0 + z]; f32x4* xo = (f32x4*)out; v2u* xn = (v2u*)XN;
                for (int i = bx * NTHR + tid; i < NTOK * 1024 / 4; i += G * NTHR) { const f32x4 v = xs[i]; xo[i] = v; v2u w; w.x = pk2(v[0], v[1]); w.y = pk2(v[2], v[3]); xn[i] = w; } }
        }
        grid.sync();
        PE(0);
        if (even) {
            RwkvW rw{a.in[2 + z] + j * 1792, a.in[3 + z] + j * 512, a.in[4 + z] + (size_t)j * 64 * 512, a.in[5 + z] + j * 512, a.in[6 + z] + (size_t)j * 64 * 512, a.in[7 + z] + (size_t)j * 128 * 512,
                     a.in[8 + z] + j * 512, a.in[9 + z] + j * 512, a.in[10 + z] + j * 512, a.in[11 + z] + j * 512, a.in[12 + z] + j * 512};
            PB(1);
            if (ON(1)) {   pg8::Gemm g{XN, W_in, NTOK, 3328, 1024}; pg8::StaticOrder S; S.init(NTOK, 3328, G, bx);
                pg8::EpiBf16<0> E{P, 3328, nullptr, 0, 0, 1.f};
                pg8::gemm_phase<pg8::EpiBf16<0>, pg8::StaticOrder, PG8_ALIGN, PG8_SP2>(ldsl, g, S, E); }
            grid.sync();
            PE(1);
            PB(2);
            if (ON(2)) rwkv_phase1(sm, P, rw, GH, bx, G);
            PB(3);
            if (ON(3)) phase_rope(P, bx, G);
            grid.sync();
            PE(2);
            PE(3);
            PB(4);
            if (ON(4)) if (bx < 64) rwkv_phase2(sm, GH, bx);
            grid.sync();
            PE(4);
            PB(5);
            if (ON(5)) {
                __syncthreads();
                const int nun = (G == 256) ? 8 : (2048 - bx + G - 1) / G;
                for (int i = 0; i < nun; ++i) {
                    int bhv, qb;
                    if (G == 256) { const int vcu = (bx % 8) * (G / 8) + bx / 8, s = vcu & 7, grp = i >> 1; bhv = vcu >> 3; qb = (i & 1) ? (16 * grp + 15 - s) : (16 * grp + s); }
                    else { const int u = bx + i * G; bhv = u & 31; qb = 63 - (u >> 5); }
                    const int b = bhv >> 4, vh = bhv & 15, hd = vh >> 2, cm = (vh >> 1) & 1, vhalf = vh & 1;
                    const attn_body::bf16* Q = (const attn_body::bf16*)(P + 1792 + (hd * 2 + cm) * 64); const attn_body::bf16* K = (const attn_body::bf16*)(P + 2304 + (hd * 2 + cm) * 64);
                    const attn_body::bf16* Vv = (const attn_body::bf16*)(P + 2816 + hd * 128 + vhalf * 64); attn_body::bf16* O = (attn_body::bf16*)(XN + vh * 64);
                    attn_body::attn_unit<8>(b, 0, qb, Q, K, Vv, O, (char*)lds);
                }
            }
            grid.sync();
            PE(5);
            PB(6);
            if (ON(6)) rwkv_phase3(sm, P, rw, GH, CAT, bx, G);
            PB(7);
            if (ON(7)) phase_attn_post(XN, CAT, a.in[13 + z] + j * 64, a.in[14 + z] + j * 64, a.in[15 + z] + j * 64, a.in[16 + z] + j * 64, a.in[17 + z] + j * 128, layer == 0 ? 0.2f : 0.4707130183435842f, bx, G);
            grid.sync();
            PE(6);
            PE(7);
            PB(8);
            if (ON(8)) {   pg8::Gemm g{CAT, W_out, NTOK, 1024, 1024}; pg8::StaticOrder S; S.init(NTOK, 1024, G, bx);
                pg8::EpiResid E{out, 1024, ALPHA};
                pg8::gemm_phase<pg8::EpiResid, pg8::StaticOrder, PG8_ALIGN, PG8_SP2>(ldsl, g, S, E); }
        } else {
            PB(9);
            if (ON(9)) {   pg8::Gemm g{XN, W_in, NTOK, 2048, 1024}; pg8::StaticOrder S; S.init(NTOK, 2048, G, bx);
                pg8::EpiBf16<1> E{U, 1024, a.in[20 + z] + j * 2048, 1024, (size_t)(WS_V - WS_U) / 2, 1.f};
                pg8::gemm_phase<pg8::EpiBf16<1>, pg8::StaticOrder, PG8_ALIGN, PG8_SP2>(ldsl, g, S, E); }
            grid.sync();
            PE(9);
            PB(10);
            if (ON(10)) phase_lnv(V, a.in[21 + z] + j * 1024, a.in[22 + z] + j * 1024, bx, G);
            grid.sync();
            PE(10);
            PB(11);
            if (ON(11)) phase_mix(lds, U, V, WSP, a.in[24 + z] + j * 1024, bx, G);
            grid.sync();
            PE(11);
            PB(12);
            if (ON(12)) {   pg8::Gemm g{U, W_out, NTOK, 1024, 1024}; pg8::StaticOrder S; S.init(NTOK, 1024, G, bx);
                pg8::EpiResid E{out, 1024, ALPHA};
                pg8::gemm_phase<pg8::EpiResid, pg8::StaticOrder, PG8_ALIGN, PG8_SP2>(ldsl, g, S, E); }
        }
        grid.sync();
        if (even) PE(8); else PE(12);
        PB(13);
        if (ON(13)) phase_ln(out, XN, a.in[26 + z] + layer * 1024, a.in[27 + z] + layer * 1024, bx, G);
        grid.sync();
        PE(13);
        PB(14);
        if (ON(14)) {   pg8::Gemm g{XN, W_up, NTOK, 5632, 1024}; pg8::StaticOrder S; S.init(NTOK, 5632, G, bx);
            pg8::EpiBf16<0> E{GATE, 2816, nullptr, 2816, (size_t)(WS_VAL - WS_GATE) / 2, 1.f};
            pg8::gemm_phase<pg8::EpiBf16<0>, pg8::StaticOrder, PG8_ALIGN, PG8_SP2>(ldsl, g, S, E); }
        grid.sync();
        PE(14);
        PB(15);
        if (ON(15)) phase_conv(GATE, VAL, a.in[29 + z] + (size_t)layer * 3 * DFF, a.in[30 + z] + layer * DFF, bx, G);
        grid.sync();
        PE(15);
        PB(16);
        if (ON(16)) {   pg8::Gemm g{VAL, W_dn, NTOK, 1024, 2816}; pg8::StaticOrder S; S.init(NTOK, 1024, G, bx);
            pg8::EpiResid E{out, 1024, ALPHA};
            pg8::gemm_phase<pg8::EpiResid, pg8::StaticOrder, PG8_ALIGN, PG8_SP2>(ldsl, g, S, E); }
        grid.sync();
        PE(16);
        PB(17);
        if (ON(17)) phase_ln(out, XN, a.in[32 + z] + layer * 1024, a.in[33 + z] + layer * 1024, bx, G);
        grid.sync();
        PE(17);
    }
#ifdef PROBE_MASK
    if (bx == 0 && threadIdx.x == 0) { const unsigned long long t0 = __builtin_amdgcn_s_memrealtime(); while (__builtin_amdgcn_s_memrealtime() - t0 < 4ull * tacc) __builtin_amdgcn_s_sleep(8); }
#endif
}

extern "C" void kernel_launch(void* const* d_in, const int* in_sizes, int n_in, void* d_out, int out_size, void* d_ws, size_t ws_size, hipStream_t stream) {
    static int grid = 0;
    if (grid == 0) {
        if (n_in != 34 || out_size != NTOK * 1024 || ws_size < WS_END) { fprintf(stderr, "kernel_launch: unexpected shapes (n_in %d out %d ws %zu)\n", n_in, out_size, ws_size); grid = -1; return; }
        int dev = 0, cus = 0, per_cu = 0;
        hipGetDevice(&dev); hipDeviceGetAttribute(&cus, hipDeviceAttributeMultiprocessorCount, dev);
        if (hipFuncSetAttribute((const void*)mega_fwd, hipFuncAttributeMaxDynamicSharedMemorySize, LDS_TOTAL) != hipSuccess) { fprintf(stderr, "kernel_launch: hipFuncSetAttribute failed\n"); grid = -1; return; }
        if (hipOccupancyMaxActiveBlocksPerMultiprocessor(&per_cu, (const void*)mega_fwd, NTHR, LDS_TOTAL) != hipSuccess || per_cu < 1) per_cu = 1;
        (void)hipGetLastError();
        grid = cus * per_cu;
        fprintf(stderr, "kernel_launch: grid %d (cus %d x %d)\n", grid, cus, per_cu);
    }
    if (grid < 0) return;
    Args a{};
    for (int i = 0; i < 34; ++i) a.in[i] = (const float*)d_in[i];
    a.out = (float*)d_out; a.ws = (unsigned char*)d_ws;
    void* args[] = {&a};
    hipError_t e = hipLaunchCooperativeKernel((const void*)mega_fwd, dim3(grid), dim3(NTHR), args, LDS_TOTAL, stream);
    if (e != hipSuccess) fprintf(stderr, "kernel_launch: cooperative launch failed: %s (grid %d)\n", hipGetErrorString(e), grid);
}
```

```cpp
#include <hip/hip_runtime.h>
#include <hip/hip_cooperative_groups.h>
#include <cstdio>
#include <cstdint>
namespace cg = cooperative_groups;
namespace pg8 {
#define PG8_LAS __attribute__((address_space(3)))
typedef unsigned short bf16_t;
typedef short bf16x8 __attribute__((ext_vector_type(8)));
typedef float f32x4 __attribute__((ext_vector_type(4)));
typedef unsigned u32x4 __attribute__((ext_vector_type(4)));
constexpr int BM = 256, BK = 64, HALF = 128, HTB = HALF * BK * 2  , STAGE_BYTES = 8 * HTB, NXCD = 8, WGM = 8;

__host__ __device__ __forceinline__ int lds_byte(int r, int c) { const int st = (r >> 4) * 2 + (c >> 5), rr = r & 15, cc = c & 31, ob = rr * 64 + cc * 2; return st * 1024 + (ob ^ (((ob >> 9) & 1) << 5)); }
__host__ __device__ __forceinline__ void stage_rc(int b, int& R, int& C) { const int st = b / 1024, sb = b % 1024, swz = sb ^ (((sb >> 9) & 1) << 5); R = (st >> 1) * 16 + swz / 64; C = (st & 1) * 32 + (swz % 64) / 2; }
__host__ __device__ __forceinline__ int perm32(int rho) { const int n = rho >> 4, i = rho & 15; return 8 * (i >> 2) + 4 * n + (i & 3); }

struct Unit { int pm, pn; };
struct Gemm { const bf16_t* A; const bf16_t* Bt; int M, N, K; };

struct StaticOrder {
    int nM, nN, nwg, G, c;
    __host__ __device__ void init(int M, int N, int G_, int c_) { nM = M / BM; nN = N / BM; nwg = nM * nN; G = G_; c = c_; }
    __host__ __device__ bool next(int i, Unit& u) const {
        const long L = (long)i * G + c; if (L >= nwg) return false;
        int wgid = (int)L; { const int q = nwg / NXCD, r = nwg % NXCD, xcd = wgid % NXCD, off = wgid / NXCD; wgid = (xcd < r ? xcd * (q + 1) : r * (q + 1) + (xcd - r) * q) + off; }
        const int nig = WGM * nN, gid = wgid / nig, fm = gid * WGM, gsz = (nM - fm) < WGM ? (nM - fm) : WGM;
        u.pm = fm + ((wgid % nig) % gsz); u.pn = (wgid % nig) / gsz; return true;
    }
    __device__ __forceinline__ void a_ready(const Unit&) const {}
    __device__ __forceinline__ void done(const Unit&) const {}
};

__device__ __forceinline__ unsigned cvt_pk_bf16(float lo, float hi) { unsigned r; asm volatile("v_cvt_pk_bf16_f32 %0, %1, %2" : "=v"(r) : "v"(lo), "v"(hi)); return r; }
typedef float f32x2 __attribute__((ext_vector_type(2)));
__device__ __forceinline__ f32x2 gelu_pk(f32x2 v) {
    const f32x2 av = __builtin_elementwise_abs(v), d = av * 0.2316418882f + 1.0f;
    f32x2 t; t.x = __builtin_amdgcn_rcpf(d.x); t.y = __builtin_amdgcn_rcpf(d.y);
    f32x2 q = t * 0.5307027145f + (-0.7265760135f); q = q * t + 0.7107068705f; q = q * t + (-0.142248368f); q = q * t + 0.127414796f; q = q * t;
    const f32x2 s = (v * v) * (-0.72134752044f);
    f32x2 e; e.x = __builtin_amdgcn_exp2f(s.x); e.y = __builtin_amdgcn_exp2f(s.y);
    const f32x2 m = v * (q * e), r = v - m;
    f32x2 o; o.x = v.x < 0.f ? m.x : r.x; o.y = v.y < 0.f ? m.y : r.y; return o;
}

template <int ACT  > struct EpiBf16 {
    static constexpr bool PERM = true, AFTER_DRAIN = false; static_assert(ACT == 0 || ACT == 1, "EpiBf16: ACT is 0 (none) or 1 (gelu_pk)");
    bf16_t* O; int ldc; const float* bias; int split_cols; size_t split_stride; float scale0;
    __device__ __forceinline__ void operator()(const f32x4 (&acc)[2][2][4][2], const Unit& u, int wr, int wc, int fr, int fq) const {
        const int row0 = u.pm * BM + wr * 64 + fr; int colt = u.pn * BM; bf16_t* base = O;
        float sc = 1.f; if (split_cols) { const int t = colt / split_cols; base += (size_t)t * split_stride; colt -= t * split_cols; if (t == 0) sc = scale0; }
        const int col0 = colt + wc * 32 + 8 * fq, bcol0 = u.pn * BM + wc * 32 + 8 * fq;
        f32x4 bv[2][2];
#pragma unroll
        for (int bj = 0; bj < 2; ++bj)
#pragma unroll
            for (int n = 0; n < 2; ++n) bv[bj][n] = bias ? *(const f32x4*)(bias + bcol0 + bj * HALF + 4 * n) : (f32x4){0.f, 0.f, 0.f, 0.f};
#pragma unroll
        for (int ai = 0; ai < 2; ++ai)
#pragma unroll
            for (int m = 0; m < 4; ++m) { bf16_t* rowp = base + (size_t)(row0 + ai * HALF + m * 16) * ldc + col0;
#pragma unroll
                for (int bj = 0; bj < 2; ++bj) { f32x4 v0 = acc[ai][bj][m][0] + bv[bj][0], v1 = acc[ai][bj][m][1] + bv[bj][1];
                    if (ACT == 1) { f32x2 a = gelu_pk((f32x2){v0[0], v0[1]}), b = gelu_pk((f32x2){v0[2], v0[3]}), c = gelu_pk((f32x2){v1[0], v1[1]}), d = gelu_pk((f32x2){v1[2], v1[3]});
                        v0 = (f32x4){a.x, a.y, b.x, b.y}; v1 = (f32x4){c.x, c.y, d.x, d.y}; }
                    v0 = v0 * sc; v1 = v1 * sc; u32x4 w; w.x = cvt_pk_bf16(v0[0], v0[1]); w.y = cvt_pk_bf16(v0[2], v0[3]); w.z = cvt_pk_bf16(v1[0], v1[1]); w.w = cvt_pk_bf16(v1[2], v1[3]);
                    *(u32x4*)(rowp + bj * HALF) = w; } }
    }
};

struct PanelStats {
    unsigned* xbuf;
    unsigned* cnt;
    unsigned* tmo;
    int ntn; float eps;
    unsigned code;
    __device__ __forceinline__ bool run(const f32x4 (&v)[2][2][4][2], const Unit& u, int wr, int wc, int fr, int fq, PG8_LAS unsigned char* lds, int wid, int lane) const {
        typedef float f32x2v __attribute__((ext_vector_type(2)));
        PG8_LAS f32x2v* P = (PG8_LAS f32x2v*)lds;
        PG8_LAS f32x2v* S = (PG8_LAS f32x2v*)(lds + 8192);
        PG8_LAS unsigned* flag = (PG8_LAS unsigned*)(lds + 8192 + 2048);
#pragma unroll
        for (int ai = 0; ai < 2; ++ai)
#pragma unroll
            for (int m = 0; m < 4; ++m) {
                float s = 0.f;
#pragma unroll
                for (int bj = 0; bj < 2; ++bj)
#pragma unroll
                    for (int n = 0; n < 2; ++n) { const f32x4 x = v[ai][bj][m][n]; s += (x[0] + x[1]) + (x[2] + x[3]); }
                s += __shfl_xor(s, 16); s += __shfl_xor(s, 32);
                const float mw = s * (1.0f / 64.0f); float q = 0.f;
#pragma unroll
                for (int bj = 0; bj < 2; ++bj)
#pragma unroll
                    for (int n = 0; n < 2; ++n) { const f32x4 d = v[ai][bj][m][n] - mw; q += (d[0] * d[0] + d[1] * d[1]) + (d[2] * d[2] + d[3] * d[3]); }
                q += __shfl_xor(q, 16); q += __shfl_xor(q, 32);
                if (fq == 0) P[(ai * HALF + wr * 64 + m * 16 + fr) * 4 + wc] = (f32x2v){mw, q};
            }
        asm volatile("s_waitcnt lgkmcnt(0)" ::: "memory"); __builtin_amdgcn_s_barrier(); asm volatile("" ::: "memory");
#if defined(BROKEN_EXCHANGE_NO_WAIT)
#warning BROKEN CONTROL BUILD: the row-statistics exchange does not wait; results are wrong by design
        if (blockIdx.x >= 64) { const long long t0_ = clock64(); while (clock64() - t0_ < 60000) __builtin_amdgcn_s_sleep(8); }
#endif
        const int row = wid * 32 + (lane & 31);
        if (lane < 32) {
            const f32x2v a = P[row * 4 + 0], b = P[row * 4 + 1], c = P[row * 4 + 2], d = P[row * 4 + 3];
            const float mt = (a.x + b.x + c.x + d.x) * 0.25f;
            const float da = a.x - mt, db = b.x - mt, dc = c.x - mt, dd = d.x - mt;
            const float m2 = (a.y + b.y) + (c.y + d.y) + 64.0f * ((da * da + db * db) + (dc * dc + dd * dd));
            unsigned long long* slot = (unsigned long long*)xbuf + ((size_t)(u.pm * BM + row) * 4 + u.pn);
            __hip_atomic_store(slot, ((unsigned long long)__float_as_uint(m2) << 32) | __float_as_uint(mt), __ATOMIC_RELAXED, __HIP_MEMORY_SCOPE_AGENT);
        }
        asm volatile("s_waitcnt vmcnt(0)" ::: "memory");
        if (lane == 0) __hip_atomic_fetch_add(cnt + 64 * u.pm, 1u, __ATOMIC_RELAXED, __HIP_MEMORY_SCOPE_AGENT);
        if (wid == 0) {
            bool dead = false; const unsigned long long t0 = __builtin_amdgcn_s_memrealtime(); const unsigned want = 8u * (unsigned)ntn;
            for (;;) {
#if defined(BROKEN_EXCHANGE_NO_WAIT)
                break;
#endif
                if ((unsigned)__builtin_amdgcn_readfirstlane(__hip_atomic_load(cnt + 64 * u.pm, __ATOMIC_RELAXED, __HIP_MEMORY_SCOPE_AGENT)) >= want) break;
                if (__builtin_amdgcn_s_memrealtime() - t0 > 2000000ull) {
                    if (lane == 0) { unsigned expect = 0u; __hip_atomic_compare_exchange_strong(tmo + 1, &expect, code | (unsigned)(u.pm & 0xff), __ATOMIC_RELAXED, __ATOMIC_RELAXED, __HIP_MEMORY_SCOPE_AGENT);
                                     __hip_atomic_store(tmo, 1u, __ATOMIC_RELAXED, __HIP_MEMORY_SCOPE_AGENT); }
                    dead = true; break; }
                __builtin_amdgcn_s_sleep(2);
            }
            __builtin_amdgcn_fence(__ATOMIC_ACQUIRE, "agent");
            if (lane == 0) flag[0] = dead ? 1u : 0u;
        }
        asm volatile("s_waitcnt vmcnt(0) lgkmcnt(0)" ::: "memory"); __builtin_amdgcn_s_barrier(); asm volatile("" ::: "memory");
        const bool bad = flag[0] != 0u;
        if (lane < 32) {
            const unsigned long long* slot = (const unsigned long long*)xbuf + (size_t)(u.pm * BM + row) * 4; float mt[4], m2[4]; float ms = 0.f;
#pragma unroll
            for (int t = 0; t < 4; ++t) { if (t < ntn) { const unsigned long long w = __hip_atomic_load(slot + t, __ATOMIC_RELAXED, __HIP_MEMORY_SCOPE_AGENT); mt[t] = __uint_as_float((unsigned)w); m2[t] = __uint_as_float((unsigned)(w >> 32)); } else { mt[t] = 0.f; m2[t] = 0.f; } ms += mt[t]; }
            const float mean = ms / (float)ntn; float q = 0.f;
#pragma unroll
            for (int t = 0; t < 4; ++t) if (t < ntn) { const float dm = mt[t] - mean; q += m2[t] + 256.0f * dm * dm; }
            S[row] = (f32x2v){mean, 1.0f / sqrtf(q / (256.0f * (float)ntn) + eps)};
        }
        asm volatile("s_waitcnt lgkmcnt(0)" ::: "memory"); __builtin_amdgcn_s_barrier(); asm volatile("" ::: "memory");
        return bad;
    }
};
struct EpiLnRes {
    static constexpr bool PERM = false, AFTER_DRAIN = true;
    const float* base; float* out; int ldc; const float* bias; PanelStats st; unsigned poison;
    __device__ __forceinline__ void fused(f32x4 (&acc)[2][2][4][2], const Unit& u, int wr, int wc, int fr, int fq, PG8_LAS unsigned char* lds, int wid, int lane) const {
        typedef float f32x2v __attribute__((ext_vector_type(2)));
        const PG8_LAS f32x2v* S = (const PG8_LAS f32x2v*)(lds + 8192);
        const int col0 = u.pn * BM + wc * 32 + 4 * fq;
#pragma unroll
        for (int bj = 0; bj < 2; ++bj)
#pragma unroll
            for (int n = 0; n < 2; ++n) { const f32x4 bv = bias ? *(const f32x4*)(bias + col0 + bj * HALF + n * 16) : (f32x4){0.f, 0.f, 0.f, 0.f};
#pragma unroll
                for (int ai = 0; ai < 2; ++ai)
#pragma unroll
                    for (int m = 0; m < 4; ++m) acc[ai][bj][m][n] += bv; }
        f32x4 pre[4][2][2];
#pragma unroll
        for (int m = 0; m < 4; ++m) { const size_t off = (size_t)(u.pm * BM + wr * 64 + m * 16 + fr) * ldc + col0;
#pragma unroll
            for (int bj = 0; bj < 2; ++bj)
#pragma unroll
                for (int n = 0; n < 2; ++n) pre[m][bj][n] = *(const f32x4*)(base + off + bj * HALF + n * 16); }
        const bool bad = st.run(acc, u, wr, wc, fr, fq, lds, wid, lane) || poison != 0u;
        const float qnan = __builtin_nanf("");
#pragma unroll
        for (int ai = 0; ai < 2; ++ai)
#pragma unroll
            for (int m = 0; m < 4; ++m) { const int r = ai * HALF + wr * 64 + m * 16 + fr; const f32x2v sr = S[r]; const size_t off = (size_t)(u.pm * BM + r) * ldc + col0;
#pragma unroll
                for (int bj = 0; bj < 2; ++bj)
#pragma unroll
                    for (int n = 0; n < 2; ++n) { const f32x4 bs = ai == 0 ? pre[m][bj][n] : *(const f32x4*)(base + off + bj * HALF + n * 16); f32x4 o = bs + (acc[ai][bj][m][n] - sr.x) * sr.y;
                        if (bad) o = (f32x4){qnan, qnan, qnan, qnan}; *(f32x4*)(out + off + bj * HALF + n * 16) = o; }
                if (m & 1) asm volatile("" ::: "memory"); }
    }
};
struct EpiLnResLn {
    static constexpr bool PERM = false, AFTER_DRAIN = true;
    const float* base; float* out; bf16_t* xn; int ldc; const float* bias; PanelStats st1, st2; unsigned poison;
    __device__ __forceinline__ void fused(f32x4 (&acc)[2][2][4][2], const Unit& u, int wr, int wc, int fr, int fq, PG8_LAS unsigned char* lds, int wid, int lane) const {
        typedef float f32x2v __attribute__((ext_vector_type(2))); typedef unsigned u32x2v __attribute__((ext_vector_type(2)));
        const PG8_LAS f32x2v* S = (const PG8_LAS f32x2v*)(lds + 8192);
        const int col0 = u.pn * BM + wc * 32 + 4 * fq;
#pragma unroll
        for (int bj = 0; bj < 2; ++bj)
#pragma unroll
            for (int n = 0; n < 2; ++n) { const f32x4 bv = bias ? *(const f32x4*)(bias + col0 + bj * HALF + n * 16) : (f32x4){0.f, 0.f, 0.f, 0.f};
#pragma unroll
                for (int ai = 0; ai < 2; ++ai)
#pragma unroll
                    for (int m = 0; m < 4; ++m) acc[ai][bj][m][n] += bv; }
        bool bad = st1.run(acc, u, wr, wc, fr, fq, lds, wid, lane) || poison != 0u;
        const float qnan = __builtin_nanf("");
#pragma unroll
        for (int ai = 0; ai < 2; ++ai)
#pragma unroll
            for (int m = 0; m < 4; ++m) { const int r = ai * HALF + wr * 64 + m * 16 + fr; const f32x2v sr = S[r]; const size_t off = (size_t)(u.pm * BM + r) * ldc + col0;
#pragma unroll
                for (int bj = 0; bj < 2; ++bj)
#pragma unroll
                    for (int n = 0; n < 2; ++n) { const f32x4 bs = *(const f32x4*)(base + off + bj * HALF + n * 16); acc[ai][bj][m][n] = bs + (acc[ai][bj][m][n] - sr.x) * sr.y; }
                asm volatile("" : "+v"(acc[ai][0][m][0]), "+v"(acc[ai][0][m][1]), "+v"(acc[ai][1][m][0]), "+v"(acc[ai][1][m][1]));
                if (m & 1) asm volatile("" ::: "memory"); }
        const bool bad1 = bad;
        bad = st2.run(acc, u, wr, wc, fr, fq, lds, wid, lane) || bad;
#pragma unroll
        for (int ai = 0; ai < 2; ++ai)
#pragma unroll
            for (int m = 0; m < 4; ++m) { const int r = ai * HALF + wr * 64 + m * 16 + fr; const f32x2v sr = S[r]; const size_t off = (size_t)(u.pm * BM + r) * ldc + col0;
#pragma unroll
                for (int bj = 0; bj < 2; ++bj)
#pragma unroll
                    for (int n = 0; n < 2; ++n) { const f32x4 x1 = acc[ai][bj][m][n]; *(f32x4*)(out + off + bj * HALF + n * 16) = bad1 ? (f32x4){qnan, qnan, qnan, qnan} : x1;
                        const f32x4 o = (x1 - sr.x) * sr.y; u32x2v w; w.x = cvt_pk_bf16(o[0], o[1]); w.y = cvt_pk_bf16(o[2], o[3]);
                        if (bad) { w.x = 0x7fc07fc0u; w.y = 0x7fc07fc0u; } *(u32x2v*)(xn + off + bj * HALF + n * 16) = w; }
                asm volatile("" ::: "memory"); }
    }
};

template <class Epi, class Sched, bool ALIGN_EPI = false, bool SP2 = false>
__device__ __forceinline__ void gemm_phase(PG8_LAS unsigned char* lds, const Gemm g, const Sched& S, const Epi& E) {
    int tid_ = threadIdx.x; asm volatile("" : "+v"(tid_));
    const int tid = tid_, wid = __builtin_amdgcn_readfirstlane(tid >> 6), lane = tid & 63, wr = wid >> 2, wc = wid & 3, fr = lane & 15, fq = lane >> 4;
    const int K = g.K, nt = K / BK;
    unsigned voffA[2], voffB[2];
#pragma unroll
    for (int i = 0; i < 2; ++i) { int R, C; stage_rc(tid * 16 + i * 8192, R, C); const int Rb = Epi::PERM ? ((R & ~31) + perm32(R & 31)) : R;
        voffA[i] = (unsigned)(R * K + C) * 2u; voffB[i] = (unsigned)(Rb * K + C) * 2u; }
    const size_t kstep = (size_t)(BK * 2);
    const size_t hstep = (size_t)HALF * K * 2;
    const size_t tstep = 2 * hstep;
    const unsigned ldsw = (unsigned)wid * 1024u;
    const int aoff = lds_byte(wr * 64 + fr, fq * 8), boff = lds_byte(wc * 32 + fr, fq * 8);
#define PG8_SA(b, h) (((b) * 2 + (h)) * HTB)
#define PG8_SB(b, h) ((4 + (b) * 2 + (h)) * HTB)
#define PG8_STAGE(bufoff, gbase, voff) do { _Pragma("unroll") for (int _i = 0; _i < 2; ++_i) \
        __builtin_amdgcn_global_load_lds((const unsigned*)((const char*)(gbase) + (voff)[_i]), (PG8_LAS unsigned*)(lds + (bufoff) + ldsw + _i * 8192), 16, 0, 0); } while (0)
#define PG8_LDA(dst, b, h) do { _Pragma("unroll") for (int m = 0; m < 4; ++m) _Pragma("unroll") for (int k = 0; k < 2; ++k) dst[m][k] = *(const PG8_LAS bf16x8*)(lds + PG8_SA(b, h) + aoff + m * 2048 + k * 1024); } while (0)
#define PG8_LDB(dst, b, h) do { _Pragma("unroll") for (int n = 0; n < 2; ++n) _Pragma("unroll") for (int k = 0; k < 2; ++k) dst[n][k] = *(const PG8_LAS bf16x8*)(lds + PG8_SB(b, h) + boff + n * 2048 + k * 1024); } while (0)
#define PG8_MMA(ai, bj, At, Bt) do { __builtin_amdgcn_s_setprio(1); _Pragma("unroll") for (int m = 0; m < 4; ++m) _Pragma("unroll") for (int n = 0; n < 2; ++n) _Pragma("unroll") for (int k = 0; k < 2; ++k) \
        acc[ai][bj][m][n] = __builtin_amdgcn_mfma_f32_16x16x32_bf16(Bt[n][k], At[m][k], acc[ai][bj][m][n], 0, 0, 0); __builtin_amdgcn_s_setprio(0); } while (0)
#define PG8_WAIT_V(n) asm volatile("s_waitcnt vmcnt(" #n ")" ::: "memory")
#define PG8_WAIT_L(n) asm volatile("s_waitcnt lgkmcnt(" #n ")" ::: "memory")
#define PG8_BAR __builtin_amdgcn_s_barrier()
#define PG8_SCHED __builtin_amdgcn_sched_barrier(0)
    Unit cur, nxt; int ui = 0;
    if (!S.next(0, cur)) return;
    f32x4 acc[2][2][4][2];
#pragma unroll
    for (int a = 0; a < 2; ++a)
#pragma unroll
        for (int b = 0; b < 2; ++b)
#pragma unroll
            for (int m = 0; m < 4; ++m)
#pragma unroll
                for (int n = 0; n < 2; ++n) acc[a][b][m][n] = (f32x4){0.f, 0.f, 0.f, 0.f};
    bf16x8 At[4][2], B0[2][2], B1[2][2];
    const char* cA = (const char*)g.A + (size_t)cur.pm * tstep; const char* cB = (const char*)g.Bt + (size_t)cur.pn * tstep;
    S.a_ready(cur);
    if constexpr (SP2) {
        PG8_STAGE(PG8_SB(0, 0), cB, voffB); PG8_STAGE(PG8_SB(0, 1), cB + hstep, voffB); PG8_STAGE(PG8_SA(0, 0), cA, voffA); PG8_STAGE(PG8_SA(0, 1), cA + hstep, voffA);
        if (wr == 1) PG8_BAR;
        PG8_WAIT_V(2); PG8_BAR;
        PG8_STAGE(PG8_SB(1, 0), cB + kstep, voffB); PG8_STAGE(PG8_SA(1, 0), cA + kstep, voffA); PG8_STAGE(PG8_SB(1, 1), cB + hstep + kstep, voffB);
        PG8_WAIT_V(6); PG8_BAR;
    } else {
        PG8_STAGE(PG8_SB(0, 0), cB, voffB); PG8_STAGE(PG8_SA(0, 0), cA, voffA); PG8_STAGE(PG8_SB(0, 1), cB + hstep, voffB); PG8_STAGE(PG8_SA(0, 1), cA + hstep, voffA);
        if (wr == 1) PG8_BAR;
        PG8_WAIT_V(4); PG8_BAR;
        PG8_STAGE(PG8_SB(1, 0), cB + kstep, voffB); PG8_STAGE(PG8_SA(1, 0), cA + kstep, voffA); PG8_STAGE(PG8_SB(1, 1), cB + hstep + kstep, voffB);
        PG8_WAIT_V(6); PG8_BAR;
    }
    for (;;) {
        const bool has_next = S.next(ui + 1, nxt);
        const char* nA = has_next ? (const char*)g.A + (size_t)nxt.pm * tstep : cA; const char* nB = has_next ? (const char*)g.Bt + (size_t)nxt.pn * tstep : cB;
        for (int t = 0; t < nt; t += 2) {
            const bool last = (t == nt - 2);
            const char* a1 = cA + (size_t)(t + 1) * kstep;
            const char* a2 = last ? nA : cA + (size_t)(t + 2) * kstep; const char* b2 = last ? nB : cB + (size_t)(t + 2) * kstep;
            const char* a3 = a2 + kstep; const char* b3 = b2 + kstep;
            if (last && has_next) S.a_ready(nxt);
            if constexpr (SP2) {
            PG8_LDB(B0, 0, 0); PG8_LDB(B1, 0, 1); PG8_SCHED; PG8_LDA(At, 0, 0); PG8_STAGE(PG8_SA(1, 1), a1 + hstep, voffA);
            PG8_WAIT_V(8); PG8_WAIT_L(0); PG8_BAR; PG8_MMA(0, 0, At, B0); PG8_MMA(0, 1, At, B1); PG8_BAR; PG8_SCHED;
            PG8_LDA(At, 0, 1); PG8_STAGE(PG8_SB(0, 0), b2, voffB); PG8_STAGE(PG8_SB(0, 1), b2 + hstep, voffB); PG8_STAGE(PG8_SA(0, 0), a2, voffA);
            PG8_WAIT_V(8); PG8_WAIT_L(0); PG8_BAR; PG8_MMA(1, 0, At, B0); PG8_MMA(1, 1, At, B1); PG8_BAR; PG8_SCHED;
            PG8_LDB(B0, 1, 0); PG8_LDB(B1, 1, 1); PG8_SCHED; PG8_LDA(At, 1, 0); PG8_STAGE(PG8_SA(0, 1), a2 + hstep, voffA);
            PG8_WAIT_V(8); PG8_WAIT_L(0); PG8_BAR; PG8_MMA(0, 0, At, B0); PG8_MMA(0, 1, At, B1); PG8_BAR; PG8_SCHED;
            PG8_LDA(At, 1, 1); PG8_STAGE(PG8_SB(1, 0), b3, voffB); PG8_STAGE(PG8_SB(1, 1), b3 + hstep, voffB); PG8_STAGE(PG8_SA(1, 0), a3, voffA);
            PG8_WAIT_V(8); PG8_WAIT_L(0); PG8_BAR; PG8_MMA(1, 0, At, B0); PG8_MMA(1, 1, At, B1); PG8_BAR; PG8_SCHED;
            } else {
            PG8_LDB(B0, 0, 0); PG8_SCHED; PG8_LDA(At, 0, 0); PG8_STAGE(PG8_SA(1, 1), a1 + hstep, voffA);
            PG8_WAIT_L(8); PG8_BAR; PG8_WAIT_L(0); PG8_MMA(0, 0, At, B0); PG8_BAR; PG8_SCHED;
            PG8_LDB(B1, 0, 1); PG8_STAGE(PG8_SB(0, 0), b2, voffB);
            PG8_BAR; PG8_WAIT_L(0); PG8_MMA(0, 1, At, B1); PG8_BAR;
            PG8_LDA(At, 0, 1); PG8_STAGE(PG8_SA(0, 0), a2, voffA);
            PG8_BAR; PG8_WAIT_L(0); PG8_MMA(1, 0, At, B0); PG8_BAR; PG8_SCHED;
            PG8_STAGE(PG8_SB(0, 1), b2 + hstep, voffB);
            PG8_WAIT_V(6); PG8_BAR; PG8_MMA(1, 1, At, B1); PG8_BAR;
            PG8_LDB(B0, 1, 0); PG8_SCHED; PG8_LDA(At, 1, 0); PG8_STAGE(PG8_SA(0, 1), a2 + hstep, voffA);
            PG8_WAIT_L(8); PG8_BAR; PG8_WAIT_L(0); PG8_MMA(0, 0, At, B0); PG8_BAR; PG8_SCHED;
            PG8_LDB(B1, 1, 1); PG8_STAGE(PG8_SB(1, 0), b3, voffB);
            PG8_BAR; PG8_WAIT_L(0); PG8_MMA(0, 1, At, B1); PG8_BAR;
            PG8_LDA(At, 1, 1); PG8_STAGE(PG8_SA(1, 0), a3, voffA);
            PG8_BAR; PG8_WAIT_L(0); PG8_MMA(1, 0, At, B0); PG8_BAR; PG8_SCHED;
            PG8_STAGE(PG8_SB(1, 1), b3 + hstep, voffB);
            PG8_WAIT_V(6); PG8_BAR; PG8_MMA(1, 1, At, B1); PG8_BAR;
            }
        }
        if constexpr (ALIGN_EPI) { if (wr == 0) PG8_BAR; }
        if constexpr (!Epi::AFTER_DRAIN) { E(acc, cur, wr, wc, fr, fq); S.done(cur); }
        if (!has_next) break;
#pragma unroll
        for (int a = 0; a < 2; ++a)
#pragma unroll
            for (int b = 0; b < 2; ++b)
#pragma unroll
                for (int m = 0; m < 4; ++m)
#pragma unroll
                    for (int n = 0; n < 2; ++n) acc[a][b][m][n] = (f32x4){0.f, 0.f, 0.f, 0.f};
        cur = nxt; cA = nA; cB = nB; ++ui;
        if constexpr (ALIGN_EPI) { if (wr == 1) PG8_BAR; }
    }
    PG8_WAIT_V(0);
    if constexpr (!ALIGN_EPI) { if (wr == 0) PG8_BAR; }
    PG8_BAR;
    if constexpr (Epi::AFTER_DRAIN) { E.fused(acc, cur, wr, wc, fr, fq, lds, wid, lane); S.done(cur); }
#undef PG8_SA
#undef PG8_SB
#undef PG8_STAGE
#undef PG8_LDA
#undef PG8_LDB
#undef PG8_MMA
#undef PG8_WAIT_V
#undef PG8_WAIT_L
#undef PG8_BAR
#undef PG8_SCHED
}
}
namespace pg8 {
struct EpiResid {
    static constexpr bool PERM = false, AFTER_DRAIN = false;
    float* x; int ldc; float alpha;
    __device__ __forceinline__ void operator()(const f32x4 (&acc)[2][2][4][2], const Unit& u, int wr, int wc, int fr, int fq) const {
        const int col0 = u.pn * BM + wc * 32 + 4 * fq;
#pragma unroll
        for (int ai = 0; ai < 2; ++ai)
#pragma unroll
            for (int m = 0; m < 4; ++m) { const int r = ai * HALF + wr * 64 + m * 16 + fr; const size_t off = (size_t)(u.pm * BM + r) * ldc + col0;
#pragma unroll
                for (int bj = 0; bj < 2; ++bj)
#pragma unroll
                    for (int n = 0; n < 2; ++n) { float* p = x + off + bj * HALF + n * 16; f32x4 v = *(const f32x4*)p; v = v * alpha + acc[ai][bj][m][n]; *(f32x4*)p = v; }
                if (m & 1) asm volatile("" ::: "memory"); }
    }
};
}
#define PG8_SP2 true
#define PG8_ALIGN true
#include <hip/hip_bf16.h>
#include <cmath>
namespace attn_body {
using bf16=__hip_bfloat16;
using bf16x8=__attribute__((ext_vector_type(8)))short;
using s16x4=__attribute__((ext_vector_type(4)))short;
using f32x16=__attribute__((ext_vector_type(16)))float;
using u32x4=__attribute__((ext_vector_type(4)))unsigned;
constexpr int BATCH=2,NHEAD=16,SEQ=16384,D=64,DM=3328,DMO=1024;
constexpr int NW=8,QBLK=32,QB=QBLK*NW,KVBLK=64,NQB=SEQ/QB;
constexpr int ATTN_PITCH=DM, ATTN_UNIT_ROWS=QB;
__device__ __forceinline__ int crow(int r,int hi){return (r&3)+8*(r>>2)+4*hi;}
#define SBAR() __builtin_amdgcn_sched_barrier(0)
__device__ __forceinline__ void cmask(f32x16&p0,f32x16&p1,int jb,int qrel,int hi){
  const float NEG=-INFINITY; int kb=64*jb+4*hi;
  #pragma unroll
  for(int r=0;r<16;++r){int kv=kb+(r&3)+8*(r>>2); if(kv>qrel)p0[r]=NEG; if(kv+32>qrel)p1[r]=NEG;}
}

constexpr int NSLOT=3, SLOTB=8192;
constexpr int LDS_K=0, LDS_V=NSLOT*SLOTB, LDS_WS=2*NSLOT*SLOTB, LDS_OST=LDS_WS+NW*64*4, LDS_BYTES=LDS_OST+NW*4096;
constexpr float C2=0.125f*1.4426950408889634f;
__device__ __forceinline__ void glds16(const void*gsrc,unsigned lds_dst){unsigned keep;
  asm volatile("s_mov_b32 %0, m0\n\ts_mov_b32 m0, %2\n\ts_nop 0\n\tglobal_load_lds_dwordx4 %1, off\n\ts_mov_b32 m0, %0":"=&s"(keep):"v"(gsrc),"s"(lds_dst):"memory");}
__device__ __forceinline__ float max3f(float a,float b,float c){float r;asm("v_max3_f32 %0, %1, %2, %3":"=v"(r):"v"(a),"v"(b),"v"(c));return r;}
__device__ __forceinline__ float max2f(float a,float b){float r;asm("v_max_f32_e32 %0, %1, %2":"=v"(r):"v"(a),"v"(b));return r;}
__device__ __forceinline__ float fadd_s(float a,float b){float r;asm("v_add_f32_e32 %0, %1, %2":"=v"(r):"v"(a),"v"(b));return r;}
__device__ __forceinline__ float fsub_s(float a,float b){float r;asm("v_sub_f32_e32 %0, %1, %2":"=v"(r):"v"(a),"v"(b));return r;}
typedef float f32x2_t __attribute__((ext_vector_type(2))); typedef __bf16 bf16x2_t __attribute__((ext_vector_type(2)));
__device__ __forceinline__ unsigned cvtpk_s(float lo,float hi){f32x2_t v={lo,hi};bf16x2_t b=__builtin_convertvector(v,bf16x2_t);return __builtin_bit_cast(unsigned,b);}
#define WAIT_BAR(N) asm volatile("s_waitcnt vmcnt(" #N ") lgkmcnt(0)\n\ts_barrier":::"memory")

__device__ __forceinline__ void qkt(f32x16&p0,f32x16&p1,const char*Kslot,const bf16x8*qr,const f32x16&negm,int r32,int hi){
  const char*kb=Kslot+hi*1024+r32*16;
  #pragma unroll
  for(int d0=0;d0<4;++d0){
    const bf16x8 b0=*reinterpret_cast<const bf16x8*>(kb+d0*2048);
    const bf16x8 b1=*reinterpret_cast<const bf16x8*>(kb+d0*2048+512);
    if(d0==0){p0=__builtin_amdgcn_mfma_f32_32x32x16_bf16(b0,qr[0],negm,0,0,0);p1=__builtin_amdgcn_mfma_f32_32x32x16_bf16(b1,qr[0],negm,0,0,0);}
    else{p0=__builtin_amdgcn_mfma_f32_32x32x16_bf16(b0,qr[d0],p0,0,0,0);p1=__builtin_amdgcn_mfma_f32_32x32x16_bf16(b1,qr[d0],p1,0,0,0);}}
}
typedef __attribute__((address_space(3))) const char* lds_cptr;
typedef short v4i16_t __attribute__((ext_vector_type(4)));
__device__ __forceinline__ void kload8(bf16x8*kf,lds_cptr kp){
  kf[0]=*(const __attribute__((address_space(3))) bf16x8*)(kp);      kf[1]=*(const __attribute__((address_space(3))) bf16x8*)(kp+512);
  kf[2]=*(const __attribute__((address_space(3))) bf16x8*)(kp+2048); kf[3]=*(const __attribute__((address_space(3))) bf16x8*)(kp+2560);
  kf[4]=*(const __attribute__((address_space(3))) bf16x8*)(kp+4096); kf[5]=*(const __attribute__((address_space(3))) bf16x8*)(kp+4608);
  kf[6]=*(const __attribute__((address_space(3))) bf16x8*)(kp+6144); kf[7]=*(const __attribute__((address_space(3))) bf16x8*)(kp+6656);
}
__device__ __forceinline__ void kload2(bf16x8*kf,lds_cptr kp,int j){ kf[2*j]=*(const __attribute__((address_space(3))) bf16x8*)(kp+j*2048); kf[2*j+1]=*(const __attribute__((address_space(3))) bf16x8*)(kp+j*2048+512); }
__device__ __forceinline__ s16x4 vtr(lds_cptr p){ return __builtin_bit_cast(s16x4,__builtin_amdgcn_ds_read_tr16_b64_v4i16((__attribute__((address_space(3))) v4i16_t*)p)); }
__device__ __forceinline__ float rowmax(const f32x16&p0,const f32x16&p1){
  float a=max3f(p0[0],p0[1],p1[0]),b=max3f(p0[2],p0[3],p1[1]);a=max3f(a,p1[2],p1[3]);
  #pragma unroll
  for(int r=4;r<16;r+=4){a=max3f(a,p0[r],p0[r+1]);b=max3f(b,p0[r+2],p0[r+3]);a=max3f(a,p1[r],p1[r+1]);b=max3f(b,p1[r+2],p1[r+3]);}
  const float m=max2f(a,b);
  auto rr=__builtin_amdgcn_permlane32_swap(__float_as_uint(m),__float_as_uint(m),false,false);
  return max2f(__uint_as_float(rr[0]),__uint_as_float(rr[1]));
}
__device__ __forceinline__ void pv(f32x16*o,int vb,bf16x8 pa0,bf16x8 pa1,bf16x8 pa2,bf16x8 pa3){
  #pragma unroll
  for(int d0=0;d0<2;++d0){s16x4 lo[4],hi[4];
    #pragma unroll
    for(int ks=0;ks<4;++ks){
      asm volatile("ds_read_b64_tr_b16 %0,%1 offset:%c2":"=&v"(lo[ks]):"v"(vb),"i"(d0*4096+ks*1024):"memory");
      asm volatile("ds_read_b64_tr_b16 %0,%1 offset:%c2":"=&v"(hi[ks]):"v"(vb),"i"(d0*4096+ks*1024+512):"memory");}
    asm volatile("s_waitcnt lgkmcnt(0)":::"memory");SBAR();
    #define PK(k) (bf16x8){lo[k][0],lo[k][1],lo[k][2],lo[k][3],hi[k][0],hi[k][1],hi[k][2],hi[k][3]}
    o[d0]=__builtin_amdgcn_mfma_f32_32x32x16_bf16(pa0,PK(0),o[d0],0,0,0);
    o[d0]=__builtin_amdgcn_mfma_f32_32x32x16_bf16(pa1,PK(1),o[d0],0,0,0);
    o[d0]=__builtin_amdgcn_mfma_f32_32x32x16_bf16(pa2,PK(2),o[d0],0,0,0);
    o[d0]=__builtin_amdgcn_mfma_f32_32x32x16_bf16(pa3,PK(3),o[d0],0,0,0);
    #undef PK
  }
}

#ifndef ATTN_STORE16
#define ATTN_STORE16(p,v) (*(u32x4*)(p)=(v))
#endif
template<int THRL> __device__ __forceinline__ void attn_unit(int b,int h,int qb,const bf16*Q,const bf16*__restrict__ K,const bf16*__restrict__ V,bf16*O,char*shm){
  int tid_=threadIdx.x; asm volatile("":"+v"(tid_)); const int tid=tid_,lane=tid&63,r32=lane&31,hi=lane>>5; const int wid=__builtin_amdgcn_readfirstlane(tid>>6);
  const long rowbase=(long)b*SEQ; const int q0=qb*QB;
  const bf16*Qw=Q+(rowbase+q0+wid*QBLK)*DM+h*D;
  const bf16*Kh=K+rowbase*DM+h*D,*Vh=V+rowbase*DM+h*D;
  const unsigned lds0=(unsigned)(uintptr_t)shm;
  float*wsf=(float*)(shm+LDS_WS)+wid*64;
  const bf16*ksrc=Kh+(long)lane*DM+wid*8;
  const bf16*vsrc=Vh+(long)(16*(wid&3)+(lane>>2))*DM+(wid>>2)*32+(lane&3)*8;
  const unsigned kdst=lds0+LDS_K+wid*1024, vdst=lds0+LDS_V+wid*1024;
  #define DMA_K(t,slot) glds16(ksrc+(long)(t)*KVBLK*DM,(unsigned)__builtin_amdgcn_readfirstlane(kdst+(slot)))
  #define DMA_V(t,slot) glds16(vsrc+(long)(t)*KVBLK*DM,(unsigned)__builtin_amdgcn_readfirstlane(vdst+(slot)))
  const int vb0=(int)(lds0+LDS_V)+((lane>>4)&1)*32+(lane&3)*8+(4*hi+((lane&15)>>2))*64;
  const char*Kbase=shm+LDS_K; bf16x8 kf[8];
  const lds_cptr shm3=(lds_cptr)shm; const lds_cptr kp0=shm3+LDS_K+hi*1024+r32*16; const lds_cptr vp0=shm3+LDS_V+((lane>>4)&1)*32+(lane&3)*8+(4*hi+((lane&15)>>2))*64;
  const int NT=(q0+QB)/KVBLK;
  DMA_K(0,0);DMA_V(0,0);DMA_K(1,SLOTB);
  bf16x8 qr[4];
  #pragma unroll
  for(int d0=0;d0<4;++d0)qr[d0]=*reinterpret_cast<const bf16x8*>(&Qw[(long)r32*DM+d0*16+hi*8]);
  float mhat=0.f,l_reg=0.f;f32x16 o[2];o[0]=f32x16{};o[1]=f32x16{};f32x16 negm=f32x16{};asm volatile("":"+v"(negm));
  const int qrel=wid*QBLK+r32;
  #define CMASK(P0,P1,t) do{int jb_=(t)-(NT-4); if(jb_>=0)cmask(P0,P1,jb_,qrel,hi);}while(0)
  bool resc=false;
  #define START(P0,P1) do{ const float rm=rowmax(P0,P1); resc=false; \
    { const float dl=rm; mhat=fadd_s(mhat,dl); \
      _Pragma("unroll") for(int r=0;r<16;++r){P0[r]=fsub_s(P0[r],dl);P1[r]=fsub_s(P1[r],dl);} \
      _Pragma("unroll") for(int r=0;r<16;++r)negm[r]=-mhat; asm volatile("":"+v"(negm)); } \
    _Pragma("unroll") for(int r=0;r<16;++r)P0[r]=__builtin_amdgcn_exp2f(P0[r]); }while(0)
  #define RESC() do{ if(resc){ asm volatile("s_waitcnt lgkmcnt(0)":::"memory"); \
      _Pragma("unroll") for(int d_=0;d_<2;++d_) _Pragma("unroll") for(int r=0;r<16;++r)o[d_][r]*=wsf[crow(r,hi)]; } }while(0)
  f32x16 pA0,pA1,pB0,pB1;
  int sl_prev=0,sl_cur=0,sl_next=SLOTB;
  #define ROT() do{sl_prev=sl_cur;sl_cur=sl_next;sl_next=(sl_next==(NSLOT-1)*SLOTB)?0:sl_next+SLOTB;}while(0)
  DMA_K(2,2*SLOTB);
  WAIT_BAR(3);
  qkt(pA0,pA1,Kbase,qr,negm,r32,hi);asm volatile("s_nop 15\n\ts_nop 7":"+v"(pA0),"+v"(pA1));CMASK(pA0,pA1,0);
  START(pA0,pA1);
  _Pragma("unroll") for(int r=0;r<16;++r)pA1[r]=__builtin_amdgcn_exp2f(pA1[r]);
  WAIT_BAR(0);
  DMA_K(3,0);DMA_V(1,SLOTB);
  ROT();
  kload8(kf,kp0+sl_cur);
  WAIT_BAR(2);
  s16x4 vlo[8],vhi[8]; u32x4 pw0,pw1,pw2,pw3;
  #define PKW(P,B) cvtpk_s(P[B],P[B+1])
  #define PAF(k) __builtin_bit_cast(bf16x8,pw##k)
  #define VFR(i) (bf16x8){vlo[i][0],vlo[i][1],vlo[i][2],vlo[i][3],vhi[i][0],vhi[i][1],vhi[i][2],vhi[i][3]}
  #define PIN(x) asm volatile("":"+v"(x))
  #define MX3(a,b,c) __builtin_fmaxf(__builtin_fmaxf((a),(b)),(c))
  #define GAPA(MF,A0,A1,A2,A3,W0,W1,PW) do{ MF; sacc+=A0; sacc+=A1; sacc+=A2; sacc+=A3; PIN(sacc); W0; W1; PIN(PW); SBAR(); }while(0)
  #define EX(v) __builtin_amdgcn_exp2f(v)
  #define GAPB(MF,X,B) do{ MF; X[B]=EX(X[B]); X[B+1]=EX(X[B+1]); X[B+2]=EX(X[B+2]); X[B+3]=EX(X[B+3]); PIN(X); SBAR(); }while(0)
  #define VRD(i) do{ vlo[i]=vtr(vp_+(((i)>>2)*4096+((i)&3)*1024)); vhi[i]=vtr(vp_+(((i)>>2)*4096+((i)&3)*1024+512)); }while(0)
  #define KRD(G,j) do{ if(G){ kload2(kf,kp0+sl_next,j); SBAR(); } }while(0)
  #define STEP(C0,C1,P0,P1,t,GK,GV,GL) do{ SBAR(); \
    const lds_cptr vp_=vp0+sl_prev; \
    VRD(0); SBAR(); float sacc=(P0[0]+P0[1]); \
    GAPA(C0=__builtin_amdgcn_mfma_f32_32x32x16_bf16(kf[0],qr[0],negm,0,0,0), P0[2],P0[3],P0[4],P0[5],     pw0[0]=PKW(P0,0), pw0[1]=PKW(P0,2), pw0); \
    VRD(4); SBAR(); GAPA(C1=__builtin_amdgcn_mfma_f32_32x32x16_bf16(kf[1],qr[0],negm,0,0,0), P0[6],P0[7],P0[8],P0[9],     pw0[2]=PKW(P0,4), pw0[3]=PKW(P0,6), pw0); \
    VRD(1); SBAR(); GAPA(C0=__builtin_amdgcn_mfma_f32_32x32x16_bf16(kf[2],qr[1],C0,0,0,0),   P0[10],P0[11],P0[12],P0[13], pw1[0]=PKW(P0,8), pw1[1]=PKW(P0,10), pw1); \
    VRD(5); SBAR(); GAPA(C1=__builtin_amdgcn_mfma_f32_32x32x16_bf16(kf[3],qr[1],C1,0,0,0),   P0[14],P0[15],P1[0],P1[1],   pw1[2]=PKW(P0,12),pw1[3]=PKW(P0,14), pw1); \
    VRD(2); SBAR(); GAPA(C0=__builtin_amdgcn_mfma_f32_32x32x16_bf16(kf[4],qr[2],C0,0,0,0),   P1[2],P1[3],P1[4],P1[5],     pw2[0]=PKW(P1,0), pw2[1]=PKW(P1,2), pw2); \
    VRD(6); SBAR(); GAPA(C1=__builtin_amdgcn_mfma_f32_32x32x16_bf16(kf[5],qr[2],C1,0,0,0),   P1[6],P1[7],P1[8],P1[9],     pw2[2]=PKW(P1,4), pw2[3]=PKW(P1,6), pw2); \
    VRD(3); SBAR(); GAPA(C0=__builtin_amdgcn_mfma_f32_32x32x16_bf16(kf[6],qr[3],C0,0,0,0),   P1[10],P1[11],P1[12],P1[13], pw3[0]=PKW(P1,8), pw3[1]=PKW(P1,10), pw3); \
    VRD(7); SBAR(); GAPA(C1=__builtin_amdgcn_mfma_f32_32x32x16_bf16(kf[7],qr[3],C1,0,0,0),   P1[14],P1[15],0.f,0.f,       pw3[2]=PKW(P1,12),pw3[3]=PKW(P1,14), pw3); \
    l_reg+=sacc; \
    if(GK){DMA_K((t)+3,sl_cur);} if(GV){DMA_V((t)+1,sl_next);} \
    CMASK(C0,C1,t); \
    { float a=MX3(C0[0],C0[1],C1[0]),b=MX3(C0[2],C0[3],C1[1]); a=MX3(a,C1[2],C1[3]); \
      _Pragma("unroll") for(int r=4;r<16;r+=4){a=MX3(a,C0[r],C0[r+1]);b=MX3(b,C0[r+2],C0[r+3]);a=MX3(a,C1[r],C1[r+1]);b=MX3(b,C1[r+2],C1[r+3]);} \
      float rm=__builtin_fmaxf(a,b); { auto rr=__builtin_amdgcn_permlane32_swap(__float_as_uint(rm),__float_as_uint(rm),false,false); rm=__builtin_fmaxf(__uint_as_float(rr[0]),__uint_as_float(rr[1])); } \
      resc=false; \
      if(__builtin_expect(__any(rm>(float)THRL),0)){ const float dl=__builtin_fmaxf(rm,0.f); mhat+=dl; \
        _Pragma("unroll") for(int r=0;r<16;++r){C0[r]-=dl;C1[r]-=dl;} \
        _Pragma("unroll") for(int r=0;r<16;++r)negm[r]=-mhat; asm volatile("":"+v"(negm)); \
        const float f=__builtin_amdgcn_exp2f(-dl); l_reg*=f; if(hi==0)wsf[r32]=f; resc=true; } } \
    SBAR(); \
    GAPB(o[0]=__builtin_amdgcn_mfma_f32_32x32x16_bf16(PAF(0),VFR(0),o[0],0,0,0), C0,0); \
    GAPB(o[1]=__builtin_amdgcn_mfma_f32_32x32x16_bf16(PAF(0),VFR(4),o[1],0,0,0), C0,4); \
    KRD(GL,0); GAPB(o[0]=__builtin_amdgcn_mfma_f32_32x32x16_bf16(PAF(1),VFR(1),o[0],0,0,0), C0,8); \
    KRD(GL,1); GAPB(o[1]=__builtin_amdgcn_mfma_f32_32x32x16_bf16(PAF(1),VFR(5),o[1],0,0,0), C0,12); \
    KRD(GL,2); GAPB(o[0]=__builtin_amdgcn_mfma_f32_32x32x16_bf16(PAF(2),VFR(2),o[0],0,0,0), C1,0); \
    KRD(GL,3); GAPB(o[1]=__builtin_amdgcn_mfma_f32_32x32x16_bf16(PAF(2),VFR(6),o[1],0,0,0), C1,4); \
    GAPB(o[0]=__builtin_amdgcn_mfma_f32_32x32x16_bf16(PAF(3),VFR(3),o[0],0,0,0), C1,8); \
    GAPB(o[1]=__builtin_amdgcn_mfma_f32_32x32x16_bf16(PAF(3),VFR(7),o[1],0,0,0), C1,12); \
    }while(0)
  int t=1;
  #undef CMASK
  #define CMASK(P0,P1,t) do{}while(0)
  for(;t+5<NT;t+=2){
    STEP(pB0,pB1,pA0,pA1,t,true,true,true);     WAIT_BAR(2); RESC(); ROT();
    STEP(pA0,pA1,pB0,pB1,t+1,true,true,true);   WAIT_BAR(2); RESC(); ROT();
  }
  #undef CMASK
  #define CMASK(P0,P1,t) do{int jb_=(t)-(NT-4); if(jb_>=0)cmask(P0,P1,jb_,qrel,hi);}while(0)
  #define ENDW(tt) do{ if((tt)+3<NT){WAIT_BAR(2);} else if((tt)+2<NT){WAIT_BAR(1);} else {WAIT_BAR(0);} }while(0)
  for(;t+1<NT;t+=2){
    STEP(pB0,pB1,pA0,pA1,t,(t+3<NT),(t+1<NT),(t+1<NT));       ENDW(t);   RESC(); ROT();
    STEP(pA0,pA1,pB0,pB1,t+1,(t+4<NT),(t+2<NT),(t+2<NT));     ENDW(t+1); RESC(); ROT();
  }
  STEP(pB0,pB1,pA0,pA1,NT-1,false,false,false); RESC();
  { float sacc=pB0[0]+pB0[1]; _Pragma("unroll") for(int r=2;r<16;++r)sacc+=pB0[r]; _Pragma("unroll") for(int r=0;r<16;++r)sacc+=pB1[r]; l_reg+=sacc;
    pw0=(u32x4){PKW(pB0,0),PKW(pB0,2),PKW(pB0,4),PKW(pB0,6)};pw1=(u32x4){PKW(pB0,8),PKW(pB0,10),PKW(pB0,12),PKW(pB0,14)};pw2=(u32x4){PKW(pB1,0),PKW(pB1,2),PKW(pB1,4),PKW(pB1,6)};pw3=(u32x4){PKW(pB1,8),PKW(pB1,10),PKW(pB1,12),PKW(pB1,14)};
    SBAR(); pv(o,vb0+sl_cur,PAF(0),PAF(1),PAF(2),PAF(3)); }
  #undef PKW
  #undef PAF
  #undef VFR
  #undef PIN
  #undef MX3
  #undef GAPA
  #undef GAPB
  #undef EX
  #undef VRD
  #undef KRD
  #undef STEP
  #undef ENDW
  {auto rr=__builtin_amdgcn_permlane32_swap(__float_as_uint(l_reg),__float_as_uint(l_reg),false,false);l_reg=__uint_as_float(rr[0])+__uint_as_float(rr[1]);}
  if(hi==0)wsf[32+r32]=l_reg;asm volatile("s_waitcnt lgkmcnt(0)":::"memory");
  float rli[16];
  #pragma unroll
  for(int r=0;r<16;++r)rli[r]=__builtin_amdgcn_rcpf(wsf[32+crow(r,hi)]);
  bf16*Ow=O+(rowbase+q0+wid*QBLK)*DMO+h*D;
  { bf16*stg=(bf16*)(shm+LDS_OST)+wid*2048;
    #pragma unroll
    for(int r=0;r<16;++r){const int orow=crow(r,hi);
      #pragma unroll
      for(int d0=0;d0<2;++d0)stg[orow*64+d0*32+r32]=__float2bfloat16(o[d0][r]*rli[r]);}
    asm volatile("s_waitcnt lgkmcnt(0)":::"memory");
    #pragma unroll
    for(int i=0;i<4;++i){const int row=i*8+(lane>>3),ch=lane&7; const u32x4 v=*(const u32x4*)(stg+row*64+ch*8); ATTN_STORE16(Ow+(long)row*DMO+ch*8,v);} }
  asm volatile("s_waitcnt lgkmcnt(0)\n\ts_barrier":::"memory");
  #undef DMA_K
  #undef DMA_V
  #undef CMASK
  #undef START
  #undef RESC
  #undef ROT
}
constexpr int ATTN_LDS_BYTES=LDS_BYTES;
#undef SBAR
#undef WAIT_BAR
}
#define LAS __attribute__((address_space(3)))
#define XB_TMO      128
#define XB_XCNT(j)  (256  + 64 * (j))
#define XB_XSUB(j)  (1280 + 64 * (j))
#define XB_XGEN(j)  (2304 + 64 * (j))
#define XB_TOP      3328
#define XB_TOPGEN   3392
#define XCD_BAR_WORDS 3456
#define XB_SPIN_CAP (1u << 18)

__device__ __forceinline__ unsigned xb_ld(unsigned* p)              { return __hip_atomic_load(p, __ATOMIC_RELAXED, __HIP_MEMORY_SCOPE_AGENT); }
__device__ __forceinline__ unsigned xb_add(unsigned* p, unsigned v) { return __hip_atomic_fetch_add(p, v, __ATOMIC_RELAXED, __HIP_MEMORY_SCOPE_AGENT); }
__device__ __forceinline__ unsigned xb_xcc_id() { return (unsigned)__builtin_amdgcn_s_getreg((3 << 11) | 20) & 0xFu; }
#define XB_SPIN(cond, bar) do { unsigned _sp = 0; while (cond) { __builtin_amdgcn_s_sleep(1); \
    if ((++_sp & 255u) == 0u) { if (xb_ld(&(bar)[XB_TMO])) break; if (_sp > XB_SPIN_CAP) { atomicAdd(&(bar)[XB_TMO], 1u); break; } } } } while (0)

struct XcdBarrier {
    unsigned* bar; unsigned x;
    volatile LAS unsigned* st;
};

__device__ __forceinline__ XcdBarrier xcd_barrier_post(unsigned* bar, volatile LAS unsigned* st) {
    XcdBarrier b; b.bar = bar; b.x = xb_xcc_id(); b.st = st;
    if (threadIdx.x == 0) (void)xb_add(&bar[XB_XCNT(b.x)], 1u);
    return b;
}
__device__ __forceinline__ void xcd_barrier_complete(unsigned* bar, unsigned x, unsigned& nloc, unsigned& nx) {
    const unsigned G = gridDim.x * gridDim.y * gridDim.z;
    unsigned sum, cnt, mine, sp = 0u;
    for (;;) {
        sum = 0u; cnt = 0u; mine = 0u;
#pragma unroll
        for (unsigned j = 0; j < 16; ++j) { const unsigned c = xb_ld(&bar[XB_XCNT(j)]); sum += c; cnt += (c > 0u) ? 1u : 0u; mine = (j == x) ? c : mine; }
        if (sum == G) break;
        __builtin_amdgcn_s_sleep(1);
        if ((++sp & 255u) == 0u) { if (xb_ld(&bar[XB_TMO])) break; if (sp > XB_SPIN_CAP) { atomicAdd(&bar[XB_TMO], 1u); break; } }
    }
    nloc = mine > 0u ? mine : 1u; nx = cnt > 0u ? cnt : 1u;
}

__device__ __forceinline__ void xcd_barrier(const XcdBarrier& b) {
    asm volatile("s_waitcnt vmcnt(0)" ::: "memory");
    __syncthreads();
    if (threadIdx.x == 0) {
        unsigned* bar = b.bar;
        __builtin_amdgcn_s_waitcnt(0);
        unsigned nloc = b.st[0], nx = b.st[1];
        if (nloc == 0u) { xcd_barrier_complete(bar, b.x, nloc, nx); b.st[0] = nloc; b.st[1] = nx; }
        const unsigned old = xb_add(&bar[XB_XSUB(b.x)], 1u);
        const unsigned gen = old / nloc;
        if (old + 1u == (gen + 1u) * nloc) {
            __builtin_amdgcn_fence(__ATOMIC_RELEASE, "agent");
            asm volatile("s_waitcnt vmcnt(0)" ::: "memory");
            const unsigned og = xb_add(&bar[XB_TOP], 1u);
            const unsigned tg = og / nx;
            if (og + 1u == (tg + 1u) * nx) xb_add(&bar[XB_TOPGEN], 1u);
            else XB_SPIN(xb_ld(&bar[XB_TOPGEN]) == tg, bar);
            __builtin_amdgcn_fence(__ATOMIC_ACQUIRE, "agent");
            xb_add(&bar[XB_XGEN(b.x)], 1u);
            asm volatile("s_waitcnt vmcnt(0)" ::: "memory");
        } else {
            XB_SPIN(xb_ld(&bar[XB_XGEN(b.x)]) == gen, bar);
            __builtin_amdgcn_fence(__ATOMIC_ACQUIRE, "agent");
            asm volatile("s_waitcnt vmcnt(0)" ::: "memory");
        }
    }
    __syncthreads();
}
typedef unsigned short bf16;
typedef unsigned v4u __attribute__((ext_vector_type(4)));
typedef unsigned v2u __attribute__((ext_vector_type(2)));
typedef float f32x4 __attribute__((ext_vector_type(4)));
typedef float f32x2 __attribute__((ext_vector_type(2)));
typedef short bf16x8 __attribute__((ext_vector_type(8)));

constexpr int NTOK = 32768, DMOD = 1024, SEQL = 16384, PW = 3328, DFF = 2816;
constexpr float ALPHA = 1.681792830507429f;
constexpr size_t MiB = 1u << 20;
constexpr size_t WS_WIN = 0, WS_WOUT = 7 * MiB, WS_WUP = 9 * MiB, WS_WDN = 20 * MiB, WS_WSP = 26 * MiB;
constexpr size_t WS_XN = 32 * MiB, WS_P = 96 * MiB, WS_GH = 304 * MiB, WS_CAT = 432 * MiB;
constexpr size_t WS_GATE = 96 * MiB, WS_VAL = 272 * MiB, WS_U = 96 * MiB, WS_V = 160 * MiB, WS_END = 496 * MiB;
constexpr int LDS_TOTAL = 147456;
constexpr size_t WS_CTL = 28 * MiB;
constexpr int NTHR = 512;

__device__ __forceinline__ float bflo(unsigned w) { return __uint_as_float(w << 16); }
__device__ __forceinline__ float bfhi(unsigned w) { return __uint_as_float(w & 0xffff0000u); }
__device__ __forceinline__ unsigned f2bf(float f) { unsigned u = __float_as_uint(f); return (u + 0x7fffu + ((u >> 16) & 1u)) >> 16; }
__device__ __forceinline__ unsigned pk2(float lo, float hi) { return f2bf(lo) | (f2bf(hi) << 16); }
__device__ __forceinline__ void unpack8(const v4u w, float* o) { o[0] = bflo(w.x); o[1] = bfhi(w.x); o[2] = bflo(w.y); o[3] = bfhi(w.y); o[4] = bflo(w.z); o[5] = bfhi(w.z); o[6] = bflo(w.w); o[7] = bfhi(w.w); }
__device__ __forceinline__ v4u pack8(const float* o) { v4u w; w.x = pk2(o[0], o[1]); w.y = pk2(o[2], o[3]); w.z = pk2(o[4], o[5]); w.w = pk2(o[6], o[7]); return w; }
__device__ __forceinline__ float wave_sum(float v) {
#pragma unroll
    for (int o = 1; o < 64; o <<= 1) v += __shfl_xor(v, o);
    return v;
}
__device__ __forceinline__ int opaque_tid() { int t = threadIdx.x; asm volatile("" : "+v"(t)); return t; }
#define TIDS const int tid = opaque_tid(), lane = tid & 63, wave = __builtin_amdgcn_readfirstlane(tid >> 6); (void)lane; (void)wave
__device__ __forceinline__ float sigmoidf_(float x) { return 1.f / (1.f + __expf(-x)); }
__device__ __forceinline__ float tanhf_(float x) { const float e = __expf(2.f * x); return 1.f - 2.f / (e + 1.f); }

__device__ __forceinline__ void transpose_item(const float* W, int K, int N, bf16* WT, LAS float* scr, int item, int lane) {
    const int nblk = N / 32, kb = item / nblk, nb = item % nblk, k0 = 64 * kb, n0 = 32 * nb;
#pragma unroll 8
    for (int i = 0; i < 32; ++i) { const int kk = 2 * i + (lane >> 5); scr[kk * 33 + (lane & 31)] = W[(size_t)(k0 + kk) * N + n0 + (lane & 31)]; }
    asm volatile("s_waitcnt lgkmcnt(0)" ::: "memory");
    const int c = lane & 7;
#pragma unroll
    for (int j = 0; j < 4; ++j) { const int n = (lane >> 3) + 8 * j; const LAS float* s = scr + (8 * c) * 33 + n;
        v4u o; o.x = pk2(s[0 * 33], s[1 * 33]); o.y = pk2(s[2 * 33], s[3 * 33]); o.z = pk2(s[4 * 33], s[5 * 33]); o.w = pk2(s[6 * 33], s[7 * 33]);
        *(v4u*)(WT + (size_t)(n0 + n) * K + k0 + 8 * c) = o; }
    asm volatile("s_waitcnt lgkmcnt(0)" ::: "memory");
}

__device__ __forceinline__ int mm_tm(int wave) { return wave < 4 ? (wave >> 1) : 3 - ((wave - 4) >> 1); }
template <int KD, bool TRI  , class FA, class FB>
__device__ __forceinline__ void mm_acc_t(f32x4& c0, f32x4& c1, int wave, int lane, FA fa, FB fb) {
    const int tm = mm_tm(wave), tn0 = (wave & 1) * 2, li = lane & 15, lk = lane >> 4;
    const int kend = TRI ? 16 * (tm + 1) : KD;
#pragma nounroll
    for (int kb = 0; kb < kend; kb += 16) {
#pragma unroll
        for (int k0 = kb; k0 < kb + 16; k0 += 4) {
            const float a = fa(tm * 16 + li, k0 + lk);
            const float b0 = fb(k0 + lk, tn0 * 16 + li);
            const float b1 = fb(k0 + lk, tn0 * 16 + 16 + li);
            c0 = __builtin_amdgcn_mfma_f32_16x16x4f32(a, b0, c0, 0, 0, 0);
            c1 = __builtin_amdgcn_mfma_f32_16x16x4f32(a, b1, c1, 0, 0, 0);
        }
    }
}
template <int KD, class FA, class FB>
__device__ __forceinline__ void mm_acc(f32x4& c0, f32x4& c1, int wave, int lane, FA fa, FB fb) { mm_acc_t<KD, false>(c0, c1, wave, lane, fa, fb); }
template <class FC>
__device__ __forceinline__ void mm_store(const f32x4& c0, const f32x4& c1, int wave, int lane, FC fc) {
    const int tm = mm_tm(wave), tn0 = (wave & 1) * 2, li = lane & 15, lk = lane >> 4;
#pragma unroll
    for (int r = 0; r < 4; ++r) { fc(tm * 16 + 4 * lk + r, tn0 * 16 + li, c0[r]); fc(tm * 16 + 4 * lk + r, tn0 * 16 + 16 + li, c1[r]); }
}
constexpr int LD = 68, BUFF = 64 * LD;
#define RM(B) [=](int i, int k) { return (B)[i * LD + k]; }
#define TR(B) [=](int i, int k) { return (B)[k * LD + i]; }

struct LsRaw { v4u cur, prv; };
__device__ __forceinline__ LsRaw ls_issue(const bf16* P, int tok0, int col0, bool seq_start, int tid) {
    const int row = tid >> 3, c8 = (tid & 7) * 8;
    const bf16* pr = P + (size_t)(tok0 + row) * PW + col0 + c8;
    LsRaw r; r.cur = *(const v4u*)pr; r.prv = (v4u){0u, 0u, 0u, 0u};
    if (!(seq_start && row == 0)) r.prv = *(const v4u*)(pr - PW);
    return r;
}
template <int ACT  >
__device__ __forceinline__ void ls_commit(float* dst, const LsRaw& r, int col0, const float* mu, int tid) {
    const int row = tid >> 3, c8 = (tid & 7) * 8;
    float c[8], p[8]; unpack8(r.cur, c); unpack8(r.prv, p);
    const f32x4 m0 = *(const f32x4*)(mu + col0 + c8), m1 = *(const f32x4*)(mu + col0 + c8 + 4);
    const float m[8] = {m0[0], m0[1], m0[2], m0[3], m1[0], m1[1], m1[2], m1[3]};
    float x[8];
#pragma unroll
    for (int e = 0; e < 8; ++e) { x[e] = c[e] + m[e] * (p[e] - c[e]); if (ACT == 1) x[e] = tanhf_(x[e]); if (ACT == 2) x[e] = sigmoidf_(x[e]); }
    *(f32x4*)(dst + row * LD + c8) = (f32x4){x[0], x[1], x[2], x[3]}; *(f32x4*)(dst + row * LD + c8 + 4) = (f32x4){x[4], x[5], x[6], x[7]};
}
struct WRaw { f32x4 a, b; };
__device__ __forceinline__ WRaw w_issue(const float* W, int ldw, int row0, int col0, int tid) {
    const int row = tid >> 3, c8 = (tid & 7) * 8; const float* s = W + (size_t)(row0 + row) * ldw + col0 + c8;
    WRaw r; r.a = *(const f32x4*)s; r.b = *(const f32x4*)(s + 4); return r;
}
__device__ __forceinline__ void w_commit(float* dst, const WRaw& r, int tid) {
    const int row = tid >> 3, c8 = (tid & 7) * 8; *(f32x4*)(dst + row * LD + c8) = r.a; *(f32x4*)(dst + row * LD + c8 + 4) = r.b;
}
template <int K, class FA, class FB>
__device__ __forceinline__ f32x4 tile_mm(int lane, FA fa, FB fb) {
    const int li = lane & 15, lk = lane >> 4; f32x4 acc = {0.f, 0.f, 0.f, 0.f};
#pragma unroll
    for (int k0 = 0; k0 < K; k0 += 4) acc = __builtin_amdgcn_mfma_f32_16x16x4f32(fa(li, k0 + lk), fb(k0 + lk, li), acc, 0, 0, 0);
    return acc;
}
__device__ __forceinline__ void tri_inverse(float* T, const float* A, float* M, int tid, int wave, int lane) {
    for (int i = tid; i < 64 * LD; i += NTHR) T[i] = 0.f;
    __syncthreads();
    if (tid < 64) { const int d = tid >> 4, j = tid & 15; const float* Ad = A + (16 * d) * LD + 16 * d; float x[16];
#pragma unroll
        for (int t = 0; t < 16; ++t) { float acc = (t == j) ? 1.f : 0.f;
            f32x4 rw[4];
#pragma unroll
            for (int q4 = 0; q4 < 4; ++q4) if (4 * q4 < t) rw[q4] = *(const f32x4*)(Ad + t * LD + 4 * q4);
#pragma unroll
            for (int q = 0; q < t; ++q) acc += rw[q >> 2][q & 3] * x[q];
            x[t] = acc; asm volatile("" ::: "memory"); }
#pragma unroll
        for (int t = 0; t < 16; ++t) T[(16 * d + t) * LD + 16 * d + j] = x[t];
    }
    __syncthreads();
    const int li = lane & 15, lk = lane >> 4;
    if (wave < 2) { const int r0 = 16 * (2 * wave + 1), c0 = 16 * (2 * wave);
        const f32x4 acc = tile_mm<16>(lane, [=](int i, int k) { return A[(r0 + i) * LD + c0 + k]; }, [=](int k, int jj) { return T[(c0 + k) * LD + c0 + jj]; });
#pragma unroll
        for (int r = 0; r < 4; ++r) M[(r0 + 4 * lk + r) * LD + c0 + li] = acc[r]; }
    __syncthreads();
    if (wave < 2) { const int r0 = 16 * (2 * wave + 1), c0 = 16 * (2 * wave);
        const f32x4 acc = tile_mm<16>(lane, [=](int i, int k) { return T[(r0 + i) * LD + r0 + k]; }, [=](int k, int jj) { return M[(r0 + k) * LD + c0 + jj]; });
#pragma unroll
        for (int r = 0; r < 4; ++r) T[(r0 + 4 * lk + r) * LD + c0 + li] = acc[r]; }
    __syncthreads();
    if (wave < 4) { const int r0 = 32 + 16 * (wave >> 1), c0 = 16 * (wave & 1);
        const f32x4 acc = tile_mm<32>(lane, [=](int i, int k) { return A[(r0 + i) * LD + k]; }, [=](int k, int jj) { return T[k * LD + c0 + jj]; });
#pragma unroll
        for (int r = 0; r < 4; ++r) M[(r0 + 4 * lk + r) * LD + c0 + li] = acc[r]; }
    __syncthreads();
    if (wave < 4) { const int r0 = 32 + 16 * (wave >> 1), c0 = 16 * (wave & 1);
        const f32x4 acc = tile_mm<32>(lane, [=](int i, int k) { return T[(r0 + i) * LD + 32 + k]; }, [=](int k, int jj) { return M[(32 + k) * LD + c0 + jj]; });
#pragma unroll
        for (int r = 0; r < 4; ++r) T[(r0 + 4 * lk + r) * LD + c0 + li] = acc[r]; }
    __syncthreads();
}

struct RwkvW { const float *mu, *w0, *w2, *a0, *a2, *g2, *kk, *ka, *rk, *lg, *lb; };

template <bool WITH_R>
__device__ __forceinline__ void rwkv_front(float* sm, const bf16* P, const RwkvW& w, int tok0, int h, bool ss, int tid, int wave, int lane) {
    float *B0 = sm, *B1 = sm + BUFF, *B2 = sm + 2 * BUFF, *B3 = sm + 3 * BUFF, *B4 = sm + 4 * BUFF, *B5 = sm + 5 * BUFF, *B6 = sm + 6 * BUFF, *B7 = sm + 7 * BUFF;
    float* part = sm + 8 * BUFF; float* bon = part + 512 + 64;
    {
        const LsRaw rk = ls_issue(P, tok0, 512 + h * 64, ss, tid), rv = ls_issue(P, tok0, 1024 + h * 64, ss, tid), rxw = ls_issue(P, tok0, 1536, ss, tid), rxa = ls_issue(P, tok0, 1600, ss, tid);
        const WRaw ww = w_issue(w.w2, 512, 0, h * 64, tid), wa = w_issue(w.a2, 512, 0, h * 64, tid);
        ls_commit<0>(B0, rk, 512 + h * 64, w.mu, tid); ls_commit<0>(B1, rv, 1024 + h * 64, w.mu, tid); ls_commit<1>(B2, rxw, 1536, w.mu, tid); ls_commit<0>(B3, rxa, 1600, w.mu, tid);
        w_commit(B4, ww, tid); w_commit(B5, wa, tid);
    }
    LsRaw rr; if (WITH_R) rr = ls_issue(P, tok0, h * 64, ss, tid);
    __syncthreads();
    { f32x4 c0 = {0.f, 0.f, 0.f, 0.f}, c1 = c0; mm_acc<64>(c0, c1, wave, lane, RM(B2), RM(B4));
      const float* w0 = w.w0 + h * 64;
      mm_store(c0, c1, wave, lane, [=](int r, int c, float v) { const float wi = v + w0[c]; const float z = -wi; const float sp = fmaxf(z, 0.f) + __logf(1.f + __expf(-fabsf(z))); B6[r * LD + c] = -__expf(-sp - 0.5f); }); }
    { f32x4 c0 = {0.f, 0.f, 0.f, 0.f}, c1 = c0; mm_acc<64>(c0, c1, wave, lane, RM(B3), RM(B5));
      const float* a0 = w.a0 + h * 64;
      mm_store(c0, c1, wave, lane, [=](int r, int c, float v) { B7[r * LD + c] = sigmoidf_(v + a0[c]); }); }
    __syncthreads();
    if (WITH_R) ls_commit<0>(B4, rr, h * 64, w.mu, tid);
    {
        const int row = tid >> 3, c8 = (tid & 7) * 8;
        float kx[8], kkv[8]; float ssq = 0.f;
#pragma unroll
        for (int e = 0; e < 8; ++e) { kx[e] = B0[row * LD + c8 + e]; kkv[e] = kx[e] * w.kk[h * 64 + c8 + e]; ssq += kkv[e] * kkv[e]; }
        ssq += __shfl_xor(ssq, 1); ssq += __shfl_xor(ssq, 2); ssq += __shfl_xor(ssq, 4);
        const float inv = 1.f / fmaxf(sqrtf(ssq), 1e-12f);
        float bsum = 0.f;
#pragma unroll
        for (int e = 0; e < 8; ++e) { const float al = B7[row * LD + c8 + e]; const float kn = kkv[e] * inv; const float kad = kx[e] * (1.f + (al - 1.f) * w.ka[h * 64 + c8 + e]);
            B2[row * LD + c8 + e] = -kn; B3[row * LD + c8 + e] = kn * al; B0[row * LD + c8 + e] = kad;
            if (WITH_R) bsum += B4[row * LD + c8 + e] * kad * w.rk[h * 64 + c8 + e]; }
        if (WITH_R) { bsum += __shfl_xor(bsum, 1); bsum += __shfl_xor(bsum, 2); bsum += __shfl_xor(bsum, 4); if ((tid & 7) == 0) bon[row] = bsum; }
    }
    {
        const int ch = tid & 63, seg = tid >> 6; float s = 0.f;
#pragma unroll
        for (int i = 0; i < 8; ++i) s += B6[(seg * 8 + i) * LD + ch];
        part[seg * 64 + ch] = s;
    }
    __syncthreads();
    {   const int ch = tid & 63, seg = tid >> 6; float cex = 0.f;
        for (int s = 0; s < seg; ++s) cex += part[s * 64 + ch];
#pragma unroll
        for (int i = 0; i < 8; ++i) { const int t = seg * 8 + i; const float lw = B6[t * LD + ch]; B2[t * LD + ch] *= __expf(cex); cex += lw; B6[t * LD + ch] = cex; }
    }
    __syncthreads();
}

__device__ __forceinline__ void rwkv_phase1(float* sm, const bf16* P, const RwkvW& w, float* GH, int bx, int G) {
    TIDS;
    float *B0 = sm, *B1 = sm + BUFF, *B2 = sm + 2 * BUFF, *B3 = sm + 3 * BUFF, *B4 = sm + 4 * BUFF, *B5 = sm + 5 * BUFF, *B6 = sm + 6 * BUFF, *B7 = sm + 7 * BUFF;
    float* gl = sm + 8 * BUFF + 512;
    for (int unit = bx; unit < 4096; unit += G) {
        const int bh = unit >> 8, c = unit & 255, b = bh >> 3, h = bh & 7, tok0 = b * SEQL + c * 64;
        __syncthreads();
        rwkv_front<false>(sm, P, w, tok0, h, c == 0, tid, wave, lane);
        for (int idx = tid; idx < 4096; idx += NTHR) { const int t = idx >> 6, ch = idx & 63; const float cu = B6[t * LD + ch], cl = B6[63 * LD + ch];
            const float em = __expf(-cu), eh = __expf(cl - cu), bv = B3[t * LD + ch], kv = B0[t * LD + ch];
            B4[t * LD + ch] = bv * em; B5[t * LD + ch] = kv * em; B3[t * LD + ch] = bv * eh; B0[t * LD + ch] = kv * eh; }
        if (tid < 64) gl[tid] = __expf(B6[63 * LD + tid]);
        __syncthreads();
        { f32x4 c0 = {0.f, 0.f, 0.f, 0.f}, c1 = c0; mm_acc<64>(c0, c1, wave, lane, RM(B2), TR(B4)); mm_store(c0, c1, wave, lane, [=](int r, int cc, float v) { B7[r * LD + cc] = (cc < r) ? v : 0.f; }); }
        { f32x4 c0 = {0.f, 0.f, 0.f, 0.f}, c1 = c0; mm_acc<64>(c0, c1, wave, lane, RM(B2), TR(B5)); mm_store(c0, c1, wave, lane, [=](int r, int cc, float v) { B6[r * LD + cc] = (cc < r) ? v : 0.f; }); }
        __syncthreads();
        { f32x4 c0 = {0.f, 0.f, 0.f, 0.f}, c1 = c0; mm_acc_t<64, true>(c0, c1, wave, lane, RM(B6), RM(B1)); mm_store(c0, c1, wave, lane, [=](int r, int cc, float v) { B4[r * LD + cc] = v; }); }
        tri_inverse(B5, B7, B6, tid, wave, lane);
        { f32x4 c0 = {0.f, 0.f, 0.f, 0.f}, c1 = c0; mm_acc_t<64, true>(c0, c1, wave, lane, RM(B5), RM(B2)); mm_store(c0, c1, wave, lane, [=](int r, int cc, float v) { B6[r * LD + cc] = v; }); }
        { f32x4 c0 = {0.f, 0.f, 0.f, 0.f}, c1 = c0; mm_acc_t<64, true>(c0, c1, wave, lane, RM(B5), RM(B4)); mm_store(c0, c1, wave, lane, [=](int r, int cc, float v) { B7[r * LD + cc] = v; }); }
        __syncthreads();
        float* Gg = GH + (size_t)unit * 8192; float* Hg = Gg + 4096;
        { f32x4 c0 = {0.f, 0.f, 0.f, 0.f}, c1 = c0; mm_acc<64>(c0, c1, wave, lane, TR(B6), RM(B3)); mm_store(c0, c1, wave, lane, [=](int r, int cc, float v) { Gg[r * 64 + cc] = v + ((r == cc) ? gl[r] : 0.f); }); }
        { f32x4 c0 = {0.f, 0.f, 0.f, 0.f}, c1 = c0; mm_acc<64>(c0, c1, wave, lane, TR(B7), RM(B3)); mm_acc<64>(c0, c1, wave, lane, TR(B1), RM(B0)); mm_store(c0, c1, wave, lane, [=](int r, int cc, float v) { Hg[r * 64 + cc] = v; }); }
    }
}

__device__ __forceinline__ void rwkv_phase2(float* sm, float* GH, int wg) {
    TIDS;
    const int bh = wg >> 2, rb = wg & 3;
    float* Ss = sm; float* Gs = sm + 16 * LD; float* Hs = Gs + 64 * LD;
    for (int i = tid; i < 16 * LD; i += NTHR) Ss[i] = 0.f;
    float* base = GH + (size_t)(bh * 256) * 8192;
    const int grow = tid >> 3, gc8 = (tid & 7) * 8, hrow = tid >> 5, hc2 = (tid & 31) * 2;
    const size_t goff = (size_t)grow * 64 + gc8, hoff = 4096 + (size_t)(rb * 16 + hrow) * 64 + hc2;
    f32x4 ga[4], gb[4]; f32x2 hv[4];
#pragma unroll
    for (int i = 0; i < 4; ++i) { const float* u = base + (size_t)i * 8192; ga[i] = *(const f32x4*)(u + goff); gb[i] = *(const f32x4*)(u + goff + 4); hv[i] = *(const f32x2*)(u + hoff); }
    const int li = lane & 15, lk = lane >> 4;
    for (int c4 = 0; c4 < 256; c4 += 4) {
#pragma unroll
        for (int i = 0; i < 4; ++i) {
            const int c = c4 + i;
            *(f32x4*)(Gs + grow * LD + gc8) = ga[i]; *(f32x4*)(Gs + grow * LD + gc8 + 4) = gb[i]; *(f32x2*)(Hs + hrow * LD + hc2) = hv[i];
            __syncthreads();
            float* u = base + (size_t)c * 8192;
            if (c + 4 < 256) { const float* un = u + (size_t)4 * 8192; ga[i] = *(const f32x4*)(un + goff); gb[i] = *(const f32x4*)(un + goff + 4); hv[i] = *(const f32x2*)(un + hoff); }
            *(f32x2*)(u + hoff) = *(const f32x2*)(Ss + hrow * LD + hc2);
            f32x4 acc = {0.f, 0.f, 0.f, 0.f};
            if (wave < 4) {
#pragma unroll
                for (int r = 0; r < 4; ++r) acc[r] = Hs[(4 * lk + r) * LD + 16 * wave + li];
#pragma unroll 4
                for (int k0 = 0; k0 < 64; k0 += 4) acc = __builtin_amdgcn_mfma_f32_16x16x4f32(Ss[li * LD + k0 + lk], Gs[(k0 + lk) * LD + 16 * wave + li], acc, 0, 0, 0);
            }
            __syncthreads();
            if (wave < 4) {
#pragma unroll
                for (int r = 0; r < 4; ++r) Ss[(4 * lk + r) * LD + 16 * wave + li] = acc[r];
            }
        }
    }
    __syncthreads();
}

__device__ __forceinline__ void rwkv_phase3(float* sm, const bf16* P, const RwkvW& w, const float* GH, bf16* CAT, int bx, int G) {
    TIDS;
    float *B0 = sm, *B1 = sm + BUFF, *B2 = sm + 2 * BUFF, *B3 = sm + 3 * BUFF, *B4 = sm + 4 * BUFF, *B5 = sm + 5 * BUFF, *B6 = sm + 6 * BUFF, *B7 = sm + 7 * BUFF;
    float* bon = sm + 8 * BUFF + 512 + 64;
    for (int unit = bx; unit < 4096; unit += G) {
        const int bh = unit >> 8, c = unit & 255, b = bh >> 3, h = bh & 7, tok0 = b * SEQL + c * 64; const bool ss = (c == 0);
        __syncthreads();
        rwkv_front<true>(sm, P, w, tok0, h, ss, tid, wave, lane);
        const WRaw s0raw = w_issue(GH + (size_t)unit * 8192 + 4096, 64, 0, 0, tid);
        const LsRaw xg0 = ls_issue(P, tok0, 1664, ss, tid), xg1 = ls_issue(P, tok0, 1728, ss, tid);
        const WRaw g2a = w_issue(w.g2, 512, 0, h * 64, tid), g2b = w_issue(w.g2, 512, 64, h * 64, tid);
        for (int idx = tid; idx < 4096; idx += NTHR) { const int t = idx >> 6, ch = idx & 63; const float cu = B6[t * LD + ch]; const float em = __expf(-cu);
            B5[t * LD + ch] = B3[t * LD + ch] * em; B0[t * LD + ch] *= em; B4[t * LD + ch] *= __expf(cu); }
        __syncthreads();
        { f32x4 c0 = {0.f, 0.f, 0.f, 0.f}, c1 = c0; mm_acc<64>(c0, c1, wave, lane, RM(B2), TR(B5)); mm_store(c0, c1, wave, lane, [=](int r, int cc, float v) { B3[r * LD + cc] = (cc < r) ? v : 0.f; }); }
        { f32x4 c0 = {0.f, 0.f, 0.f, 0.f}, c1 = c0; mm_acc<64>(c0, c1, wave, lane, RM(B2), TR(B0)); mm_store(c0, c1, wave, lane, [=](int r, int cc, float v) { B6[r * LD + cc] = (cc < r) ? v : 0.f; }); }
        { f32x4 c0 = {0.f, 0.f, 0.f, 0.f}, c1 = c0; mm_acc<64>(c0, c1, wave, lane, RM(B4), TR(B5)); mm_store(c0, c1, wave, lane, [=](int r, int cc, float v) { B7[r * LD + cc] = (cc <= r) ? v : 0.f; }); }
        __syncthreads();
        { f32x4 c0 = {0.f, 0.f, 0.f, 0.f}, c1 = c0; mm_acc<64>(c0, c1, wave, lane, RM(B4), TR(B0)); mm_store(c0, c1, wave, lane, [=](int r, int cc, float v) { B5[r * LD + cc] = (cc <= r) ? v : 0.f; }); }
        __syncthreads();
        w_commit(B0, s0raw, tid);
        __syncthreads();
        { f32x4 c0 = {0.f, 0.f, 0.f, 0.f}, c1 = c0; mm_acc<64>(c0, c1, wave, lane, RM(B2), TR(B0)); mm_acc_t<64, true>(c0, c1, wave, lane, RM(B6), RM(B1)); __syncthreads();
          mm_store(c0, c1, wave, lane, [=](int r, int cc, float v) { B2[r * LD + cc] = v; }); }
        __syncthreads();
        f32x4 y0 = {0.f, 0.f, 0.f, 0.f}, y1 = y0;
        mm_acc<64>(y0, y1, wave, lane, RM(B4), TR(B0)); mm_acc_t<64, true>(y0, y1, wave, lane, RM(B5), RM(B1));
        tri_inverse(B6, B3, B0, tid, wave, lane);
        { f32x4 c0 = {0.f, 0.f, 0.f, 0.f}, c1 = c0; mm_acc_t<64, true>(c0, c1, wave, lane, RM(B6), RM(B2)); mm_store(c0, c1, wave, lane, [=](int r, int cc, float v) { B4[r * LD + cc] = v; }); }
        __syncthreads();
        mm_acc_t<64, true>(y0, y1, wave, lane, RM(B7), RM(B4));
        ls_commit<2>(B3, xg0, 1664, w.mu, tid); ls_commit<2>(B5, xg1, 1728, w.mu, tid); w_commit(B0, g2a, tid); w_commit(B2, g2b, tid);
        mm_store(y0, y1, wave, lane, [=](int r, int cc, float v) { B6[r * LD + cc] = v; });
        __syncthreads();
        { f32x4 c0 = {0.f, 0.f, 0.f, 0.f}, c1 = c0; mm_acc<64>(c0, c1, wave, lane, RM(B3), RM(B0)); mm_acc<64>(c0, c1, wave, lane, RM(B5), RM(B2));
          mm_store(c0, c1, wave, lane, [=](int r, int cc, float v) { B4[r * LD + cc] = v; }); }
        __syncthreads();
        {   const int row = tid >> 3, c8 = (tid & 7) * 8; float y[8], s = 0.f;
#pragma unroll
            for (int e = 0; e < 8; ++e) { y[e] = B6[row * LD + c8 + e]; s += y[e]; }
            s += __shfl_xor(s, 1); s += __shfl_xor(s, 2); s += __shfl_xor(s, 4);
            const float mu = s * (1.f / 64.f); float q = 0.f;
#pragma unroll
            for (int e = 0; e < 8; ++e) { y[e] -= mu; q += y[e] * y[e]; }
            q += __shfl_xor(q, 1); q += __shfl_xor(q, 2); q += __shfl_xor(q, 4);
            const float rs = 1.f / sqrtf(q * (1.f / 64.f) + 64e-5f); const float bn = bon[row];
            float o[8];
#pragma unroll
            for (int e = 0; e < 8; ++e) { const int ch = h * 64 + c8 + e; const float yn = y[e] * rs * w.lg[ch] + w.lb[ch]; o[e] = (yn + bn * B1[row * LD + c8 + e]) * B4[row * LD + c8 + e]; }
            *(v4u*)(CAT + (size_t)(tok0 + row) * 1024 + h * 64 + c8) = pack8(o);
        }
    }
}

__device__ __forceinline__ void phase_rope(bf16* P, int bx, int G) {
    TIDS;
    constexpr float INVF[8] = {1.0f, 0.1939227432012558f, 0.03760603070259094f, 0.007292664609849453f, 0.0014142135623842478f, 0.00027424818836152554f, 5.318296098266728e-05f, 1.0313386155758053e-05f};
    for (int it = bx * NTHR + tid; it < NTOK * 16; it += G * NTHR) {
        const int tok = it >> 4, hh = it & 15, s = tok & (SEQL - 1);
        bf16* p = P + (size_t)tok * PW + 1792 + hh * 64;
        float x1[8], x2[8]; unpack8(*(const v4u*)p, x1); unpack8(*(const v4u*)(p + 8), x2);
        const float sc = (hh < 8) ? attn_body::C2 : 1.f;
        float o1[8], o2[8];
#pragma unroll
        for (int d = 0; d < 8; ++d) { const float ang = (float)s * INVF[d]; double rev = (double)ang * 0.15915494309189535; rev -= rint(rev); const float fr = (float)rev;
            const float sn = __builtin_amdgcn_sinf(fr), cs = __builtin_amdgcn_cosf(fr);
            o1[d] = (x1[d] * cs - x2[d] * sn) * sc; o2[d] = (x1[d] * sn + x2[d] * cs) * sc; }
        *(v4u*)p = pack8(o1); *(v4u*)(p + 8) = pack8(o2);
        if (hh < 8) {
#pragma unroll
            for (int q = 2; q < 8; ++q) { float x[8]; unpack8(*(const v4u*)(p + 8 * q), x);
#pragma unroll
                for (int e = 0; e < 8; ++e) x[e] *= sc;
                *(v4u*)(p + 8 * q) = pack8(x); }
        }
    }
}

__device__ __forceinline__ void phase_attn_post(const bf16* OB, bf16* CAT, const float* q1, const float* k1, const float* q2, const float* k2, const float* sg, float lam_init, int bx, int G) {
    TIDS; const int gw = bx * 8 + wave, NGW = G * 8;
    const float d1 = wave_sum(q1[lane] * k1[lane]), d2 = wave_sum(q2[lane] * k2[lane]);
    const float lam = expf(d1) - expf(d2) + lam_init;
    const int h = lane >> 4, d0 = (lane & 15) * 8, vhalf = d0 >> 6, dd = d0 & 63;
    float g[8];
#pragma unroll
    for (int e = 0; e < 8; ++e) g[e] = sg[d0 + e] * (1.f - lam_init);
    for (int tok = gw; tok < NTOK; tok += NGW) {
        const bf16* r = OB + (size_t)tok * 1024;
        float a[8], b[8]; unpack8(*(const v4u*)(r + ((h * 2 + 0) * 2 + vhalf) * 64 + dd), a); unpack8(*(const v4u*)(r + ((h * 2 + 1) * 2 + vhalf) * 64 + dd), b);
        float o[8], q = 0.f;
#pragma unroll
        for (int e = 0; e < 8; ++e) { o[e] = a[e] - lam * b[e]; q += o[e] * o[e]; }
        q += __shfl_xor(q, 1); q += __shfl_xor(q, 2); q += __shfl_xor(q, 4); q += __shfl_xor(q, 8);
        const float rs = 1.f / sqrtf(q * (1.f / 128.f) + 1e-5f);
#pragma unroll
        for (int e = 0; e < 8; ++e) o[e] = o[e] * rs * g[e];
        *(v4u*)(CAT + (size_t)tok * 1024 + 512 + h * 128 + d0) = pack8(o);
    }
}

__device__ __forceinline__ void phase_ln(float* X, bf16* XN, const float* g, const float* b, int bx, int G) {
    TIDS; const int gw = bx * 8 + wave, NGW = G * 8;
    for (int m = gw; m < NTOK; m += NGW) {
        f32x4* xr = (f32x4*)(X + (size_t)m * 1024) + lane;
        f32x4 v[4]; float s = 0.f;
#pragma unroll
        for (int j = 0; j < 4; ++j) { v[j] = xr[64 * j]; s += (v[j][0] + v[j][1]) + (v[j][2] + v[j][3]); }
        const float mean = wave_sum(s) * (1.f / 1024.f); float s2 = 0.f;
#pragma unroll
        for (int j = 0; j < 4; ++j) { v[j] = v[j] - mean; s2 += (v[j][0] * v[j][0] + v[j][1] * v[j][1]) + (v[j][2] * v[j][2] + v[j][3] * v[j][3]); }
        const float rstd = 1.f / sqrtf(wave_sum(s2) * (1.f / 1024.f) + 1e-5f);
        v2u* o8 = (v2u*)(XN + (size_t)m * 1024) + lane;
#pragma unroll
        for (int j = 0; j < 4; ++j) { const f32x4 gg = *(const f32x4*)(g + 4 * lane + 256 * j), bb = *(const f32x4*)(b + 4 * lane + 256 * j);
            const f32x4 o = v[j] * rstd * gg + bb; xr[64 * j] = o; v2u w; w.x = pk2(o[0], o[1]); w.y = pk2(o[2], o[3]); o8[64 * j] = w; }
    }
}
__device__ __forceinline__ void phase_lnv(bf16* V, const float* g, const float* b, int bx, int G) {
    TIDS; const int gw = bx * 8 + wave, NGW = G * 8;
    for (int m = gw; m < NTOK; m += NGW) {
        bf16* r = V + (size_t)m * 1024;
        float x[16]; unpack8(*(const v4u*)(r + lane * 8), x); unpack8(*(const v4u*)(r + 512 + lane * 8), x + 8);
        float s = 0.f;
#pragma unroll
        for (int e = 0; e < 16; ++e) s += x[e];
        const float mean = wave_sum(s) * (1.f / 1024.f); float s2 = 0.f;
#pragma unroll
        for (int e = 0; e < 16; ++e) { x[e] -= mean; s2 += x[e] * x[e]; }
        const float rstd = 1.f / sqrtf(wave_sum(s2) * (1.f / 1024.f) + 1e-5f);
#pragma unroll
        for (int e = 0; e < 16; ++e) { const int col = (e < 8) ? lane * 8 + e : 512 + lane * 8 + (e - 8); x[e] = x[e] * rstd * g[col] + b[col]; }
        *(v4u*)(r + lane * 8) = pack8(x); *(v4u*)(r + 512 + lane * 8) = pack8(x + 8);
    }
}

__device__ __forceinline__ void phase_conv(const bf16* GATE, bf16* VAL, const float* cw, const float* cb, int bx, int G) {
    TIDS;
    constexpr int NCG = DFF / 8, NIT = (NTOK / 16) * NCG;
    for (int it = bx * NTHR + tid; it < NIT; it += G * NTHR) {
        const int rb = it / NCG, c0 = (it % NCG) * 8, t0 = rb * 16;
        float w0[8], w1[8], w2[8], bb[8];
#pragma unroll
        for (int e = 0; e < 8; ++e) { w0[e] = cw[c0 + e]; w1[e] = cw[DFF + c0 + e]; w2[e] = cw[2 * DFF + c0 + e]; bb[e] = cb[c0 + e]; }
        float g1[8], g2[8];
        if ((t0 & (SEQL - 1)) == 0) {
#pragma unroll
            for (int e = 0; e < 8; ++e) { g1[e] = 0.f; g2[e] = 0.f; }
        } else { unpack8(*(const v4u*)(GATE + (size_t)(t0 - 1) * DFF + c0), g1); unpack8(*(const v4u*)(GATE + (size_t)(t0 - 2) * DFF + c0), g2); }
        for (int r = 0; r < 16; ++r) {
            const size_t off = (size_t)(t0 + r) * DFF + c0;
            float gg[8], vv[8], o[8]; unpack8(*(const v4u*)(GATE + off), gg); unpack8(*(const v4u*)(VAL + off), vv);
#pragma unroll
            for (int e = 0; e < 8; ++e) { const float cv = bb[e] + w0[e] * g2[e] + w1[e] * g1[e] + w2[e] * gg[e]; o[e] = cv * sigmoidf_(cv) * vv[e]; g2[e] = g1[e]; g1[e] = gg[e]; }
            *(v4u*)(VAL + off) = pack8(o);
        }
    }
}

__device__ __forceinline__ void phase_mix(unsigned char* ldsb, bf16* U, const bf16* V, const bf16* WSP, const float* bs, int bx, int G) {
    TIDS;
    bf16* Vt = (bf16*)ldsb;
    for (int unit = bx; unit < 2048; unit += G) {
        const int cidx = unit >> 3, g = unit & 7, tok0 = cidx * 128;
        __syncthreads();
        {   const int s = tid >> 2, q = tid & 3;
#pragma unroll
            for (int i = 0; i < 4; ++i) { const v4u w = *(const v4u*)(V + (size_t)(tok0 + s) * 1024 + g * 128 + q * 32 + i * 8); const int d0 = q * 32 + i * 8;
                Vt[(d0 + 0) * 136 + s] = (bf16)(w.x & 0xffffu); Vt[(d0 + 1) * 136 + s] = (bf16)(w.x >> 16); Vt[(d0 + 2) * 136 + s] = (bf16)(w.y & 0xffffu); Vt[(d0 + 3) * 136 + s] = (bf16)(w.y >> 16);
                Vt[(d0 + 4) * 136 + s] = (bf16)(w.z & 0xffffu); Vt[(d0 + 5) * 136 + s] = (bf16)(w.z >> 16); Vt[(d0 + 6) * 136 + s] = (bf16)(w.w & 0xffffu); Vt[(d0 + 7) * 136 + s] = (bf16)(w.w >> 16); }
        }
        __syncthreads();
        f32x4 acc[8];
#pragma unroll
        for (int tn = 0; tn < 8; ++tn) acc[tn] = (f32x4){0.f, 0.f, 0.f, 0.f};
        const int li = lane & 15, lk = lane >> 4, nks = (16 * wave + 15) / 32 + 1;
        for (int ks = 0; ks < nks; ++ks) {
            const bf16x8 a = *(const bf16x8*)(WSP + (size_t)g * 16384 + (16 * wave + li) * 128 + ks * 32 + lk * 8);
#pragma unroll
            for (int tn = 0; tn < 8; ++tn) { const bf16x8 bq = *(const bf16x8*)(Vt + (16 * tn + li) * 136 + ks * 32 + lk * 8); acc[tn] = __builtin_amdgcn_mfma_f32_16x16x32_bf16(a, bq, acc[tn], 0, 0, 0); }
        }
#pragma unroll
        for (int r = 0; r < 4; ++r) { const int t = 16 * wave + 4 * lk + r; const float bias = bs[g * 128 + t];
#pragma unroll
            for (int tn = 0; tn < 8; ++tn) { bf16* up = U + (size_t)(tok0 + t) * 1024 + g * 128 + 16 * tn + li; const float u = __uint_as_float(((unsigned)*up) << 16); *up = (bf16)f2bf(u * (acc[tn][r] + bias)); } }
    }
}

#ifndef PHASE_SEL
#define PHASE_SEL 0xffffffffu
#endif
#define ON(k) (((PHASE_SEL) >> (k)) & 1u)
struct Args { const float* in[34]; float* out; unsigned char* ws; };

__global__ void __launch_bounds__(NTHR, 2) mega_fwd(Args a) {
    extern __shared__ __attribute__((aligned(16))) unsigned char lds[];
    cg::grid_group grid = cg::this_grid();
    const int G = gridDim.x, bx = blockIdx.x;
    unsigned* barw = (unsigned*)(a.ws + WS_CTL);
    volatile LAS unsigned* bst = (volatile LAS unsigned*)((LAS unsigned char*)lds + (LDS_TOTAL - 16));
    if (threadIdx.x < 2) bst[threadIdx.x] = 0u;
    if (bx == 0) for (int i = threadIdx.x; i < XCD_BAR_WORDS; i += NTHR) barw[i] = 0u;
    __threadfence();
    grid.sync();
    const XcdBarrier xbar = xcd_barrier_post(barw, bst);
#ifdef PROBE_MASK
    unsigned long long tacc = 0, tmark = 0;
#define PB(k) do { if ((PROBE_MASK >> (k)) & 1u) tmark = __builtin_amdgcn_s_memrealtime(); } while (0)
#define PE(k) do { if ((PROBE_MASK >> (k)) & 1u) tacc += __builtin_amdgcn_s_memrealtime() - tmark; } while (0)
#else
#define PB(k) do {} while (0)
#define PE(k) do {} while (0)
#endif
    for (int layer = 0; layer < 4; ++layer) {
        const int j = layer >> 1; const bool even = (layer & 1) == 0;
        int z = 0; asm volatile("" : "+s"(z));
        unsigned char* ws = a.ws + z; float* out = a.out + z;
        bf16 *W_in = (bf16*)(ws + WS_WIN), *W_out = (bf16*)(ws + WS_WOUT), *W_up = (bf16*)(ws + WS_WUP), *W_dn = (bf16*)(ws + WS_WDN), *WSP = (bf16*)(ws + WS_WSP);
        bf16 *XN = (bf16*)(ws + WS_XN), *P = (bf16*)(ws + WS_P), *CAT = (bf16*)(ws + WS_CAT), *GATE = (bf16*)(ws + WS_GATE), *VAL = (bf16*)(ws + WS_VAL), *U = (bf16*)(ws + WS_U), *V = (bf16*)(ws + WS_V);
        float* GH = (float*)(ws + WS_GH);
        LAS unsigned char* ldsl = (LAS unsigned char*)lds;
        float* sm = (float*)lds;

        PB(0);
        if (ON(0)) {
            TIDS; const int gw = bx * 8 + wave, NGW = G * 8;
            LAS float* scr = (LAS float*)(ldsl + wave * 16384);
            const float* wi = even ? a.in[1 + z] + (size_t)j * 1024 * 3328 : a.in[19 + z] + (size_t)j * 1024 * 2048;
            const int Nin = even ? 3328 : 2048;
            const float* wo = even ? a.in[18 + z] + (size_t)j * 1024 * 1024 : a.in[25 + z] + (size_t)j * 1024 * 1024;
            const float* wu = a.in[28 + z] + (size_t)layer * 1024 * 5632;
            const float* wd = a.in[31 + z] + (size_t)layer * 2816 * 1024;
            const int I_in = 16 * (Nin / 32), I_out = 16 * 32, I_up = 16 * 176, I_dn = 44 * 32, NIT = I_in + I_out + I_up + I_dn;
            for (int it = gw; it < NIT; it += NGW) {
                int r = it;
                if (r < I_in) { transpose_item(wi, 1024, Nin, W_in, scr, r, lane); continue; } r -= I_in;
                if (r < I_out) { transpose_item(wo, 1024, 1024, W_out, scr, r, lane); continue; } r -= I_out;
                if (r < I_up) { transpose_item(wu, 1024, 5632, W_up, scr, r, lane); continue; } r -= I_up;
                transpose_item(wd, 2816, 1024, W_dn, scr, r, lane);
            }
            if (!even) { const float* wsrc = a.in[23 + z] + (size_t)j * 8 * 128 * 128;
                for (int i = bx * NTHR + tid; i < 8 * 128 * 128; i += G * NTHR) { const int t = (i >> 7) & 127, s = i & 127; WSP[i] = (bf16)f2bf(s <= t ? wsrc[i] : 0.f); } }
            if (layer == 0) { const f32x4* xs = (const f32x4*)a.in[0 + z]; f32x4* xo = (f32x4*)out; v2u* xn = (v2u*)XN;
                for (int i = bx * NTHR + tid; i < NTOK * 1024 / 4; i += G * NTHR) { const f32x4 v = xs[i]; xo[i] = v; v2u w; w.x = pk2(v[0], v[1]); w.y = pk2(v[2], v[3]); xn[i] = w; } }
        }
        xcd_barrier(xbar);
        PE(0);
        if (even) {
            RwkvW rw{a.in[2 + z] + j * 1792, a.in[3 + z] + j * 512, a.in[4 + z] + (size_t)j * 64 * 512, a.in[5 + z] + j * 512, a.in[6 + z] + (size_t)j * 64 * 512, a.in[7 + z] + (size_t)j * 128 * 512,
                     a.in[8 + z] + j * 512, a.in[9 + z] + j * 512, a.in[10 + z] + j * 512, a.in[11 + z] + j * 512, a.in[12 + z] + j * 512};
            PB(1);
            if (ON(1)) {   pg8::Gemm g{XN, W_in, NTOK, 3328, 1024}; pg8::StaticOrder S; S.init(NTOK, 3328, G, bx);
                pg8::EpiBf16<0> E{P, 3328, nullptr, 0, 0, 1.f};
                pg8::gemm_phase<pg8::EpiBf16<0>, pg8::StaticOrder, PG8_ALIGN, PG8_SP2>(ldsl, g, S, E); }
            xcd_barrier(xbar);
            PE(1);
            PB(2);
            if (ON(2)) rwkv_phase1(sm, P, rw, GH, bx, G);
            PB(3);
            if (ON(3)) phase_rope(P, bx, G);
            xcd_barrier(xbar);
            PE(2);
            PE(3);
            PB(4);
            if (ON(4)) if (bx < 64) rwkv_phase2(sm, GH, bx);
            xcd_barrier(xbar);
            PE(4);
            PB(5);
            if (ON(5)) {
                __syncthreads();
                const int nun = (G == 256) ? 8 : (2048 - bx + G - 1) / G;
                for (int i = 0; i < nun; ++i) {
                    int bhv, qb;
                    if (G == 256) { const int vcu = (bx % 8) * (G / 8) + bx / 8, s = vcu & 7, grp = i >> 1; bhv = vcu >> 3; qb = (i & 1) ? (16 * grp + 15 - s) : (16 * grp + s); }
                    else { const int u = bx + i * G; bhv = u & 31; qb = 63 - (u >> 5); }
                    const int b = bhv >> 4, vh = bhv & 15, hd = vh >> 2, cm = (vh >> 1) & 1, vhalf = vh & 1;
                    const attn_body::bf16* Q = (const attn_body::bf16*)(P + 1792 + (hd * 2 + cm) * 64); const attn_body::bf16* K = (const attn_body::bf16*)(P + 2304 + (hd * 2 + cm) * 64);
                    const attn_body::bf16* Vv = (const attn_body::bf16*)(P + 2816 + hd * 128 + vhalf * 64); attn_body::bf16* O = (attn_body::bf16*)(XN + vh * 64);
                    attn_body::attn_unit<8>(b, 0, qb, Q, K, Vv, O, (char*)lds);
                }
            }
            xcd_barrier(xbar);
            PE(5);
            PB(6);
            if (ON(6)) rwkv_phase3(sm, P, rw, GH, CAT, bx, G);
            PB(7);
            if (ON(7)) phase_attn_post(XN, CAT, a.in[13 + z] + j * 64, a.in[14 + z] + j * 64, a.in[15 + z] + j * 64, a.in[16 + z] + j * 64, a.in[17 + z] + j * 128, layer == 0 ? 0.2f : 0.4707130183435842f, bx, G);
            xcd_barrier(xbar);
            PE(6);
            PE(7);
            PB(8);
            if (ON(8)) {   pg8::Gemm g{CAT, W_out, NTOK, 1024, 1024}; pg8::StaticOrder S; S.init(NTOK, 1024, G, bx);
                pg8::EpiResid E{out, 1024, ALPHA};
                pg8::gemm_phase<pg8::EpiResid, pg8::StaticOrder, PG8_ALIGN, PG8_SP2>(ldsl, g, S, E); }
        } else {
            PB(9);
            if (ON(9)) {   pg8::Gemm g{XN, W_in, NTOK, 2048, 1024}; pg8::StaticOrder S; S.init(NTOK, 2048, G, bx);
                pg8::EpiBf16<1> E{U, 1024, a.in[20 + z] + j * 2048, 1024, (size_t)(WS_V - WS_U) / 2, 1.f};
                pg8::gemm_phase<pg8::EpiBf16<1>, pg8::StaticOrder, PG8_ALIGN, PG8_SP2>(ldsl, g, S, E); }
            xcd_barrier(xbar);
            PE(9);
            PB(10);
            if (ON(10)) phase_lnv(V, a.in[21 + z] + j * 1024, a.in[22 + z] + j * 1024, bx, G);
            xcd_barrier(xbar);
            PE(10);
            PB(11);
            if (ON(11)) phase_mix(lds, U, V, WSP, a.in[24 + z] + j * 1024, bx, G);
            xcd_barrier(xbar);
            PE(11);
            PB(12);
            if (ON(12)) {   pg8::Gemm g{U, W_out, NTOK, 1024, 1024}; pg8::StaticOrder S; S.init(NTOK, 1024, G, bx);
                pg8::EpiResid E{out, 1024, ALPHA};
                pg8::gemm_phase<pg8::EpiResid, pg8::StaticOrder, PG8_ALIGN, PG8_SP2>(ldsl, g, S, E); }
        }
        xcd_barrier(xbar);
        if (even) PE(8); else PE(12);
        PB(13);
        if (ON(13)) phase_ln(out, XN, a.in[26 + z] + layer * 1024, a.in[27 + z] + layer * 1024, bx, G);
        xcd_barrier(xbar);
        PE(13);
        PB(14);
        if (ON(14)) {   pg8::Gemm g{XN, W_up, NTOK, 5632, 1024}; pg8::StaticOrder S; S.init(NTOK, 5632, G, bx);
            pg8::EpiBf16<0> E{GATE, 2816, nullptr, 2816, (size_t)(WS_VAL - WS_GATE) / 2, 1.f};
            pg8::gemm_phase<pg8::EpiBf16<0>, pg8::StaticOrder, PG8_ALIGN, PG8_SP2>(ldsl, g, S, E); }
        xcd_barrier(xbar);
        PE(14);
        PB(15);
        if (ON(15)) phase_conv(GATE, VAL, a.in[29 + z] + (size_t)layer * 3 * DFF, a.in[30 + z] + layer * DFF, bx, G);
        xcd_barrier(xbar);
        PE(15);
        PB(16);
        if (ON(16)) {   pg8::Gemm g{VAL, W_dn, NTOK, 1024, 2816}; pg8::StaticOrder S; S.init(NTOK, 1024, G, bx);
            pg8::EpiResid E{out, 1024, ALPHA};
            pg8::gemm_phase<pg8::EpiResid, pg8::StaticOrder, PG8_ALIGN, PG8_SP2>(ldsl, g, S, E); }
        xcd_barrier(xbar);
        PE(16);
        PB(17);
#ifdef EXTRA_SYNCS
        for (int es = 0; es < EXTRA_SYNCS; ++es) xcd_barrier(xbar);
#endif
        if (ON(17)) phase_ln(out, XN, a.in[32 + z] + layer * 1024, a.in[33 + z] + layer * 1024, bx, G);
        xcd_barrier(xbar);
        PE(17);
    }
#ifdef PROBE_MASK
    if (bx == 0 && threadIdx.x == 0) { const unsigned long long t0 = __builtin_amdgcn_s_memrealtime(); while (__builtin_amdgcn_s_memrealtime() - t0 < 4ull * tacc) __builtin_amdgcn_s_sleep(8); }
#endif
}

extern "C" void kernel_launch(void* const* d_in, const int* in_sizes, int n_in, void* d_out, int out_size, void* d_ws, size_t ws_size, hipStream_t stream) {
    static int grid = 0;
    if (grid == 0) {
        if (n_in != 34 || out_size != NTOK * 1024 || ws_size < WS_END) { fprintf(stderr, "kernel_launch: unexpected shapes (n_in %d out %d ws %zu)\n", n_in, out_size, ws_size); grid = -1; return; }
        int dev = 0, cus = 0, per_cu = 0;
        hipGetDevice(&dev); hipDeviceGetAttribute(&cus, hipDeviceAttributeMultiprocessorCount, dev);
        if (hipFuncSetAttribute((const void*)mega_fwd, hipFuncAttributeMaxDynamicSharedMemorySize, LDS_TOTAL) != hipSuccess) { fprintf(stderr, "kernel_launch: hipFuncSetAttribute failed\n"); grid = -1; return; }
        if (hipOccupancyMaxActiveBlocksPerMultiprocessor(&per_cu, (const void*)mega_fwd, NTHR, LDS_TOTAL) != hipSuccess || per_cu < 1) per_cu = 1;
        (void)hipGetLastError();
        grid = cus * per_cu;
        fprintf(stderr, "kernel_launch: grid %d (cus %d x %d)\n", grid, cus, per_cu);
    }
    if (grid < 0) return;
    Args a{};
    for (int i = 0; i < 34; ++i) a.in[i] = (const float*)d_in[i];
    a.out = (float*)d_out; a.ws = (unsigned char*)d_ws;
    void* args[] = {&a};
    hipError_t e = hipLaunchCooperativeKernel((const void*)mega_fwd, dim3(grid), dim3(NTHR), args, LDS_TOTAL, stream);
    if (e != hipSuccess) fprintf(stderr, "kernel_launch: cooperative launch failed: %s (grid %d)\n", hipGetErrorString(e), grid);
}
```

```cpp
#include <hip/hip_runtime.h>
#include <hip/hip_cooperative_groups.h>
#include <cstdio>
#include <cstdint>
namespace cg = cooperative_groups;
namespace pg8 {
#define PG8_LAS __attribute__((address_space(3)))
typedef unsigned short bf16_t;
typedef short bf16x8 __attribute__((ext_vector_type(8)));
typedef float f32x4 __attribute__((ext_vector_type(4)));
typedef unsigned u32x4 __attribute__((ext_vector_type(4)));
constexpr int BM = 256, BK = 64, HALF = 128, HTB = HALF * BK * 2  , STAGE_BYTES = 8 * HTB, NXCD = 8, WGM = 8;

__host__ __device__ __forceinline__ int lds_byte(int r, int c) { const int st = (r >> 4) * 2 + (c >> 5), rr = r & 15, cc = c & 31, ob = rr * 64 + cc * 2; return st * 1024 + (ob ^ (((ob >> 9) & 1) << 5)); }
__host__ __device__ __forceinline__ void stage_rc(int b, int& R, int& C) { const int st = b / 1024, sb = b % 1024, swz = sb ^ (((sb >> 9) & 1) << 5); R = (st >> 1) * 16 + swz / 64; C = (st & 1) * 32 + (swz % 64) / 2; }
__host__ __device__ __forceinline__ int perm32(int rho) { const int n = rho >> 4, i = rho & 15; return 8 * (i >> 2) + 4 * n + (i & 3); }

struct Unit { int pm, pn; };
struct Gemm { const bf16_t* A; const bf16_t* Bt; int M, N, K; };

struct StaticOrder {
    int nM, nN, nwg, G, c;
    __host__ __device__ void init(int M, int N, int G_, int c_) { nM = M / BM; nN = N / BM; nwg = nM * nN; G = G_; c = c_; }
    __host__ __device__ bool next(int i, Unit& u) const {
        const long L = (long)i * G + c; if (L >= nwg) return false;
        int wgid = (int)L; { const int q = nwg / NXCD, r = nwg % NXCD, xcd = wgid % NXCD, off = wgid / NXCD; wgid = (xcd < r ? xcd * (q + 1) : r * (q + 1) + (xcd - r) * q) + off; }
        const int nig = WGM * nN, gid = wgid / nig, fm = gid * WGM, gsz = (nM - fm) < WGM ? (nM - fm) : WGM;
        u.pm = fm + ((wgid % nig) % gsz); u.pn = (wgid % nig) / gsz; return true;
    }
    __device__ __forceinline__ void a_ready(const Unit&) const {}
    __device__ __forceinline__ void done(const Unit&) const {}
};

__device__ __forceinline__ unsigned cvt_pk_bf16(float lo, float hi) { unsigned r; asm volatile("v_cvt_pk_bf16_f32 %0, %1, %2" : "=v"(r) : "v"(lo), "v"(hi)); return r; }
typedef float f32x2 __attribute__((ext_vector_type(2)));
__device__ __forceinline__ f32x2 gelu_pk(f32x2 v) {
    const f32x2 av = __builtin_elementwise_abs(v), d = av * 0.2316418882f + 1.0f;
    f32x2 t; t.x = __builtin_amdgcn_rcpf(d.x); t.y = __builtin_amdgcn_rcpf(d.y);
    f32x2 q = t * 0.5307027145f + (-0.7265760135f); q = q * t + 0.7107068705f; q = q * t + (-0.142248368f); q = q * t + 0.127414796f; q = q * t;
    const f32x2 s = (v * v) * (-0.72134752044f);
    f32x2 e; e.x = __builtin_amdgcn_exp2f(s.x); e.y = __builtin_amdgcn_exp2f(s.y);
    const f32x2 m = v * (q * e), r = v - m;
    f32x2 o; o.x = v.x < 0.f ? m.x : r.x; o.y = v.y < 0.f ? m.y : r.y; return o;
}

template <int ACT  > struct EpiBf16 {
    static constexpr bool PERM = true, AFTER_DRAIN = false; static_assert(ACT == 0 || ACT == 1, "EpiBf16: ACT is 0 (none) or 1 (gelu_pk)");
    bf16_t* O; int ldc; const float* bias; int split_cols; size_t split_stride; float scale0;
    __device__ __forceinline__ void operator()(const f32x4 (&acc)[2][2][4][2], const Unit& u, int wr, int wc, int fr, int fq) const {
        const int row0 = u.pm * BM + wr * 64 + fr; int colt = u.pn * BM; bf16_t* base = O;
        float sc = 1.f; if (split_cols) { const int t = colt / split_cols; base += (size_t)t * split_stride; colt -= t * split_cols; if (t == 0) sc = scale0; }
        const int col0 = colt + wc * 32 + 8 * fq, bcol0 = u.pn * BM + wc * 32 + 8 * fq;
        f32x4 bv[2][2];
#pragma unroll
        for (int bj = 0; bj < 2; ++bj)
#pragma unroll
            for (int n = 0; n < 2; ++n) bv[bj][n] = bias ? *(const f32x4*)(bias + bcol0 + bj * HALF + 4 * n) : (f32x4){0.f, 0.f, 0.f, 0.f};
#pragma unroll
        for (int ai = 0; ai < 2; ++ai)
#pragma unroll
            for (int m = 0; m < 4; ++m) { bf16_t* rowp = base + (size_t)(row0 + ai * HALF + m * 16) * ldc + col0;
#pragma unroll
                for (int bj = 0; bj < 2; ++bj) { f32x4 v0 = acc[ai][bj][m][0] + bv[bj][0], v1 = acc[ai][bj][m][1] + bv[bj][1];
                    if (ACT == 1) { f32x2 a = gelu_pk((f32x2){v0[0], v0[1]}), b = gelu_pk((f32x2){v0[2], v0[3]}), c = gelu_pk((f32x2){v1[0], v1[1]}), d = gelu_pk((f32x2){v1[2], v1[3]});
                        v0 = (f32x4){a.x, a.y, b.x, b.y}; v1 = (f32x4){c.x, c.y, d.x, d.y}; }
                    v0 = v0 * sc; v1 = v1 * sc; u32x4 w; w.x = cvt_pk_bf16(v0[0], v0[1]); w.y = cvt_pk_bf16(v0[2], v0[3]); w.z = cvt_pk_bf16(v1[0], v1[1]); w.w = cvt_pk_bf16(v1[2], v1[3]);
                    *(u32x4*)(rowp + bj * HALF) = w; } }
    }
};

struct PanelStats {
    unsigned* xbuf;
    unsigned* cnt;
    unsigned* tmo;
    int ntn; float eps;
    unsigned code;
    __device__ __forceinline__ bool run(const f32x4 (&v)[2][2][4][2], const Unit& u, int wr, int wc, int fr, int fq, PG8_LAS unsigned char* lds, int wid, int lane) const {
        typedef float f32x2v __attribute__((ext_vector_type(2)));
        PG8_LAS f32x2v* P = (PG8_LAS f32x2v*)lds;
        PG8_LAS f32x2v* S = (PG8_LAS f32x2v*)(lds + 8192);
        PG8_LAS unsigned* flag = (PG8_LAS unsigned*)(lds + 8192 + 2048);
#pragma unroll
        for (int ai = 0; ai < 2; ++ai)
#pragma unroll
            for (int m = 0; m < 4; ++m) {
                float s = 0.f;
#pragma unroll
                for (int bj = 0; bj < 2; ++bj)
#pragma unroll
                    for (int n = 0; n < 2; ++n) { const f32x4 x = v[ai][bj][m][n]; s += (x[0] + x[1]) + (x[2] + x[3]); }
                s += __shfl_xor(s, 16); s += __shfl_xor(s, 32);
                const float mw = s * (1.0f / 64.0f); float q = 0.f;
#pragma unroll
                for (int bj = 0; bj < 2; ++bj)
#pragma unroll
                    for (int n = 0; n < 2; ++n) { const f32x4 d = v[ai][bj][m][n] - mw; q += (d[0] * d[0] + d[1] * d[1]) + (d[2] * d[2] + d[3] * d[3]); }
                q += __shfl_xor(q, 16); q += __shfl_xor(q, 32);
                if (fq == 0) P[(ai * HALF + wr * 64 + m * 16 + fr) * 4 + wc] = (f32x2v){mw, q};
            }
        asm volatile("s_waitcnt lgkmcnt(0)" ::: "memory"); __builtin_amdgcn_s_barrier(); asm volatile("" ::: "memory");
#if defined(BROKEN_EXCHANGE_NO_WAIT)
#warning BROKEN CONTROL BUILD: the row-statistics exchange does not wait; results are wrong by design
        if (blockIdx.x >= 64) { const long long t0_ = clock64(); while (clock64() - t0_ < 60000) __builtin_amdgcn_s_sleep(8); }
#endif
        const int row = wid * 32 + (lane & 31);
        if (lane < 32) {
            const f32x2v a = P[row * 4 + 0], b = P[row * 4 + 1], c = P[row * 4 + 2], d = P[row * 4 + 3];
            const float mt = (a.x + b.x + c.x + d.x) * 0.25f;
            const float da = a.x - mt, db = b.x - mt, dc = c.x - mt, dd = d.x - mt;
            const float m2 = (a.y + b.y) + (c.y + d.y) + 64.0f * ((da * da + db * db) + (dc * dc + dd * dd));
            unsigned long long* slot = (unsigned long long*)xbuf + ((size_t)(u.pm * BM + row) * 4 + u.pn);
            __hip_atomic_store(slot, ((unsigned long long)__float_as_uint(m2) << 32) | __float_as_uint(mt), __ATOMIC_RELAXED, __HIP_MEMORY_SCOPE_AGENT);
        }
        asm volatile("s_waitcnt vmcnt(0)" ::: "memory");
        if (lane == 0) __hip_atomic_fetch_add(cnt + 64 * u.pm, 1u, __ATOMIC_RELAXED, __HIP_MEMORY_SCOPE_AGENT);
        if (wid == 0) {
            bool dead = false; const unsigned long long t0 = __builtin_amdgcn_s_memrealtime(); const unsigned want = 8u * (unsigned)ntn;
            for (;;) {
#if defined(BROKEN_EXCHANGE_NO_WAIT)
                break;
#endif
                if ((unsigned)__builtin_amdgcn_readfirstlane(__hip_atomic_load(cnt + 64 * u.pm, __ATOMIC_RELAXED, __HIP_MEMORY_SCOPE_AGENT)) >= want) break;
                if (__builtin_amdgcn_s_memrealtime() - t0 > 2000000ull) {
                    if (lane == 0) { unsigned expect = 0u; __hip_atomic_compare_exchange_strong(tmo + 1, &expect, code | (unsigned)(u.pm & 0xff), __ATOMIC_RELAXED, __ATOMIC_RELAXED, __HIP_MEMORY_SCOPE_AGENT);
                                     __hip_atomic_store(tmo, 1u, __ATOMIC_RELAXED, __HIP_MEMORY_SCOPE_AGENT); }
                    dead = true; break; }
                __builtin_amdgcn_s_sleep(2);
            }
            __builtin_amdgcn_fence(__ATOMIC_ACQUIRE, "agent");
            if (lane == 0) flag[0] = dead ? 1u : 0u;
        }
        asm volatile("s_waitcnt vmcnt(0) lgkmcnt(0)" ::: "memory"); __builtin_amdgcn_s_barrier(); asm volatile("" ::: "memory");
        const bool bad = flag[0] != 0u;
        if (lane < 32) {
            const unsigned long long* slot = (const unsigned long long*)xbuf + (size_t)(u.pm * BM + row) * 4; float mt[4], m2[4]; float ms = 0.f;
#pragma unroll
            for (int t = 0; t < 4; ++t) { if (t < ntn) { const unsigned long long w = __hip_atomic_load(slot + t, __ATOMIC_RELAXED, __HIP_MEMORY_SCOPE_AGENT); mt[t] = __uint_as_float((unsigned)w); m2[t] = __uint_as_float((unsigned)(w >> 32)); } else { mt[t] = 0.f; m2[t] = 0.f; } ms += mt[t]; }
            const float mean = ms / (float)ntn; float q = 0.f;
#pragma unroll
            for (int t = 0; t < 4; ++t) if (t < ntn) { const float dm = mt[t] - mean; q += m2[t] + 256.0f * dm * dm; }
            S[row] = (f32x2v){mean, 1.0f / sqrtf(q / (256.0f * (float)ntn) + eps)};
        }
        asm volatile("s_waitcnt lgkmcnt(0)" ::: "memory"); __builtin_amdgcn_s_barrier(); asm volatile("" ::: "memory");
        return bad;
    }
};
struct EpiLnRes {
    static constexpr bool PERM = false, AFTER_DRAIN = true;
    const float* base; float* out; int ldc; const float* bias; PanelStats st; unsigned poison;
    __device__ __forceinline__ void fused(f32x4 (&acc)[2][2][4][2], const Unit& u, int wr, int wc, int fr, int fq, PG8_LAS unsigned char* lds, int wid, int lane) const {
        typedef float f32x2v __attribute__((ext_vector_type(2)));
        const PG8_LAS f32x2v* S = (const PG8_LAS f32x2v*)(lds + 8192);
        const int col0 = u.pn * BM + wc * 32 + 4 * fq;
#pragma unroll
        for (int bj = 0; bj < 2; ++bj)
#pragma unroll
            for (int n = 0; n < 2; ++n) { const f32x4 bv = bias ? *(const f32x4*)(bias + col0 + bj * HALF + n * 16) : (f32x4){0.f, 0.f, 0.f, 0.f};
#pragma unroll
                for (int ai = 0; ai < 2; ++ai)
#pragma unroll
                    for (int m = 0; m < 4; ++m) acc[ai][bj][m][n] += bv; }
        f32x4 pre[4][2][2];
#pragma unroll
        for (int m = 0; m < 4; ++m) { const size_t off = (size_t)(u.pm * BM + wr * 64 + m * 16 + fr) * ldc + col0;
#pragma unroll
            for (int bj = 0; bj < 2; ++bj)
#pragma unroll
                for (int n = 0; n < 2; ++n) pre[m][bj][n] = *(const f32x4*)(base + off + bj * HALF + n * 16); }
        const bool bad = st.run(acc, u, wr, wc, fr, fq, lds, wid, lane) || poison != 0u;
        const float qnan = __builtin_nanf("");
#pragma unroll
        for (int ai = 0; ai < 2; ++ai)
#pragma unroll
            for (int m = 0; m < 4; ++m) { const int r = ai * HALF + wr * 64 + m * 16 + fr; const f32x2v sr = S[r]; const size_t off = (size_t)(u.pm * BM + r) * ldc + col0;
#pragma unroll
                for (int bj = 0; bj < 2; ++bj)
#pragma unroll
                    for (int n = 0; n < 2; ++n) { const f32x4 bs = ai == 0 ? pre[m][bj][n] : *(const f32x4*)(base + off + bj * HALF + n * 16); f32x4 o = bs + (acc[ai][bj][m][n] - sr.x) * sr.y;
                        if (bad) o = (f32x4){qnan, qnan, qnan, qnan}; *(f32x4*)(out + off + bj * HALF + n * 16) = o; }
                if (m & 1) asm volatile("" ::: "memory"); }
    }
};
struct EpiLnResLn {
    static constexpr bool PERM = false, AFTER_DRAIN = true;
    const float* base; float* out; bf16_t* xn; int ldc; const float* bias; PanelStats st1, st2; unsigned poison;
    __device__ __forceinline__ void fused(f32x4 (&acc)[2][2][4][2], const Unit& u, int wr, int wc, int fr, int fq, PG8_LAS unsigned char* lds, int wid, int lane) const {
        typedef float f32x2v __attribute__((ext_vector_type(2))); typedef unsigned u32x2v __attribute__((ext_vector_type(2)));
        const PG8_LAS f32x2v* S = (const PG8_LAS f32x2v*)(lds + 8192);
        const int col0 = u.pn * BM + wc * 32 + 4 * fq;
#pragma unroll
        for (int bj = 0; bj < 2; ++bj)
#pragma unroll
            for (int n = 0; n < 2; ++n) { const f32x4 bv = bias ? *(const f32x4*)(bias + col0 + bj * HALF + n * 16) : (f32x4){0.f, 0.f, 0.f, 0.f};
#pragma unroll
                for (int ai = 0; ai < 2; ++ai)
#pragma unroll
                    for (int m = 0; m < 4; ++m) acc[ai][bj][m][n] += bv; }
        bool bad = st1.run(acc, u, wr, wc, fr, fq, lds, wid, lane) || poison != 0u;
        const float qnan = __builtin_nanf("");
#pragma unroll
        for (int ai = 0; ai < 2; ++ai)
#pragma unroll
            for (int m = 0; m < 4; ++m) { const int r = ai * HALF + wr * 64 + m * 16 + fr; const f32x2v sr = S[r]; const size_t off = (size_t)(u.pm * BM + r) * ldc + col0;
#pragma unroll
                for (int bj = 0; bj < 2; ++bj)
#pragma unroll
                    for (int n = 0; n < 2; ++n) { const f32x4 bs = *(const f32x4*)(base + off + bj * HALF + n * 16); acc[ai][bj][m][n] = bs + (acc[ai][bj][m][n] - sr.x) * sr.y; }
                asm volatile("" : "+v"(acc[ai][0][m][0]), "+v"(acc[ai][0][m][1]), "+v"(acc[ai][1][m][0]), "+v"(acc[ai][1][m][1]));
                if (m & 1) asm volatile("" ::: "memory"); }
        const bool bad1 = bad;
        bad = st2.run(acc, u, wr, wc, fr, fq, lds, wid, lane) || bad;
#pragma unroll
        for (int ai = 0; ai < 2; ++ai)
#pragma unroll
            for (int m = 0; m < 4; ++m) { const int r = ai * HALF + wr * 64 + m * 16 + fr; const f32x2v sr = S[r]; const size_t off = (size_t)(u.pm * BM + r) * ldc + col0;
#pragma unroll
                for (int bj = 0; bj < 2; ++bj)
#pragma unroll
                    for (int n = 0; n < 2; ++n) { const f32x4 x1 = acc[ai][bj][m][n]; *(f32x4*)(out + off + bj * HALF + n * 16) = bad1 ? (f32x4){qnan, qnan, qnan, qnan} : x1;
                        const f32x4 o = (x1 - sr.x) * sr.y; u32x2v w; w.x = cvt_pk_bf16(o[0], o[1]); w.y = cvt_pk_bf16(o[2], o[3]);
                        if (bad) { w.x = 0x7fc07fc0u; w.y = 0x7fc07fc0u; } *(u32x2v*)(xn + off + bj * HALF + n * 16) = w; }
                asm volatile("" ::: "memory"); }
    }
};

template <class Epi, class Sched, bool ALIGN_EPI = false, bool SP2 = false>
__device__ __forceinline__ void gemm_phase(PG8_LAS unsigned char* lds, const Gemm g, const Sched& S, const Epi& E) {
    int tid_ = threadIdx.x; asm volatile("" : "+v"(tid_));
    const int tid = tid_, wid = __builtin_amdgcn_readfirstlane(tid >> 6), lane = tid & 63, wr = wid >> 2, wc = wid & 3, fr = lane & 15, fq = lane >> 4;
    const int K = g.K, nt = K / BK;
    unsigned voffA[2], voffB[2];
#pragma unroll
    for (int i = 0; i < 2; ++i) { int R, C; stage_rc(tid * 16 + i * 8192, R, C); const int Rb = Epi::PERM ? ((R & ~31) + perm32(R & 31)) : R;
        voffA[i] = (unsigned)(R * K + C) * 2u; voffB[i] = (unsigned)(Rb * K + C) * 2u; }
    const size_t kstep = (size_t)(BK * 2);
    const size_t hstep = (size_t)HALF * K * 2;
    const size_t tstep = 2 * hstep;
    const unsigned ldsw = (unsigned)wid * 1024u;
    const int aoff = lds_byte(wr * 64 + fr, fq * 8), boff = lds_byte(wc * 32 + fr, fq * 8);
#define PG8_SA(b, h) (((b) * 2 + (h)) * HTB)
#define PG8_SB(b, h) ((4 + (b) * 2 + (h)) * HTB)
#define PG8_STAGE(bufoff, gbase, voff) do { _Pragma("unroll") for (int _i = 0; _i < 2; ++_i) \
        __builtin_amdgcn_global_load_lds((const unsigned*)((const char*)(gbase) + (voff)[_i]), (PG8_LAS unsigned*)(lds + (bufoff) + ldsw + _i * 8192), 16, 0, 0); } while (0)
#define PG8_LDA(dst, b, h) do { _Pragma("unroll") for (int m = 0; m < 4; ++m) _Pragma("unroll") for (int k = 0; k < 2; ++k) dst[m][k] = *(const PG8_LAS bf16x8*)(lds + PG8_SA(b, h) + aoff + m * 2048 + k * 1024); } while (0)
#define PG8_LDB(dst, b, h) do { _Pragma("unroll") for (int n = 0; n < 2; ++n) _Pragma("unroll") for (int k = 0; k < 2; ++k) dst[n][k] = *(const PG8_LAS bf16x8*)(lds + PG8_SB(b, h) + boff + n * 2048 + k * 1024); } while (0)
#define PG8_MMA(ai, bj, At, Bt) do { __builtin_amdgcn_s_setprio(1); _Pragma("unroll") for (int m = 0; m < 4; ++m) _Pragma("unroll") for (int n = 0; n < 2; ++n) _Pragma("unroll") for (int k = 0; k < 2; ++k) \
        acc[ai][bj][m][n] = __builtin_amdgcn_mfma_f32_16x16x32_bf16(Bt[n][k], At[m][k], acc[ai][bj][m][n], 0, 0, 0); __builtin_amdgcn_s_setprio(0); } while (0)
#define PG8_WAIT_V(n) asm volatile("s_waitcnt vmcnt(" #n ")" ::: "memory")
#define PG8_WAIT_L(n) asm volatile("s_waitcnt lgkmcnt(" #n ")" ::: "memory")
#define PG8_BAR __builtin_amdgcn_s_barrier()
#define PG8_SCHED __builtin_amdgcn_sched_barrier(0)
    Unit cur, nxt; int ui = 0;
    if (!S.next(0, cur)) return;
    f32x4 acc[2][2][4][2];
#pragma unroll
    for (int a = 0; a < 2; ++a)
#pragma unroll
        for (int b = 0; b < 2; ++b)
#pragma unroll
            for (int m = 0; m < 4; ++m)
#pragma unroll
                for (int n = 0; n < 2; ++n) acc[a][b][m][n] = (f32x4){0.f, 0.f, 0.f, 0.f};
    bf16x8 At[4][2], B0[2][2], B1[2][2];
    const char* cA = (const char*)g.A + (size_t)cur.pm * tstep; const char* cB = (const char*)g.Bt + (size_t)cur.pn * tstep;
    S.a_ready(cur);
    if constexpr (SP2) {
        PG8_STAGE(PG8_SB(0, 0), cB, voffB); PG8_STAGE(PG8_SB(0, 1), cB + hstep, voffB); PG8_STAGE(PG8_SA(0, 0), cA, voffA); PG8_STAGE(PG8_SA(0, 1), cA + hstep, voffA);
        if (wr == 1) PG8_BAR;
        PG8_WAIT_V(2); PG8_BAR;
        PG8_STAGE(PG8_SB(1, 0), cB + kstep, voffB); PG8_STAGE(PG8_SA(1, 0), cA + kstep, voffA); PG8_STAGE(PG8_SB(1, 1), cB + hstep + kstep, voffB);
        PG8_WAIT_V(6); PG8_BAR;
    } else {
        PG8_STAGE(PG8_SB(0, 0), cB, voffB); PG8_STAGE(PG8_SA(0, 0), cA, voffA); PG8_STAGE(PG8_SB(0, 1), cB + hstep, voffB); PG8_STAGE(PG8_SA(0, 1), cA + hstep, voffA);
        if (wr == 1) PG8_BAR;
        PG8_WAIT_V(4); PG8_BAR;
        PG8_STAGE(PG8_SB(1, 0), cB + kstep, voffB); PG8_STAGE(PG8_SA(1, 0), cA + kstep, voffA); PG8_STAGE(PG8_SB(1, 1), cB + hstep + kstep, voffB);
        PG8_WAIT_V(6); PG8_BAR;
    }
    for (;;) {
        const bool has_next = S.next(ui + 1, nxt);
        const char* nA = has_next ? (const char*)g.A + (size_t)nxt.pm * tstep : cA; const char* nB = has_next ? (const char*)g.Bt + (size_t)nxt.pn * tstep : cB;
        for (int t = 0; t < nt; t += 2) {
            const bool last = (t == nt - 2);
            const char* a1 = cA + (size_t)(t + 1) * kstep;
            const char* a2 = last ? nA : cA + (size_t)(t + 2) * kstep; const char* b2 = last ? nB : cB + (size_t)(t + 2) * kstep;
            const char* a3 = a2 + kstep; const char* b3 = b2 + kstep;
            if (last && has_next) S.a_ready(nxt);
            if constexpr (SP2) {
            PG8_LDB(B0, 0, 0); PG8_LDB(B1, 0, 1); PG8_SCHED; PG8_LDA(At, 0, 0); PG8_STAGE(PG8_SA(1, 1), a1 + hstep, voffA);
            PG8_WAIT_V(8); PG8_WAIT_L(0); PG8_BAR; PG8_MMA(0, 0, At, B0); PG8_MMA(0, 1, At, B1); PG8_BAR; PG8_SCHED;
            PG8_LDA(At, 0, 1); PG8_STAGE(PG8_SB(0, 0), b2, voffB); PG8_STAGE(PG8_SB(0, 1), b2 + hstep, voffB); PG8_STAGE(PG8_SA(0, 0), a2, voffA);
            PG8_WAIT_V(8); PG8_WAIT_L(0); PG8_BAR; PG8_MMA(1, 0, At, B0); PG8_MMA(1, 1, At, B1); PG8_BAR; PG8_SCHED;
            PG8_LDB(B0, 1, 0); PG8_LDB(B1, 1, 1); PG8_SCHED; PG8_LDA(At, 1, 0); PG8_STAGE(PG8_SA(0, 1), a2 + hstep, voffA);
            PG8_WAIT_V(8); PG8_WAIT_L(0); PG8_BAR; PG8_MMA(0, 0, At, B0); PG8_MMA(0, 1, At, B1); PG8_BAR; PG8_SCHED;
            PG8_LDA(At, 1, 1); PG8_STAGE(PG8_SB(1, 0), b3, voffB); PG8_STAGE(PG8_SB(1, 1), b3 + hstep, voffB); PG8_STAGE(PG8_SA(1, 0), a3, voffA);
            PG8_WAIT_V(8); PG8_WAIT_L(0); PG8_BAR; PG8_MMA(1, 0, At, B0); PG8_MMA(1, 1, At, B1); PG8_BAR; PG8_SCHED;
            } else {
            PG8_LDB(B0, 0, 0); PG8_SCHED; PG8_LDA(At, 0, 0); PG8_STAGE(PG8_SA(1, 1), a1 + hstep, voffA);
            PG8_WAIT_L(8); PG8_BAR; PG8_WAIT_L(0); PG8_MMA(0, 0, At, B0); PG8_BAR; PG8_SCHED;
            PG8_LDB(B1, 0, 1); PG8_STAGE(PG8_SB(0, 0), b2, voffB);
            PG8_BAR; PG8_WAIT_L(0); PG8_MMA(0, 1, At, B1); PG8_BAR;
            PG8_LDA(At, 0, 1); PG8_STAGE(PG8_SA(0, 0), a2, voffA);
            PG8_BAR; PG8_WAIT_L(0); PG8_MMA(1, 0, At, B0); PG8_BAR; PG8_SCHED;
            PG8_STAGE(PG8_SB(0, 1), b2 + hstep, voffB);
            PG8_WAIT_V(6); PG8_BAR; PG8_MMA(1, 1, At, B1); PG8_BAR;
            PG8_LDB(B0, 1, 0); PG8_SCHED; PG8_LDA(At, 1, 0); PG8_STAGE(PG8_SA(0, 1), a2 + hstep, voffA);
            PG8_WAIT_L(8); PG8_BAR; PG8_WAIT_L(0); PG8_MMA(0, 0, At, B0); PG8_BAR; PG8_SCHED;
            PG8_LDB(B1, 1, 1); PG8_STAGE(PG8_SB(1, 0), b3, voffB);
            PG8_BAR; PG8_WAIT_L(0); PG8_MMA(0, 1, At, B1); PG8_BAR;
            PG8_LDA(At, 1, 1); PG8_STAGE(PG8_SA(1, 0), a3, voffA);
            PG8_BAR; PG8_WAIT_L(0); PG8_MMA(1, 0, At, B0); PG8_BAR; PG8_SCHED;
            PG8_STAGE(PG8_SB(1, 1), b3 + hstep, voffB);
            PG8_WAIT_V(6); PG8_BAR; PG8_MMA(1, 1, At, B1); PG8_BAR;
            }
        }
        if constexpr (ALIGN_EPI) { if (wr == 0) PG8_BAR; }
        if constexpr (!Epi::AFTER_DRAIN) { E(acc, cur, wr, wc, fr, fq); S.done(cur); }
        if (!has_next) break;
#pragma unroll
        for (int a = 0; a < 2; ++a)
#pragma unroll
            for (int b = 0; b < 2; ++b)
#pragma unroll
                for (int m = 0; m < 4; ++m)
#pragma unroll
                    for (int n = 0; n < 2; ++n) acc[a][b][m][n] = (f32x4){0.f, 0.f, 0.f, 0.f};
        cur = nxt; cA = nA; cB = nB; ++ui;
        if constexpr (ALIGN_EPI) { if (wr == 1) PG8_BAR; }
    }
    PG8_WAIT_V(0);
    if constexpr (!ALIGN_EPI) { if (wr == 0) PG8_BAR; }
    PG8_BAR;
    if constexpr (Epi::AFTER_DRAIN) { E.fused(acc, cur, wr, wc, fr, fq, lds, wid, lane); S.done(cur); }
#undef PG8_SA
#undef PG8_SB
#undef PG8_STAGE
#undef PG8_LDA
#undef PG8_LDB
#undef PG8_MMA
#undef PG8_WAIT_V
#undef PG8_WAIT_L
#undef PG8_BAR
#undef PG8_SCHED
}
}
namespace pg8 {
struct EpiResid {
    static constexpr bool PERM = false, AFTER_DRAIN = false;
    float* x; int ldc; float alpha;
    __device__ __forceinline__ void operator()(const f32x4 (&acc)[2][2][4][2], const Unit& u, int wr, int wc, int fr, int fq) const {
        const int col0 = u.pn * BM + wc * 32 + 4 * fq;
#pragma unroll
        for (int ai = 0; ai < 2; ++ai)
#pragma unroll
            for (int m = 0; m < 4; ++m) { const int r = ai * HALF + wr * 64 + m * 16 + fr; const size_t off = (size_t)(u.pm * BM + r) * ldc + col0;
#pragma unroll
                for (int bj = 0; bj < 2; ++bj)
#pragma unroll
                    for (int n = 0; n < 2; ++n) { float* p = x + off + bj * HALF + n * 16; f32x4 v = *(const f32x4*)p; v = v * alpha + acc[ai][bj][m][n]; *(f32x4*)p = v; }
                if (m & 1) asm volatile("" ::: "memory"); }
    }
};
}
#define PG8_SP2 true
#define PG8_ALIGN true
#include <hip/hip_bf16.h>
#include <cmath>
namespace attn_body {
using bf16=__hip_bfloat16;
using bf16x8=__attribute__((ext_vector_type(8)))short;
using s16x4=__attribute__((ext_vector_type(4)))short;
using f32x16=__attribute__((ext_vector_type(16)))float;
using u32x4=__attribute__((ext_vector_type(4)))unsigned;
constexpr int BATCH=2,NHEAD=16,SEQ=16384,D=64,DM=3328,DMO=1024;
constexpr int NW=8,QBLK=32,QB=QBLK*NW,KVBLK=64,NQB=SEQ/QB;
constexpr int ATTN_PITCH=DM, ATTN_UNIT_ROWS=QB;
__device__ __forceinline__ int crow(int r,int hi){return (r&3)+8*(r>>2)+4*hi;}
#define SBAR() __builtin_amdgcn_sched_barrier(0)
__device__ __forceinline__ void cmask(f32x16&p0,f32x16&p1,int jb,int qrel,int hi){
  const float NEG=-INFINITY; int kb=64*jb+4*hi;
  #pragma unroll
  for(int r=0;r<16;++r){int kv=kb+(r&3)+8*(r>>2); if(kv>qrel)p0[r]=NEG; if(kv+32>qrel)p1[r]=NEG;}
}

constexpr int NSLOT=3, SLOTB=8192;
constexpr int LDS_K=0, LDS_V=NSLOT*SLOTB, LDS_WS=2*NSLOT*SLOTB, LDS_OST=LDS_WS+NW*64*4, LDS_BYTES=LDS_OST+NW*4096;
constexpr float C2=0.125f*1.4426950408889634f;
__device__ __forceinline__ void glds16(const void*gsrc,unsigned lds_dst){unsigned keep;
  asm volatile("s_mov_b32 %0, m0\n\ts_mov_b32 m0, %2\n\ts_nop 0\n\tglobal_load_lds_dwordx4 %1, off\n\ts_mov_b32 m0, %0":"=&s"(keep):"v"(gsrc),"s"(lds_dst):"memory");}
__device__ __forceinline__ float max3f(float a,float b,float c){float r;asm("v_max3_f32 %0, %1, %2, %3":"=v"(r):"v"(a),"v"(b),"v"(c));return r;}
__device__ __forceinline__ float max2f(float a,float b){float r;asm("v_max_f32_e32 %0, %1, %2":"=v"(r):"v"(a),"v"(b));return r;}
__device__ __forceinline__ float fadd_s(float a,float b){float r;asm("v_add_f32_e32 %0, %1, %2":"=v"(r):"v"(a),"v"(b));return r;}
__device__ __forceinline__ float fsub_s(float a,float b){float r;asm("v_sub_f32_e32 %0, %1, %2":"=v"(r):"v"(a),"v"(b));return r;}
typedef float f32x2_t __attribute__((ext_vector_type(2))); typedef __bf16 bf16x2_t __attribute__((ext_vector_type(2)));
__device__ __forceinline__ unsigned cvtpk_s(float lo,float hi){f32x2_t v={lo,hi};bf16x2_t b=__builtin_convertvector(v,bf16x2_t);return __builtin_bit_cast(unsigned,b);}
#define WAIT_BAR(N) asm volatile("s_waitcnt vmcnt(" #N ") lgkmcnt(0)\n\ts_barrier":::"memory")

__device__ __forceinline__ void qkt(f32x16&p0,f32x16&p1,const char*Kslot,const bf16x8*qr,const f32x16&negm,int r32,int hi){
  const char*kb=Kslot+hi*1024+r32*16;
  #pragma unroll
  for(int d0=0;d0<4;++d0){
    const bf16x8 b0=*reinterpret_cast<const bf16x8*>(kb+d0*2048);
    const bf16x8 b1=*reinterpret_cast<const bf16x8*>(kb+d0*2048+512);
    if(d0==0){p0=__builtin_amdgcn_mfma_f32_32x32x16_bf16(b0,qr[0],negm,0,0,0);p1=__builtin_amdgcn_mfma_f32_32x32x16_bf16(b1,qr[0],negm,0,0,0);}
    else{p0=__builtin_amdgcn_mfma_f32_32x32x16_bf16(b0,qr[d0],p0,0,0,0);p1=__builtin_amdgcn_mfma_f32_32x32x16_bf16(b1,qr[d0],p1,0,0,0);}}
}
typedef __attribute__((address_space(3))) const char* lds_cptr;
typedef short v4i16_t __attribute__((ext_vector_type(4)));
__device__ __forceinline__ void kload8(bf16x8*kf,lds_cptr kp){
  kf[0]=*(const __attribute__((address_space(3))) bf16x8*)(kp);      kf[1]=*(const __attribute__((address_space(3))) bf16x8*)(kp+512);
  kf[2]=*(const __attribute__((address_space(3))) bf16x8*)(kp+2048); kf[3]=*(const __attribute__((address_space(3))) bf16x8*)(kp+2560);
  kf[4]=*(const __attribute__((address_space(3))) bf16x8*)(kp+4096); kf[5]=*(const __attribute__((address_space(3))) bf16x8*)(kp+4608);
  kf[6]=*(const __attribute__((address_space(3))) bf16x8*)(kp+6144); kf[7]=*(const __attribute__((address_space(3))) bf16x8*)(kp+6656);
}
__device__ __forceinline__ void kload2(bf16x8*kf,lds_cptr kp,int j){ kf[2*j]=*(const __attribute__((address_space(3))) bf16x8*)(kp+j*2048); kf[2*j+1]=*(const __attribute__((address_space(3))) bf16x8*)(kp+j*2048+512); }
__device__ __forceinline__ s16x4 vtr(lds_cptr p){ return __builtin_bit_cast(s16x4,__builtin_amdgcn_ds_read_tr16_b64_v4i16((__attribute__((address_space(3))) v4i16_t*)p)); }
__device__ __forceinline__ float rowmax(const f32x16&p0,const f32x16&p1){
  float a=max3f(p0[0],p0[1],p1[0]),b=max3f(p0[2],p0[3],p1[1]);a=max3f(a,p1[2],p1[3]);
  #pragma unroll
  for(int r=4;r<16;r+=4){a=max3f(a,p0[r],p0[r+1]);b=max3f(b,p0[r+2],p0[r+3]);a=max3f(a,p1[r],p1[r+1]);b=max3f(b,p1[r+2],p1[r+3]);}
  const float m=max2f(a,b);
  auto rr=__builtin_amdgcn_permlane32_swap(__float_as_uint(m),__float_as_uint(m),false,false);
  return max2f(__uint_as_float(rr[0]),__uint_as_float(rr[1]));
}
__device__ __forceinline__ void pv(f32x16*o,int vb,bf16x8 pa0,bf16x8 pa1,bf16x8 pa2,bf16x8 pa3){
  #pragma unroll
  for(int d0=0;d0<2;++d0){s16x4 lo[4],hi[4];
    #pragma unroll
    for(int ks=0;ks<4;++ks){
      asm volatile("ds_read_b64_tr_b16 %0,%1 offset:%c2":"=&v"(lo[ks]):"v"(vb),"i"(d0*4096+ks*1024):"memory");
      asm volatile("ds_read_b64_tr_b16 %0,%1 offset:%c2":"=&v"(hi[ks]):"v"(vb),"i"(d0*4096+ks*1024+512):"memory");}
    asm volatile("s_waitcnt lgkmcnt(0)":::"memory");SBAR();
    #define PK(k) (bf16x8){lo[k][0],lo[k][1],lo[k][2],lo[k][3],hi[k][0],hi[k][1],hi[k][2],hi[k][3]}
    o[d0]=__builtin_amdgcn_mfma_f32_32x32x16_bf16(pa0,PK(0),o[d0],0,0,0);
    o[d0]=__builtin_amdgcn_mfma_f32_32x32x16_bf16(pa1,PK(1),o[d0],0,0,0);
    o[d0]=__builtin_amdgcn_mfma_f32_32x32x16_bf16(pa2,PK(2),o[d0],0,0,0);
    o[d0]=__builtin_amdgcn_mfma_f32_32x32x16_bf16(pa3,PK(3),o[d0],0,0,0);
    #undef PK
  }
}

#ifndef ATTN_STORE16
#define ATTN_STORE16(p,v) (*(u32x4*)(p)=(v))
#endif
template<int THRL> __device__ __forceinline__ void attn_unit(int b,int h,int qb,const bf16*Q,const bf16*__restrict__ K,const bf16*__restrict__ V,bf16*O,char*shm){
  int tid_=threadIdx.x; asm volatile("":"+v"(tid_)); const int tid=tid_,lane=tid&63,r32=lane&31,hi=lane>>5; const int wid=__builtin_amdgcn_readfirstlane(tid>>6);
  const long rowbase=(long)b*SEQ; const int q0=qb*QB;
  const bf16*Qw=Q+(rowbase+q0+wid*QBLK)*DM+h*D;
  const bf16*Kh=K+rowbase*DM+h*D,*Vh=V+rowbase*DM+h*D;
  const unsigned lds0=(unsigned)(uintptr_t)shm;
  float*wsf=(float*)(shm+LDS_WS)+wid*64;
  const bf16*ksrc=Kh+(long)lane*DM+wid*8;
  const bf16*vsrc=Vh+(long)(16*(wid&3)+(lane>>2))*DM+(wid>>2)*32+(lane&3)*8;
  const unsigned kdst=lds0+LDS_K+wid*1024, vdst=lds0+LDS_V+wid*1024;
  #define DMA_K(t,slot) glds16(ksrc+(long)(t)*KVBLK*DM,(unsigned)__builtin_amdgcn_readfirstlane(kdst+(slot)))
  #define DMA_V(t,slot) glds16(vsrc+(long)(t)*KVBLK*DM,(unsigned)__builtin_amdgcn_readfirstlane(vdst+(slot)))
  const int vb0=(int)(lds0+LDS_V)+((lane>>4)&1)*32+(lane&3)*8+(4*hi+((lane&15)>>2))*64;
  const char*Kbase=shm+LDS_K; bf16x8 kf[8];
  const lds_cptr shm3=(lds_cptr)shm; const lds_cptr kp0=shm3+LDS_K+hi*1024+r32*16; const lds_cptr vp0=shm3+LDS_V+((lane>>4)&1)*32+(lane&3)*8+(4*hi+((lane&15)>>2))*64;
  const int NT=(q0+QB)/KVBLK;
  DMA_K(0,0);DMA_V(0,0);DMA_K(1,SLOTB);
  bf16x8 qr[4];
  #pragma unroll
  for(int d0=0;d0<4;++d0)qr[d0]=*reinterpret_cast<const bf16x8*>(&Qw[(long)r32*DM+d0*16+hi*8]);
  float mhat=0.f,l_reg=0.f;f32x16 o[2];o[0]=f32x16{};o[1]=f32x16{};f32x16 negm=f32x16{};asm volatile("":"+v"(negm));
  const int qrel=wid*QBLK+r32;
  #define CMASK(P0,P1,t) do{int jb_=(t)-(NT-4); if(jb_>=0)cmask(P0,P1,jb_,qrel,hi);}while(0)
  bool resc=false;
  #define START(P0,P1) do{ const float rm=rowmax(P0,P1); resc=false; \
    { const float dl=rm; mhat=fadd_s(mhat,dl); \
      _Pragma("unroll") for(int r=0;r<16;++r){P0[r]=fsub_s(P0[r],dl);P1[r]=fsub_s(P1[r],dl);} \
      _Pragma("unroll") for(int r=0;r<16;++r)negm[r]=-mhat; asm volatile("":"+v"(negm)); } \
    _Pragma("unroll") for(int r=0;r<16;++r)P0[r]=__builtin_amdgcn_exp2f(P0[r]); }while(0)
  #define RESC() do{ if(resc){ asm volatile("s_waitcnt lgkmcnt(0)":::"memory"); \
      _Pragma("unroll") for(int d_=0;d_<2;++d_) _Pragma("unroll") for(int r=0;r<16;++r)o[d_][r]*=wsf[crow(r,hi)]; } }while(0)
  f32x16 pA0,pA1,pB0,pB1;
  int sl_prev=0,sl_cur=0,sl_next=SLOTB;
  #define ROT() do{sl_prev=sl_cur;sl_cur=sl_next;sl_next=(sl_next==(NSLOT-1)*SLOTB)?0:sl_next+SLOTB;}while(0)
  DMA_K(2,2*SLOTB);
  WAIT_BAR(3);
  qkt(pA0,pA1,Kbase,qr,negm,r32,hi);asm volatile("s_nop 15\n\ts_nop 7":"+v"(pA0),"+v"(pA1));CMASK(pA0,pA1,0);
  START(pA0,pA1);
  _Pragma("unroll") for(int r=0;r<16;++r)pA1[r]=__builtin_amdgcn_exp2f(pA1[r]);
  WAIT_BAR(0);
  DMA_K(3,0);DMA_V(1,SLOTB);
  ROT();
  kload8(kf,kp0+sl_cur);
  WAIT_BAR(2);
  s16x4 vlo[8],vhi[8]; u32x4 pw0,pw1,pw2,pw3;
  #define PKW(P,B) cvtpk_s(P[B],P[B+1])
  #define PAF(k) __builtin_bit_cast(bf16x8,pw##k)
  #define VFR(i) (bf16x8){vlo[i][0],vlo[i][1],vlo[i][2],vlo[i][3],vhi[i][0],vhi[i][1],vhi[i][2],vhi[i][3]}
  #define PIN(x) asm volatile("":"+v"(x))
  #define MX3(a,b,c) __builtin_fmaxf(__builtin_fmaxf((a),(b)),(c))
  #define GAPA(MF,A0,A1,A2,A3,W0,W1,PW) do{ MF; sacc+=A0; sacc+=A1; sacc+=A2; sacc+=A3; PIN(sacc); W0; W1; PIN(PW); SBAR(); }while(0)
  #define EX(v) __builtin_amdgcn_exp2f(v)
  #define GAPB(MF,X,B) do{ MF; X[B]=EX(X[B]); X[B+1]=EX(X[B+1]); X[B+2]=EX(X[B+2]); X[B+3]=EX(X[B+3]); PIN(X); SBAR(); }while(0)
  #define VRD(i) do{ vlo[i]=vtr(vp_+(((i)>>2)*4096+((i)&3)*1024)); vhi[i]=vtr(vp_+(((i)>>2)*4096+((i)&3)*1024+512)); }while(0)
  #define KRD(G,j) do{ if(G){ kload2(kf,kp0+sl_next,j); SBAR(); } }while(0)
  #define STEP(C0,C1,P0,P1,t,GK,GV,GL) do{ SBAR(); \
    const lds_cptr vp_=vp0+sl_prev; \
    VRD(0); SBAR(); float sacc=(P0[0]+P0[1]); \
    GAPA(C0=__builtin_amdgcn_mfma_f32_32x32x16_bf16(kf[0],qr[0],negm,0,0,0), P0[2],P0[3],P0[4],P0[5],     pw0[0]=PKW(P0,0), pw0[1]=PKW(P0,2), pw0); \
    VRD(4); SBAR(); GAPA(C1=__builtin_amdgcn_mfma_f32_32x32x16_bf16(kf[1],qr[0],negm,0,0,0), P0[6],P0[7],P0[8],P0[9],     pw0[2]=PKW(P0,4), pw0[3]=PKW(P0,6), pw0); \
    VRD(1); SBAR(); GAPA(C0=__builtin_amdgcn_mfma_f32_32x32x16_bf16(kf[2],qr[1],C0,0,0,0),   P0[10],P0[11],P0[12],P0[13], pw1[0]=PKW(P0,8), pw1[1]=PKW(P0,10), pw1); \
    VRD(5); SBAR(); GAPA(C1=__builtin_amdgcn_mfma_f32_32x32x16_bf16(kf[3],qr[1],C1,0,0,0),   P0[14],P0[15],P1[0],P1[1],   pw1[2]=PKW(P0,12),pw1[3]=PKW(P0,14), pw1); \
    VRD(2); SBAR(); GAPA(C0=__builtin_amdgcn_mfma_f32_32x32x16_bf16(kf[4],qr[2],C0,0,0,0),   P1[2],P1[3],P1[4],P1[5],     pw2[0]=PKW(P1,0), pw2[1]=PKW(P1,2), pw2); \
    VRD(6); SBAR(); GAPA(C1=__builtin_amdgcn_mfma_f32_32x32x16_bf16(kf[5],qr[2],C1,0,0,0),   P1[6],P1[7],P1[8],P1[9],     pw2[2]=PKW(P1,4), pw2[3]=PKW(P1,6), pw2); \
    VRD(3); SBAR(); GAPA(C0=__builtin_amdgcn_mfma_f32_32x32x16_bf16(kf[6],qr[3],C0,0,0,0),   P1[10],P1[11],P1[12],P1[13], pw3[0]=PKW(P1,8), pw3[1]=PKW(P1,10), pw3); \
    VRD(7); SBAR(); GAPA(C1=__builtin_amdgcn_mfma_f32_32x32x16_bf16(kf[7],qr[3],C1,0,0,0),   P1[14],P1[15],0.f,0.f,       pw3[2]=PKW(P1,12),pw3[3]=PKW(P1,14), pw3); \
    l_reg+=sacc; \
    if(GK){DMA_K((t)+3,sl_cur);} if(GV){DMA_V((t)+1,sl_next);} \
    CMASK(C0,C1,t); \
    { float a=MX3(C0[0],C0[1],C1[0]),b=MX3(C0[2],C0[3],C1[1]); a=MX3(a,C1[2],C1[3]); \
      _Pragma("unroll") for(int r=4;r<16;r+=4){a=MX3(a,C0[r],C0[r+1]);b=MX3(b,C0[r+2],C0[r+3]);a=MX3(a,C1[r],C1[r+1]);b=MX3(b,C1[r+2],C1[r+3]);} \
      float rm=__builtin_fmaxf(a,b); { auto rr=__builtin_amdgcn_permlane32_swap(__float_as_uint(rm),__float_as_uint(rm),false,false); rm=__builtin_fmaxf(__uint_as_float(rr[0]),__uint_as_float(rr[1])); } \
      resc=false; \
      if(__builtin_expect(__any(rm>(float)THRL),0)){ const float dl=__builtin_fmaxf(rm,0.f); mhat+=dl; \
        _Pragma("unroll") for(int r=0;r<16;++r){C0[r]-=dl;C1[r]-=dl;} \
        _Pragma("unroll") for(int r=0;r<16;++r)negm[r]=-mhat; asm volatile("":"+v"(negm)); \
        const float f=__builtin_amdgcn_exp2f(-dl); l_reg*=f; if(hi==0)wsf[r32]=f; resc=true; } } \
    SBAR(); \
    GAPB(o[0]=__builtin_amdgcn_mfma_f32_32x32x16_bf16(PAF(0),VFR(0),o[0],0,0,0), C0,0); \
    GAPB(o[1]=__builtin_amdgcn_mfma_f32_32x32x16_bf16(PAF(0),VFR(4),o[1],0,0,0), C0,4); \
    KRD(GL,0); GAPB(o[0]=__builtin_amdgcn_mfma_f32_32x32x16_bf16(PAF(1),VFR(1),o[0],0,0,0), C0,8); \
    KRD(GL,1); GAPB(o[1]=__builtin_amdgcn_mfma_f32_32x32x16_bf16(PAF(1),VFR(5),o[1],0,0,0), C0,12); \
    KRD(GL,2); GAPB(o[0]=__builtin_amdgcn_mfma_f32_32x32x16_bf16(PAF(2),VFR(2),o[0],0,0,0), C1,0); \
    KRD(GL,3); GAPB(o[1]=__builtin_amdgcn_mfma_f32_32x32x16_bf16(PAF(2),VFR(6),o[1],0,0,0), C1,4); \
    GAPB(o[0]=__builtin_amdgcn_mfma_f32_32x32x16_bf16(PAF(3),VFR(3),o[0],0,0,0), C1,8); \
    GAPB(o[1]=__builtin_amdgcn_mfma_f32_32x32x16_bf16(PAF(3),VFR(7),o[1],0,0,0), C1,12); \
    }while(0)
  int t=1;
  #undef CMASK
  #define CMASK(P0,P1,t) do{}while(0)
  for(;t+5<NT;t+=2){
    STEP(pB0,pB1,pA0,pA1,t,true,true,true);     WAIT_BAR(2); RESC(); ROT();
    STEP(pA0,pA1,pB0,pB1,t+1,true,true,true);   WAIT_BAR(2); RESC(); ROT();
  }
  #undef CMASK
  #define CMASK(P0,P1,t) do{int jb_=(t)-(NT-4); if(jb_>=0)cmask(P0,P1,jb_,qrel,hi);}while(0)
  #define ENDW(tt) do{ if((tt)+3<NT){WAIT_BAR(2);} else if((tt)+2<NT){WAIT_BAR(1);} else {WAIT_BAR(0);} }while(0)
  for(;t+1<NT;t+=2){
    STEP(pB0,pB1,pA0,pA1,t,(t+3<NT),(t+1<NT),(t+1<NT));       ENDW(t);   RESC(); ROT();
    STEP(pA0,pA1,pB0,pB1,t+1,(t+4<NT),(t+2<NT),(t+2<NT));     ENDW(t+1); RESC(); ROT();
  }
  STEP(pB0,pB1,pA0,pA1,NT-1,false,false,false); RESC();
  { float sacc=pB0[0]+pB0[1]; _Pragma("unroll") for(int r=2;r<16;++r)sacc+=pB0[r]; _Pragma("unroll") for(int r=0;r<16;++r)sacc+=pB1[r]; l_reg+=sacc;
    pw0=(u32x4){PKW(pB0,0),PKW(pB0,2),PKW(pB0,4),PKW(pB0,6)};pw1=(u32x4){PKW(pB0,8),PKW(pB0,10),PKW(pB0,12),PKW(pB0,14)};pw2=(u32x4){PKW(pB1,0),PKW(pB1,2),PKW(pB1,4),PKW(pB1,6)};pw3=(u32x4){PKW(pB1,8),PKW(pB1,10),PKW(pB1,12),PKW(pB1,14)};
    SBAR(); pv(o,vb0+sl_cur,PAF(0),PAF(1),PAF(2),PAF(3)); }
  #undef PKW
  #undef PAF
  #undef VFR
  #undef PIN
  #undef MX3
  #undef GAPA
  #undef GAPB
  #undef EX
  #undef VRD
  #undef KRD
  #undef STEP
  #undef ENDW
  {auto rr=__builtin_amdgcn_permlane32_swap(__float_as_uint(l_reg),__float_as_uint(l_reg),false,false);l_reg=__uint_as_float(rr[0])+__uint_as_float(rr[1]);}
  if(hi==0)wsf[32+r32]=l_reg;asm volatile("s_waitcnt lgkmcnt(0)":::"memory");
  float rli[16];
  #pragma unroll
  for(int r=0;r<16;++r)rli[r]=__builtin_amdgcn_rcpf(wsf[32+crow(r,hi)]);
  bf16*Ow=O+(rowbase+q0+wid*QBLK)*DMO+h*D;
  { bf16*stg=(bf16*)(shm+LDS_OST)+wid*2048;
    #pragma unroll
    for(int r=0;r<16;++r){const int orow=crow(r,hi);
      #pragma unroll
      for(int d0=0;d0<2;++d0)stg[orow*64+d0*32+r32]=__float2bfloat16(o[d0][r]*rli[r]);}
    asm volatile("s_waitcnt lgkmcnt(0)":::"memory");
    #pragma unroll
    for(int i=0;i<4;++i){const int row=i*8+(lane>>3),ch=lane&7; const u32x4 v=*(const u32x4*)(stg+row*64+ch*8); ATTN_STORE16(Ow+(long)row*DMO+ch*8,v);} }
  asm volatile("s_waitcnt lgkmcnt(0)\n\ts_barrier":::"memory");
  #undef DMA_K
  #undef DMA_V
  #undef CMASK
  #undef START
  #undef RESC
  #undef ROT
}
constexpr int ATTN_LDS_BYTES=LDS_BYTES;
#undef SBAR
#undef WAIT_BAR
}
#define LAS __attribute__((address_space(3)))
#define XB_TMO      128
#define XB_XCNT(j)  (256  + 64 * (j))
#define XB_XSUB(j)  (1280 + 64 * (j))
#define XB_XGEN(j)  (2304 + 64 * (j))
#define XB_TOP      3328
#define XB_TOPGEN   3392
#define XCD_BAR_WORDS 3456
#define XB_SPIN_CAP (1u << 18)

__device__ __forceinline__ unsigned xb_ld(unsigned* p)              { return __hip_atomic_load(p, __ATOMIC_RELAXED, __HIP_MEMORY_SCOPE_AGENT); }
__device__ __forceinline__ unsigned xb_add(unsigned* p, unsigned v) { return __hip_atomic_fetch_add(p, v, __ATOMIC_RELAXED, __HIP_MEMORY_SCOPE_AGENT); }
__device__ __forceinline__ unsigned xb_xcc_id() { return (unsigned)__builtin_amdgcn_s_getreg((3 << 11) | 20) & 0xFu; }
#define XB_SPIN(cond, bar) do { unsigned _sp = 0; while (cond) { __builtin_amdgcn_s_sleep(1); \
    if ((++_sp & 255u) == 0u) { if (xb_ld(&(bar)[XB_TMO])) break; if (_sp > XB_SPIN_CAP) { atomicAdd(&(bar)[XB_TMO], 1u); break; } } } } while (0)

struct XcdBarrier {
    unsigned* bar; unsigned x;
    volatile LAS unsigned* st;
};

__device__ __forceinline__ XcdBarrier xcd_barrier_post(unsigned* bar, volatile LAS unsigned* st) {
    XcdBarrier b; b.bar = bar; b.x = xb_xcc_id(); b.st = st;
    if (threadIdx.x == 0) (void)xb_add(&bar[XB_XCNT(b.x)], 1u);
    return b;
}
__device__ __forceinline__ void xcd_barrier_complete(unsigned* bar, unsigned x, unsigned& nloc, unsigned& nx) {
    const unsigned G = gridDim.x * gridDim.y * gridDim.z;
    unsigned sum, cnt, mine, sp = 0u;
    for (;;) {
        sum = 0u; cnt = 0u; mine = 0u;
#pragma unroll
        for (unsigned j = 0; j < 16; ++j) { const unsigned c = xb_ld(&bar[XB_XCNT(j)]); sum += c; cnt += (c > 0u) ? 1u : 0u; mine = (j == x) ? c : mine; }
        if (sum == G) break;
        __builtin_amdgcn_s_sleep(1);
        if ((++sp & 255u) == 0u) { if (xb_ld(&bar[XB_TMO])) break; if (sp > XB_SPIN_CAP) { atomicAdd(&bar[XB_TMO], 1u); break; } }
    }
    nloc = mine > 0u ? mine : 1u; nx = cnt > 0u ? cnt : 1u;
}

__device__ __forceinline__ void xcd_barrier(const XcdBarrier& b) {
    asm volatile("s_waitcnt vmcnt(0)" ::: "memory");
    __syncthreads();
    if (threadIdx.x == 0) {
        unsigned* bar = b.bar;
        __builtin_amdgcn_s_waitcnt(0);
        unsigned nloc = b.st[0], nx = b.st[1];
        if (nloc == 0u) { xcd_barrier_complete(bar, b.x, nloc, nx); b.st[0] = nloc; b.st[1] = nx; }
        const unsigned old = xb_add(&bar[XB_XSUB(b.x)], 1u);
        const unsigned gen = old / nloc;
        if (old + 1u == (gen + 1u) * nloc) {
            __builtin_amdgcn_fence(__ATOMIC_RELEASE, "agent");
            asm volatile("s_waitcnt vmcnt(0)" ::: "memory");
            const unsigned og = xb_add(&bar[XB_TOP], 1u);
            const unsigned tg = og / nx;
            if (og + 1u == (tg + 1u) * nx) xb_add(&bar[XB_TOPGEN], 1u);
            else XB_SPIN(xb_ld(&bar[XB_TOPGEN]) == tg, bar);
            __builtin_amdgcn_fence(__ATOMIC_ACQUIRE, "agent");
            xb_add(&bar[XB_XGEN(b.x)], 1u);
            asm volatile("s_waitcnt vmcnt(0)" ::: "memory");
        } else {
            XB_SPIN(xb_ld(&bar[XB_XGEN(b.x)]) == gen, bar);
            __builtin_amdgcn_fence(__ATOMIC_ACQUIRE, "agent");
            asm volatile("s_waitcnt vmcnt(0)" ::: "memory");
        }
    }
    __syncthreads();
}
typedef unsigned short bf16;
typedef unsigned v4u __attribute__((ext_vector_type(4)));
typedef unsigned v2u __attribute__((ext_vector_type(2)));
typedef float f32x4 __attribute__((ext_vector_type(4)));
typedef float f32x2 __attribute__((ext_vector_type(2)));
typedef short bf16x8 __attribute__((ext_vector_type(8)));

constexpr int NTOK = 32768, DMOD = 1024, SEQL = 16384, PW = 3328, DFF = 2816;
constexpr float ALPHA = 1.681792830507429f;
constexpr size_t MiB = 1u << 20;
constexpr size_t WS_WIN = 0, WS_WOUT = 7 * MiB, WS_WUP = 9 * MiB, WS_WDN = 20 * MiB, WS_WSP = 26 * MiB;
constexpr size_t WS_XN = 32 * MiB, WS_P = 96 * MiB, WS_GH = 304 * MiB, WS_CAT = 432 * MiB;
constexpr size_t WS_GATE = 96 * MiB, WS_VAL = 272 * MiB, WS_U = 96 * MiB, WS_V = 160 * MiB, WS_END = 496 * MiB;
constexpr int LDS_TOTAL = 147456;
constexpr size_t WS_CTL = 28 * MiB;
constexpr int NTHR = 512;

__device__ __forceinline__ float bflo(unsigned w) { return __uint_as_float(w << 16); }
__device__ __forceinline__ float bfhi(unsigned w) { return __uint_as_float(w & 0xffff0000u); }
__device__ __forceinline__ unsigned f2bf(float f) { unsigned u = __float_as_uint(f); return (u + 0x7fffu + ((u >> 16) & 1u)) >> 16; }
__device__ __forceinline__ unsigned pk2(float lo, float hi) { return f2bf(lo) | (f2bf(hi) << 16); }
__device__ __forceinline__ void unpack8(const v4u w, float* o) { o[0] = bflo(w.x); o[1] = bfhi(w.x); o[2] = bflo(w.y); o[3] = bfhi(w.y); o[4] = bflo(w.z); o[5] = bfhi(w.z); o[6] = bflo(w.w); o[7] = bfhi(w.w); }
__device__ __forceinline__ v4u pack8(const float* o) { v4u w; w.x = pk2(o[0], o[1]); w.y = pk2(o[2], o[3]); w.z = pk2(o[4], o[5]); w.w = pk2(o[6], o[7]); return w; }
__device__ __forceinline__ float wave_sum(float v) {
#pragma unroll
    for (int o = 1; o < 64; o <<= 1) v += __shfl_xor(v, o);
    return v;
}
__device__ __forceinline__ int opaque_tid() { int t = threadIdx.x; asm volatile("" : "+v"(t)); return t; }
#define TIDS const int tid = opaque_tid(), lane = tid & 63, wave = __builtin_amdgcn_readfirstlane(tid >> 6); (void)lane; (void)wave
#if defined(SEC_B)
#define SECT(n) do { if (tid == 0) { volatile unsigned long long* pa_ = (volatile unsigned long long*)((char*)sm + (LDS_TOTAL - 48)); \
    if ((n) == SEC_E || (n) == SEC_E2) pa_[0] += __builtin_amdgcn_s_memrealtime() - pa_[1]; if ((n) == SEC_B || (n) == SEC_B2) pa_[1] = __builtin_amdgcn_s_memrealtime(); } } while (0)
#else
#define SECT(n) do {} while (0)
#endif
__device__ __forceinline__ float sigmoidf_(float x) { return 1.f / (1.f + __expf(-x)); }
__device__ __forceinline__ float tanhf_(float x) { const float e = __expf(2.f * x); return 1.f - 2.f / (e + 1.f); }

__device__ __forceinline__ void transpose_item(const float* W, int K, int N, bf16* WT, LAS float* scr, int item, int lane) {
    const int nblk = N / 32, kb = item / nblk, nb = item % nblk, k0 = 64 * kb, n0 = 32 * nb;
#pragma unroll 8
    for (int i = 0; i < 32; ++i) { const int kk = 2 * i + (lane >> 5); scr[kk * 33 + (lane & 31)] = W[(size_t)(k0 + kk) * N + n0 + (lane & 31)]; }
    asm volatile("s_waitcnt lgkmcnt(0)" ::: "memory");
    const int c = lane & 7;
#pragma unroll
    for (int j = 0; j < 4; ++j) { const int n = (lane >> 3) + 8 * j; const LAS float* s = scr + (8 * c) * 33 + n;
        v4u o; o.x = pk2(s[0 * 33], s[1 * 33]); o.y = pk2(s[2 * 33], s[3 * 33]); o.z = pk2(s[4 * 33], s[5 * 33]); o.w = pk2(s[6 * 33], s[7 * 33]);
        *(v4u*)(WT + (size_t)(n0 + n) * K + k0 + 8 * c) = o; }
    asm volatile("s_waitcnt lgkmcnt(0)" ::: "memory");
}

constexpr int LD = 68, BUFF = 64 * LD;
__device__ __forceinline__ int mm_tm(int wave) { return wave < 4 ? (wave >> 1) : 3 - ((wave - 4) >> 1); }
struct KMin { const float* p; __device__ __forceinline__ f32x4 ld(int idx, int k) const { return *(const f32x4*)(p + idx * LD + k); } };
struct KMaj { const float* p; __device__ __forceinline__ f32x4 ld(int idx, int k) const { f32x4 v; v[0] = p[k * LD + idx]; v[1] = p[(k + 1) * LD + idx]; v[2] = p[(k + 2) * LD + idx]; v[3] = p[(k + 3) * LD + idx]; return v; } };
template <int KD, bool TRI  , class OA, class OB>
__device__ __forceinline__ void mm_acc_t(f32x4& c0, f32x4& c1, int wave, int lane, OA oa, OB ob) {
    const int tm = mm_tm(wave), tn0 = (wave & 1) * 2, li = lane & 15, lk = lane >> 4;
    const int kend = TRI ? 16 * (tm + 1) : KD;
    f32x4 a = oa.ld(tm * 16 + li, 4 * lk), b0 = ob.ld(tn0 * 16 + li, 4 * lk), b1 = ob.ld(tn0 * 16 + 16 + li, 4 * lk);
#pragma nounroll
    for (int kb = 0; kb < kend; kb += 16) {
        const int kn = ((kb + 16 < kend) ? kb + 16 : kb) + 4 * lk;
        const f32x4 an = oa.ld(tm * 16 + li, kn), b0n = ob.ld(tn0 * 16 + li, kn), b1n = ob.ld(tn0 * 16 + 16 + li, kn);
#pragma unroll
        for (int q = 0; q < 4; ++q) { c0 = __builtin_amdgcn_mfma_f32_16x16x4f32(a[q], b0[q], c0, 0, 0, 0); c1 = __builtin_amdgcn_mfma_f32_16x16x4f32(a[q], b1[q], c1, 0, 0, 0); }
        a = an; b0 = b0n; b1 = b1n;
    }
}
template <int KD, class OA, class OB>
__device__ __forceinline__ void mm_acc(f32x4& c0, f32x4& c1, int wave, int lane, OA oa, OB ob) { mm_acc_t<KD, false>(c0, c1, wave, lane, oa, ob); }
template <class FC>
__device__ __forceinline__ void mm_store(const f32x4& c0, const f32x4& c1, int wave, int lane, FC fc) {
    const int tm = mm_tm(wave), tn0 = (wave & 1) * 2, li = lane & 15, lk = lane >> 4;
#pragma unroll
    for (int r = 0; r < 4; ++r) { fc(tm * 16 + 4 * lk + r, tn0 * 16 + li, c0[r]); fc(tm * 16 + 4 * lk + r, tn0 * 16 + 16 + li, c1[r]); }
}

struct LsRaw { v4u cur, prv; };
__device__ __forceinline__ LsRaw ls_issue(const bf16* P, int tok0, int col0, bool seq_start, int tid) {
    const int row = tid >> 3, c8 = (tid & 7) * 8;
    const bf16* pr = P + (size_t)(tok0 + row) * PW + col0 + c8;
    LsRaw r; r.cur = *(const v4u*)pr; r.prv = (v4u){0u, 0u, 0u, 0u};
    if (!(seq_start && row == 0)) r.prv = *(const v4u*)(pr - PW);
    return r;
}
template <int ACT  >
__device__ __forceinline__ void ls_commit(float* dst, const LsRaw& r, const float* mu  , int tid) {
    const int row = tid >> 3, c8 = (tid & 7) * 8;
    float c[8], p[8]; unpack8(r.cur, c); unpack8(r.prv, p);
    const f32x4 m0 = *(const f32x4*)(mu + c8), m1 = *(const f32x4*)(mu + c8 + 4);
    const float m[8] = {m0[0], m0[1], m0[2], m0[3], m1[0], m1[1], m1[2], m1[3]};
    float x[8];
#pragma unroll
    for (int e = 0; e < 8; ++e) { x[e] = c[e] + m[e] * (p[e] - c[e]); if (ACT == 1) x[e] = tanhf_(x[e]); if (ACT == 2) x[e] = sigmoidf_(x[e]); }
    *(f32x4*)(dst + row * LD + c8) = (f32x4){x[0], x[1], x[2], x[3]}; *(f32x4*)(dst + row * LD + c8 + 4) = (f32x4){x[4], x[5], x[6], x[7]};
}
struct WRaw { f32x4 a, b; };
__device__ __forceinline__ WRaw w_issue(const float* W, int ldw, int row0, int col0, int tid) {
    const int row = tid >> 3, c8 = (tid & 7) * 8; const float* s = W + (size_t)(row0 + row) * ldw + col0 + c8;
    WRaw r; r.a = *(const f32x4*)s; r.b = *(const f32x4*)(s + 4); return r;
}
__device__ __forceinline__ void w_commit(float* dst, const WRaw& r, int tid) {
    const int row = tid >> 3, c8 = (tid & 7) * 8; *(f32x4*)(dst + row * LD + c8) = r.a; *(f32x4*)(dst + row * LD + c8 + 4) = r.b;
}
template <int K, class FA, class FB>
__device__ __forceinline__ f32x4 tile_mm(int lane, FA fa, FB fb) {
    const int li = lane & 15, lk = lane >> 4; f32x4 acc = {0.f, 0.f, 0.f, 0.f};
#pragma unroll
    for (int k0 = 0; k0 < K; k0 += 4) acc = __builtin_amdgcn_mfma_f32_16x16x4f32(fa(li, k0 + lk), fb(k0 + lk, li), acc, 0, 0, 0);
    return acc;
}
__device__ __forceinline__ void tri_inverse(float* T, const float* A, float* M, int tid, int wave, int lane) {
    for (int i = tid; i < 64 * LD; i += NTHR) T[i] = 0.f;
    __syncthreads();
    if (tid < 64) { const int d = tid >> 4, j = tid & 15; const float* Ad = A + (16 * d) * LD + 16 * d; float x[16];
#pragma unroll
        for (int t = 0; t < 16; ++t) { float acc = (t == j) ? 1.f : 0.f;
            f32x4 rw[4];
#pragma unroll
            for (int q4 = 0; q4 < 4; ++q4) if (4 * q4 < t) rw[q4] = *(const f32x4*)(Ad + t * LD + 4 * q4);
#pragma unroll
            for (int q = 0; q < t; ++q) acc += rw[q >> 2][q & 3] * x[q];
            x[t] = acc; asm volatile("" ::: "memory"); }
#pragma unroll
        for (int t = 0; t < 16; ++t) T[(16 * d + t) * LD + 16 * d + j] = x[t];
    }
    __syncthreads();
    const int li = lane & 15, lk = lane >> 4;
    if (wave < 2) { const int r0 = 16 * (2 * wave + 1), c0 = 16 * (2 * wave);
        const f32x4 acc = tile_mm<16>(lane, [=](int i, int k) { return A[(r0 + i) * LD + c0 + k]; }, [=](int k, int jj) { return T[(c0 + k) * LD + c0 + jj]; });
#pragma unroll
        for (int r = 0; r < 4; ++r) M[(r0 + 4 * lk + r) * LD + c0 + li] = acc[r]; }
    __syncthreads();
    if (wave < 2) { const int r0 = 16 * (2 * wave + 1), c0 = 16 * (2 * wave);
        const f32x4 acc = tile_mm<16>(lane, [=](int i, int k) { return T[(r0 + i) * LD + r0 + k]; }, [=](int k, int jj) { return M[(r0 + k) * LD + c0 + jj]; });
#pragma unroll
        for (int r = 0; r < 4; ++r) T[(r0 + 4 * lk + r) * LD + c0 + li] = acc[r]; }
    __syncthreads();
    if (wave < 4) { const int r0 = 32 + 16 * (wave >> 1), c0 = 16 * (wave & 1);
        const f32x4 acc = tile_mm<32>(lane, [=](int i, int k) { return A[(r0 + i) * LD + k]; }, [=](int k, int jj) { return T[k * LD + c0 + jj]; });
#pragma unroll
        for (int r = 0; r < 4; ++r) M[(r0 + 4 * lk + r) * LD + c0 + li] = acc[r]; }
    __syncthreads();
    if (wave < 4) { const int r0 = 32 + 16 * (wave >> 1), c0 = 16 * (wave & 1);
        const f32x4 acc = tile_mm<32>(lane, [=](int i, int k) { return T[(r0 + i) * LD + 32 + k]; }, [=](int k, int jj) { return M[(32 + k) * LD + c0 + jj]; });
#pragma unroll
        for (int r = 0; r < 4; ++r) T[(r0 + 4 * lk + r) * LD + c0 + li] = acc[r]; }
    __syncthreads();
}

struct RwkvW { const float *mu, *w0, *w2, *a0, *a2, *g2, *kk, *ka, *rk, *lg, *lb; };

constexpr int PK = 0, PV = 64, PXW = 128, PXA = 192, PR = 256, PXG = 320, PW0 = 448, PA0 = 512, PKK = 576, PKA = 640, PRK = 704, PLG = 768, PLB = 832, PAR_OFF = 8 * BUFF + 640;
__device__ __forceinline__ void stage_params(float* par, const RwkvW& w, int h, int tid) {
    const int seg = tid >> 6, l = tid & 63;
    const float* s1 = seg == 0 ? w.mu + 512 + h * 64 : seg == 1 ? w.mu + 1024 + h * 64 : seg == 2 ? w.mu + 1536 : seg == 3 ? w.mu + 1600 : seg == 4 ? w.mu + h * 64 : seg == 5 ? w.mu + 1664 : seg == 6 ? w.mu + 1728 : w.w0 + h * 64;
    par[seg * 64 + l] = s1[l];
    if (seg < 6) { const float* s2 = (seg == 0 ? w.a0 : seg == 1 ? w.kk : seg == 2 ? w.ka : seg == 3 ? w.rk : seg == 4 ? w.lg : w.lb) + h * 64; par[(8 + seg) * 64 + l] = s2[l]; }
}
template <bool WITH_R>
__device__ __forceinline__ unsigned rwkv_front(float* sm, const bf16* P, const RwkvW& w, int tok0, int h, bool ss, bool has_next, int tid, int wave, int lane) {
    float *B0 = sm, *B1 = sm + BUFF, *B2 = sm + 2 * BUFF, *B3 = sm + 3 * BUFF, *B4 = sm + 4 * BUFF, *B5 = sm + 5 * BUFF, *B6 = sm + 6 * BUFF, *B7 = sm + 7 * BUFF;
    float* part = sm + 8 * BUFF; float* bon = part + 512 + 64; const float* par = sm + PAR_OFF;
    unsigned touch = 0u;
    {
        const LsRaw rk = ls_issue(P, tok0, 512 + h * 64, ss, tid), rv = ls_issue(P, tok0, 1024 + h * 64, ss, tid), rxw = ls_issue(P, tok0, 1536, ss, tid), rxa = ls_issue(P, tok0, 1600, ss, tid);
        const WRaw ww = w_issue(w.w2, 512, 0, h * 64, tid), wa = w_issue(w.a2, 512, 0, h * 64, tid);
        if (has_next) { const int blk = tid & 7; const int col = blk == 0 ? 512 + h * 64 : blk == 1 ? 1024 + h * 64 : blk == 2 ? 1536 : blk == 3 ? 1600 : blk == 4 ? h * 64 : blk == 5 ? 1664 : blk == 6 ? 1728 : 1536;
            touch = *(const unsigned*)(P + (size_t)(tok0 + 64 + (tid >> 3)) * PW + col); }
        ls_commit<0>(B0, rk, par + PK, tid); ls_commit<0>(B1, rv, par + PV, tid); ls_commit<1>(B2, rxw, par + PXW, tid); ls_commit<0>(B3, rxa, par + PXA, tid);
        w_commit(B4, ww, tid); w_commit(B5, wa, tid);
    }
    LsRaw rr; if (WITH_R) rr = ls_issue(P, tok0, h * 64, ss, tid);
    __syncthreads();
    SECT(20);
    { f32x4 c0 = {0.f, 0.f, 0.f, 0.f}, c1 = c0; mm_acc<64>(c0, c1, wave, lane, KMin{B2}, KMaj{B4});
      mm_store(c0, c1, wave, lane, [=](int r, int c, float v) { const float wi = v + par[PW0 + c]; const float z = -wi; const float sp = fmaxf(z, 0.f) + __logf(1.f + __expf(-fabsf(z))); B6[r * LD + c] = -__expf(-sp - 0.5f); }); }
    { f32x4 c0 = {0.f, 0.f, 0.f, 0.f}, c1 = c0; mm_acc<64>(c0, c1, wave, lane, KMin{B3}, KMaj{B5});
      mm_store(c0, c1, wave, lane, [=](int r, int c, float v) { B7[r * LD + c] = sigmoidf_(v + par[PA0 + c]); }); }
    __syncthreads();
    SECT(21);
    if (WITH_R) ls_commit<0>(B4, rr, par + PR, tid);
    {
        const int row = tid >> 3, c8 = (tid & 7) * 8;
        float kx[8], kkv[8]; float ssq = 0.f;
#pragma unroll
        for (int e = 0; e < 8; ++e) { kx[e] = B0[row * LD + c8 + e]; kkv[e] = kx[e] * par[PKK + c8 + e]; ssq += kkv[e] * kkv[e]; }
        ssq += __shfl_xor(ssq, 1); ssq += __shfl_xor(ssq, 2); ssq += __shfl_xor(ssq, 4);
        const float inv = 1.f / fmaxf(sqrtf(ssq), 1e-12f);
        float bsum = 0.f;
#pragma unroll
        for (int e = 0; e < 8; ++e) { const float al = B7[row * LD + c8 + e]; const float kn = kkv[e] * inv; const float kad = kx[e] * (1.f + (al - 1.f) * par[PKA + c8 + e]);
            B2[row * LD + c8 + e] = -kn; B3[row * LD + c8 + e] = kn * al; B0[row * LD + c8 + e] = kad;
            if (WITH_R) bsum += B4[row * LD + c8 + e] * kad * par[PRK + c8 + e]; }
        if (WITH_R) { bsum += __shfl_xor(bsum, 1); bsum += __shfl_xor(bsum, 2); bsum += __shfl_xor(bsum, 4); if ((tid & 7) == 0) bon[row] = bsum; }
    }
    {
        const int ch = tid & 63, seg = tid >> 6; float s = 0.f;
#pragma unroll
        for (int i = 0; i < 8; ++i) s += B6[(seg * 8 + i) * LD + ch];
        part[seg * 64 + ch] = s;
    }
    __syncthreads();
    {   const int ch = tid & 63, seg = tid >> 6; float cex = 0.f;
        for (int s = 0; s < seg; ++s) cex += part[s * 64 + ch];
#pragma unroll
        for (int i = 0; i < 8; ++i) { const int t = seg * 8 + i; const float lw = B6[t * LD + ch]; B2[t * LD + ch] *= __expf(cex); cex += lw; B6[t * LD + ch] = cex; }
    }
    __syncthreads();
    return touch;
}

__device__ __forceinline__ void rwkv_phase1(float* sm, const bf16* P, const RwkvW& w, float* GH, int bx, int G) {
    float *B0 = sm, *B1 = sm + BUFF, *B2 = sm + 2 * BUFF, *B3 = sm + 3 * BUFF, *B4 = sm + 4 * BUFF, *B5 = sm + 5 * BUFF, *B6 = sm + 6 * BUFF, *B7 = sm + 7 * BUFF;
    float* gl = sm + 8 * BUFF + 512;
    int hprev = -1;
    for (int unit = (4096 * bx) / G, uend = (4096 * (bx + 1)) / G; unit < uend; ++unit) {
        TIDS;
        const int bh = unit >> 8, c = unit & 255, b = bh >> 3, h = bh & 7, tok0 = b * SEQL + c * 64;
        if (h != hprev) { __syncthreads(); stage_params(sm + PAR_OFF, w, h, tid); hprev = h; }
        __syncthreads();
        SECT(10);
        const unsigned touch = rwkv_front<false>(sm, P, w, tok0, h, c == 0, (c != 255) && (unit + 1 < uend), tid, wave, lane);
        SECT(11);
        for (int idx = tid; idx < 4096; idx += NTHR) { const int t = idx >> 6, ch = idx & 63; const float cu = B6[t * LD + ch], cl = B6[63 * LD + ch];
            const float em = __expf(-cu), eh = __expf(cl - cu), bv = B3[t * LD + ch], kv = B0[t * LD + ch];
            B4[t * LD + ch] = bv * em; B5[t * LD + ch] = kv * em; B3[t * LD + ch] = bv * eh; B0[t * LD + ch] = kv * eh; }
        if (tid < 64) gl[tid] = __expf(B6[63 * LD + tid]);
        __syncthreads();
        { f32x4 c0 = {0.f, 0.f, 0.f, 0.f}, c1 = c0; mm_acc<64>(c0, c1, wave, lane, KMin{B2}, KMin{B4}); mm_store(c0, c1, wave, lane, [=](int r, int cc, float v) { B7[r * LD + cc] = (cc < r) ? v : 0.f; }); }
        { f32x4 c0 = {0.f, 0.f, 0.f, 0.f}, c1 = c0; mm_acc<64>(c0, c1, wave, lane, KMin{B2}, KMin{B5}); mm_store(c0, c1, wave, lane, [=](int r, int cc, float v) { B6[r * LD + cc] = (cc < r) ? v : 0.f; }); }
        __syncthreads();
        { f32x4 c0 = {0.f, 0.f, 0.f, 0.f}, c1 = c0; mm_acc_t<64, true>(c0, c1, wave, lane, KMin{B6}, KMaj{B1}); mm_store(c0, c1, wave, lane, [=](int r, int cc, float v) { B4[r * LD + cc] = v; }); }
        SECT(12);
        tri_inverse(B5, B7, B6, tid, wave, lane);
        SECT(13);
        { f32x4 c0 = {0.f, 0.f, 0.f, 0.f}, c1 = c0; mm_acc_t<64, true>(c0, c1, wave, lane, KMin{B5}, KMaj{B2}); mm_store(c0, c1, wave, lane, [=](int r, int cc, float v) { B6[r * LD + cc] = v; }); }
        { f32x4 c0 = {0.f, 0.f, 0.f, 0.f}, c1 = c0; mm_acc_t<64, true>(c0, c1, wave, lane, KMin{B5}, KMaj{B4}); mm_store(c0, c1, wave, lane, [=](int r, int cc, float v) { B7[r * LD + cc] = v; }); }
        __syncthreads();
        float* Gg = GH + (size_t)unit * 8192; float* Hg = Gg + 4096;
        { f32x4 c0 = {0.f, 0.f, 0.f, 0.f}, c1 = c0; mm_acc<64>(c0, c1, wave, lane, KMaj{B6}, KMaj{B3}); mm_store(c0, c1, wave, lane, [=](int r, int cc, float v) { Gg[r * 64 + cc] = v + ((r == cc) ? gl[r] : 0.f); }); }
        { f32x4 c0 = {0.f, 0.f, 0.f, 0.f}, c1 = c0; mm_acc<64>(c0, c1, wave, lane, KMaj{B7}, KMaj{B3}); mm_acc<64>(c0, c1, wave, lane, KMaj{B1}, KMaj{B0}); mm_store(c0, c1, wave, lane, [=](int r, int cc, float v) { Hg[r * 64 + cc] = v; }); }
        SECT(14);
        asm volatile("" :: "v"(touch));
    }
}

__device__ __forceinline__ void rwkv_phase2(float* sm, float* GH, int wg) {
    TIDS;
    const int bh = wg >> 2, rb = wg & 3;
    float* Ss = sm; float* Gs = sm + 16 * LD; float* Hs = Gs + 64 * LD;
    for (int i = tid; i < 16 * LD; i += NTHR) Ss[i] = 0.f;
    float* base = GH + (size_t)(bh * 256) * 8192;
    const int grow = tid >> 3, gc8 = (tid & 7) * 8, hrow = tid >> 5, hc2 = (tid & 31) * 2;
    const size_t goff = (size_t)grow * 64 + gc8, hoff = 4096 + (size_t)(rb * 16 + hrow) * 64 + hc2;
    f32x4 ga[4], gb[4]; f32x2 hv[4];
#pragma unroll
    for (int i = 0; i < 4; ++i) { const float* u = base + (size_t)i * 8192; ga[i] = *(const f32x4*)(u + goff); gb[i] = *(const f32x4*)(u + goff + 4); hv[i] = *(const f32x2*)(u + hoff); }
    const int li = lane & 15, lk = lane >> 4;
    for (int c4 = 0; c4 < 256; c4 += 4) {
#pragma unroll
        for (int i = 0; i < 4; ++i) {
            const int c = c4 + i;
            *(f32x4*)(Gs + grow * LD + gc8) = ga[i]; *(f32x4*)(Gs + grow * LD + gc8 + 4) = gb[i]; *(f32x2*)(Hs + hrow * LD + hc2) = hv[i];
            __syncthreads();
            float* u = base + (size_t)c * 8192;
            if (c + 4 < 256) { const float* un = u + (size_t)4 * 8192; ga[i] = *(const f32x4*)(un + goff); gb[i] = *(const f32x4*)(un + goff + 4); hv[i] = *(const f32x2*)(un + hoff); }
            *(f32x2*)(u + hoff) = *(const f32x2*)(Ss + hrow * LD + hc2);
            f32x4 acc = {0.f, 0.f, 0.f, 0.f};
            if (wave < 4) {
#pragma unroll
                for (int r = 0; r < 4; ++r) acc[r] = Hs[(4 * lk + r) * LD + 16 * wave + li];
#pragma unroll 4
                for (int k0 = 0; k0 < 64; k0 += 4) acc = __builtin_amdgcn_mfma_f32_16x16x4f32(Ss[li * LD + k0 + lk], Gs[(k0 + lk) * LD + 16 * wave + li], acc, 0, 0, 0);
            }
            __syncthreads();
            if (wave < 4) {
#pragma unroll
                for (int r = 0; r < 4; ++r) Ss[(4 * lk + r) * LD + 16 * wave + li] = acc[r];
            }
        }
    }
    __syncthreads();
}

__device__ __forceinline__ void rwkv_phase3(float* sm, const bf16* P, const RwkvW& w, const float* GH, bf16* CAT, int bx, int G) {
    float *B0 = sm, *B1 = sm + BUFF, *B2 = sm + 2 * BUFF, *B3 = sm + 3 * BUFF, *B4 = sm + 4 * BUFF, *B5 = sm + 5 * BUFF, *B6 = sm + 6 * BUFF, *B7 = sm + 7 * BUFF;
    float* bon = sm + 8 * BUFF + 512 + 64;
    int hprev = -1;
    for (int unit = (4096 * bx) / G, uend = (4096 * (bx + 1)) / G; unit < uend; ++unit) {
        TIDS;
        const int bh = unit >> 8, c = unit & 255, b = bh >> 3, h = bh & 7, tok0 = b * SEQL + c * 64; const bool ss = (c == 0);
        if (h != hprev) { __syncthreads(); stage_params(sm + PAR_OFF, w, h, tid); hprev = h; }
        __syncthreads();
        SECT(0);
        const unsigned touch = rwkv_front<true>(sm, P, w, tok0, h, ss, (c != 255) && (unit + 1 < uend), tid, wave, lane);
        SECT(1);
        const WRaw s0raw = w_issue(GH + (size_t)unit * 8192 + 4096, 64, 0, 0, tid);
        const LsRaw xg0 = ls_issue(P, tok0, 1664, ss, tid), xg1 = ls_issue(P, tok0, 1728, ss, tid);
        const WRaw g2a = w_issue(w.g2, 512, 0, h * 64, tid), g2b = w_issue(w.g2, 512, 64, h * 64, tid);
        for (int idx = tid; idx < 4096; idx += NTHR) { const int t = idx >> 6, ch = idx & 63; const float cu = B6[t * LD + ch]; const float em = __expf(-cu);
            B5[t * LD + ch] = B3[t * LD + ch] * em; B0[t * LD + ch] *= em; B4[t * LD + ch] *= __expf(cu); }
        __syncthreads();
        { f32x4 c0 = {0.f, 0.f, 0.f, 0.f}, c1 = c0; mm_acc<64>(c0, c1, wave, lane, KMin{B2}, KMin{B5}); mm_store(c0, c1, wave, lane, [=](int r, int cc, float v) { B3[r * LD + cc] = (cc < r) ? v : 0.f; }); }
        { f32x4 c0 = {0.f, 0.f, 0.f, 0.f}, c1 = c0; mm_acc<64>(c0, c1, wave, lane, KMin{B2}, KMin{B0}); mm_store(c0, c1, wave, lane, [=](int r, int cc, float v) { B6[r * LD + cc] = (cc < r) ? v : 0.f; }); }
        { f32x4 c0 = {0.f, 0.f, 0.f, 0.f}, c1 = c0; mm_acc<64>(c0, c1, wave, lane, KMin{B4}, KMin{B5}); mm_store(c0, c1, wave, lane, [=](int r, int cc, float v) { B7[r * LD + cc] = (cc <= r) ? v : 0.f; }); }
        __syncthreads();
        { f32x4 c0 = {0.f, 0.f, 0.f, 0.f}, c1 = c0; mm_acc<64>(c0, c1, wave, lane, KMin{B4}, KMin{B0}); mm_store(c0, c1, wave, lane, [=](int r, int cc, float v) { B5[r * LD + cc] = (cc <= r) ? v : 0.f; }); }
        __syncthreads();
        SECT(2);
        w_commit(B0, s0raw, tid);
        __syncthreads();
        { f32x4 c0 = {0.f, 0.f, 0.f, 0.f}, c1 = c0; mm_acc<64>(c0, c1, wave, lane, KMin{B2}, KMin{B0}); mm_acc_t<64, true>(c0, c1, wave, lane, KMin{B6}, KMaj{B1}); __syncthreads();
          mm_store(c0, c1, wave, lane, [=](int r, int cc, float v) { B2[r * LD + cc] = v; }); }
        __syncthreads();
        SECT(3);
        f32x4 y0 = {0.f, 0.f, 0.f, 0.f}, y1 = y0;
        mm_acc<64>(y0, y1, wave, lane, KMin{B4}, KMin{B0}); mm_acc_t<64, true>(y0, y1, wave, lane, KMin{B5}, KMaj{B1});
        SECT(4);
        tri_inverse(B6, B3, B0, tid, wave, lane);
        SECT(5);
        { f32x4 c0 = {0.f, 0.f, 0.f, 0.f}, c1 = c0; mm_acc_t<64, true>(c0, c1, wave, lane, KMin{B6}, KMaj{B2}); mm_store(c0, c1, wave, lane, [=](int r, int cc, float v) { B4[r * LD + cc] = v; }); }
        __syncthreads();
        mm_acc_t<64, true>(y0, y1, wave, lane, KMin{B7}, KMaj{B4});
        ls_commit<2>(B3, xg0, sm + PAR_OFF + PXG, tid); ls_commit<2>(B5, xg1, sm + PAR_OFF + PXG + 64, tid); w_commit(B0, g2a, tid); w_commit(B2, g2b, tid);
        mm_store(y0, y1, wave, lane, [=](int r, int cc, float v) { B6[r * LD + cc] = v; });
        __syncthreads();
        { f32x4 c0 = {0.f, 0.f, 0.f, 0.f}, c1 = c0; mm_acc<64>(c0, c1, wave, lane, KMin{B3}, KMaj{B0}); mm_acc<64>(c0, c1, wave, lane, KMin{B5}, KMaj{B2});
        SECT(6);
          mm_store(c0, c1, wave, lane, [=](int r, int cc, float v) { B4[r * LD + cc] = v; }); }
        __syncthreads();
        {   const int row = tid >> 3, c8 = (tid & 7) * 8; float y[8], s = 0.f;
#pragma unroll
            for (int e = 0; e < 8; ++e) { y[e] = B6[row * LD + c8 + e]; s += y[e]; }
            s += __shfl_xor(s, 1); s += __shfl_xor(s, 2); s += __shfl_xor(s, 4);
            const float mu = s * (1.f / 64.f); float q = 0.f;
#pragma unroll
            for (int e = 0; e < 8; ++e) { y[e] -= mu; q += y[e] * y[e]; }
            q += __shfl_xor(q, 1); q += __shfl_xor(q, 2); q += __shfl_xor(q, 4);
            const float rs = 1.f / sqrtf(q * (1.f / 64.f) + 64e-5f); const float bn = bon[row];
            float o[8];
#pragma unroll
            for (int e = 0; e < 8; ++e) { const float yn = y[e] * rs * sm[PAR_OFF + PLG + c8 + e] + sm[PAR_OFF + PLB + c8 + e]; o[e] = (yn + bn * B1[row * LD + c8 + e]) * B4[row * LD + c8 + e]; }
            *(v4u*)(CAT + (size_t)(tok0 + row) * 1024 + h * 64 + c8) = pack8(o);
        }
        SECT(7);
        asm volatile("" :: "v"(touch));
    }
}

__device__ __forceinline__ void phase_rope(bf16* P, int bx, int G) {
    TIDS;
    constexpr float INVF[8] = {1.0f, 0.1939227432012558f, 0.03760603070259094f, 0.007292664609849453f, 0.0014142135623842478f, 0.00027424818836152554f, 5.318296098266728e-05f, 1.0313386155758053e-05f};
    for (int it = bx * NTHR + tid; it < NTOK * 16; it += G * NTHR) {
        const int tok = it >> 4, hh = it & 15, s = tok & (SEQL - 1);
        bf16* p = P + (size_t)tok * PW + 1792 + hh * 64;
        float x1[8], x2[8]; unpack8(*(const v4u*)p, x1); unpack8(*(const v4u*)(p + 8), x2);
        const float sc = (hh < 8) ? attn_body::C2 : 1.f;
        float o1[8], o2[8];
#pragma unroll
        for (int d = 0; d < 8; ++d) { const float ang = (float)s * INVF[d]; double rev = (double)ang * 0.15915494309189535; rev -= rint(rev); const float fr = (float)rev;
            const float sn = __builtin_amdgcn_sinf(fr), cs = __builtin_amdgcn_cosf(fr);
            o1[d] = (x1[d] * cs - x2[d] * sn) * sc; o2[d] = (x1[d] * sn + x2[d] * cs) * sc; }
        *(v4u*)p = pack8(o1); *(v4u*)(p + 8) = pack8(o2);
        if (hh < 8) {
#pragma unroll
            for (int q = 2; q < 8; ++q) { float x[8]; unpack8(*(const v4u*)(p + 8 * q), x);
#pragma unroll
                for (int e = 0; e < 8; ++e) x[e] *= sc;
                *(v4u*)(p + 8 * q) = pack8(x); }
        }
    }
}

__device__ __forceinline__ void phase_attn_post(const bf16* OB, bf16* CAT, const float* q1, const float* k1, const float* q2, const float* k2, const float* sg, float lam_init, int bx, int G) {
    TIDS; const int gw = bx * 8 + wave, NGW = G * 8;
    const float d1 = wave_sum(q1[lane] * k1[lane]), d2 = wave_sum(q2[lane] * k2[lane]);
    const float lam = expf(d1) - expf(d2) + lam_init;
    const int h = lane >> 4, d0 = (lane & 15) * 8, vhalf = d0 >> 6, dd = d0 & 63;
    float g[8];
#pragma unroll
    for (int e = 0; e < 8; ++e) g[e] = sg[d0 + e] * (1.f - lam_init);
    for (int tok = gw; tok < NTOK; tok += NGW) {
        const bf16* r = OB + (size_t)tok * 1024;
        float a[8], b[8]; unpack8(*(const v4u*)(r + ((h * 2 + 0) * 2 + vhalf) * 64 + dd), a); unpack8(*(const v4u*)(r + ((h * 2 + 1) * 2 + vhalf) * 64 + dd), b);
        float o[8], q = 0.f;
#pragma unroll
        for (int e = 0; e < 8; ++e) { o[e] = a[e] - lam * b[e]; q += o[e] * o[e]; }
        q += __shfl_xor(q, 1); q += __shfl_xor(q, 2); q += __shfl_xor(q, 4); q += __shfl_xor(q, 8);
        const float rs = 1.f / sqrtf(q * (1.f / 128.f) + 1e-5f);
#pragma unroll
        for (int e = 0; e < 8; ++e) o[e] = o[e] * rs * g[e];
        *(v4u*)(CAT + (size_t)tok * 1024 + 512 + h * 128 + d0) = pack8(o);
    }
}

__device__ __forceinline__ void phase_ln(float* X, bf16* XN, const float* g, const float* b, int bx, int G) {
    TIDS; const int gw = bx * 8 + wave, NGW = G * 8;
    for (int m = gw; m < NTOK; m += NGW) {
        f32x4* xr = (f32x4*)(X + (size_t)m * 1024) + lane;
        f32x4 v[4]; float s = 0.f;
#pragma unroll
        for (int j = 0; j < 4; ++j) { v[j] = xr[64 * j]; s += (v[j][0] + v[j][1]) + (v[j][2] + v[j][3]); }
        const float mean = wave_sum(s) * (1.f / 1024.f); float s2 = 0.f;
#pragma unroll
        for (int j = 0; j < 4; ++j) { v[j] = v[j] - mean; s2 += (v[j][0] * v[j][0] + v[j][1] * v[j][1]) + (v[j][2] * v[j][2] + v[j][3] * v[j][3]); }
        const float rstd = 1.f / sqrtf(wave_sum(s2) * (1.f / 1024.f) + 1e-5f);
        v2u* o8 = (v2u*)(XN + (size_t)m * 1024) + lane;
#pragma unroll
        for (int j = 0; j < 4; ++j) { const f32x4 gg = *(const f32x4*)(g + 4 * lane + 256 * j), bb = *(const f32x4*)(b + 4 * lane + 256 * j);
            const f32x4 o = v[j] * rstd * gg + bb; xr[64 * j] = o; v2u w; w.x = pk2(o[0], o[1]); w.y = pk2(o[2], o[3]); o8[64 * j] = w; }
    }
}
__device__ __forceinline__ void phase_lnv(bf16* V, const float* g, const float* b, int bx, int G) {
    TIDS; const int gw = bx * 8 + wave, NGW = G * 8;
    for (int m = gw; m < NTOK; m += NGW) {
        bf16* r = V + (size_t)m * 1024;
        float x[16]; unpack8(*(const v4u*)(r + lane * 8), x); unpack8(*(const v4u*)(r + 512 + lane * 8), x + 8);
        float s = 0.f;
#pragma unroll
        for (int e = 0; e < 16; ++e) s += x[e];
        const float mean = wave_sum(s) * (1.f / 1024.f); float s2 = 0.f;
#pragma unroll
        for (int e = 0; e < 16; ++e) { x[e] -= mean; s2 += x[e] * x[e]; }
        const float rstd = 1.f / sqrtf(wave_sum(s2) * (1.f / 1024.f) + 1e-5f);
#pragma unroll
        for (int e = 0; e < 16; ++e) { const int col = (e < 8) ? lane * 8 + e : 512 + lane * 8 + (e - 8); x[e] = x[e] * rstd * g[col] + b[col]; }
        *(v4u*)(r + lane * 8) = pack8(x); *(v4u*)(r + 512 + lane * 8) = pack8(x + 8);
    }
}

__device__ __forceinline__ void phase_conv(const bf16* GATE, bf16* VAL, const float* cw, const float* cb, int bx, int G) {
    TIDS;
    constexpr int NCG = DFF / 8, NIT = (NTOK / 16) * NCG;
    for (int it = bx * NTHR + tid; it < NIT; it += G * NTHR) {
        const int rb = it / NCG, c0 = (it % NCG) * 8, t0 = rb * 16;
        float w0[8], w1[8], w2[8], bb[8];
#pragma unroll
        for (int e = 0; e < 8; ++e) { w0[e] = cw[c0 + e]; w1[e] = cw[DFF + c0 + e]; w2[e] = cw[2 * DFF + c0 + e]; bb[e] = cb[c0 + e]; }
        float g1[8], g2[8];
        if ((t0 & (SEQL - 1)) == 0) {
#pragma unroll
            for (int e = 0; e < 8; ++e) { g1[e] = 0.f; g2[e] = 0.f; }
        } else { unpack8(*(const v4u*)(GATE + (size_t)(t0 - 1) * DFF + c0), g1); unpack8(*(const v4u*)(GATE + (size_t)(t0 - 2) * DFF + c0), g2); }
        for (int r = 0; r < 16; ++r) {
            const size_t off = (size_t)(t0 + r) * DFF + c0;
            float gg[8], vv[8], o[8]; unpack8(*(const v4u*)(GATE + off), gg); unpack8(*(const v4u*)(VAL + off), vv);
#pragma unroll
            for (int e = 0; e < 8; ++e) { const float cv = bb[e] + w0[e] * g2[e] + w1[e] * g1[e] + w2[e] * gg[e]; o[e] = cv * sigmoidf_(cv) * vv[e]; g2[e] = g1[e]; g1[e] = gg[e]; }
            *(v4u*)(VAL + off) = pack8(o);
        }
    }
}

__device__ __forceinline__ void phase_mix(unsigned char* ldsb, bf16* U, const bf16* V, const bf16* WSP, const float* bs, int bx, int G) {
    TIDS;
    bf16* Vt = (bf16*)ldsb;
    for (int unit = bx; unit < 2048; unit += G) {
        const int cidx = unit >> 3, g = unit & 7, tok0 = cidx * 128;
        __syncthreads();
        {   const int s = tid >> 2, q = tid & 3;
#pragma unroll
            for (int i = 0; i < 4; ++i) { const v4u w = *(const v4u*)(V + (size_t)(tok0 + s) * 1024 + g * 128 + q * 32 + i * 8); const int d0 = q * 32 + i * 8;
                Vt[(d0 + 0) * 136 + s] = (bf16)(w.x & 0xffffu); Vt[(d0 + 1) * 136 + s] = (bf16)(w.x >> 16); Vt[(d0 + 2) * 136 + s] = (bf16)(w.y & 0xffffu); Vt[(d0 + 3) * 136 + s] = (bf16)(w.y >> 16);
                Vt[(d0 + 4) * 136 + s] = (bf16)(w.z & 0xffffu); Vt[(d0 + 5) * 136 + s] = (bf16)(w.z >> 16); Vt[(d0 + 6) * 136 + s] = (bf16)(w.w & 0xffffu); Vt[(d0 + 7) * 136 + s] = (bf16)(w.w >> 16); }
        }
        __syncthreads();
        f32x4 acc[8];
#pragma unroll
        for (int tn = 0; tn < 8; ++tn) acc[tn] = (f32x4){0.f, 0.f, 0.f, 0.f};
        const int li = lane & 15, lk = lane >> 4, nks = (16 * wave + 15) / 32 + 1;
        for (int ks = 0; ks < nks; ++ks) {
            const bf16x8 a = *(const bf16x8*)(WSP + (size_t)g * 16384 + (16 * wave + li) * 128 + ks * 32 + lk * 8);
#pragma unroll
            for (int tn = 0; tn < 8; ++tn) { const bf16x8 bq = *(const bf16x8*)(Vt + (16 * tn + li) * 136 + ks * 32 + lk * 8); acc[tn] = __builtin_amdgcn_mfma_f32_16x16x32_bf16(a, bq, acc[tn], 0, 0, 0); }
        }
#pragma unroll
        for (int r = 0; r < 4; ++r) { const int t = 16 * wave + 4 * lk + r; const float bias = bs[g * 128 + t];
#pragma unroll
            for (int tn = 0; tn < 8; ++tn) { bf16* up = U + (size_t)(tok0 + t) * 1024 + g * 128 + 16 * tn + li; const float u = __uint_as_float(((unsigned)*up) << 16); *up = (bf16)f2bf(u * (acc[tn][r] + bias)); } }
    }
}

#ifndef PHASE_SEL
#define PHASE_SEL 0xffffffffu
#endif
#define ON(k) (((PHASE_SEL) >> (k)) & 1u)
struct Args { const float* in[34]; float* out; unsigned char* ws; };

__global__ void __launch_bounds__(NTHR, 2) mega_fwd(Args a) {
    extern __shared__ __attribute__((aligned(16))) unsigned char lds[];
    cg::grid_group grid = cg::this_grid();
    const int G = gridDim.x, bx = blockIdx.x;
    unsigned* barw = (unsigned*)(a.ws + WS_CTL);
    volatile LAS unsigned* bst = (volatile LAS unsigned*)((LAS unsigned char*)lds + (LDS_TOTAL - 16));
    if (threadIdx.x < 2) bst[threadIdx.x] = 0u;
#if defined(SEC_B)
    if (threadIdx.x == 0) { volatile unsigned long long* pa_ = (volatile unsigned long long*)((char*)lds + (LDS_TOTAL - 48)); pa_[0] = 0ull; pa_[1] = 0ull; }
#endif
    if (bx == 0) for (int i = threadIdx.x; i < XCD_BAR_WORDS; i += NTHR) barw[i] = 0u;
    __threadfence();
    grid.sync();
    const XcdBarrier xbar = xcd_barrier_post(barw, bst);
#ifdef PROBE_MASK
    unsigned long long tacc = 0, tmark = 0;
#define PB(k) do { if ((PROBE_MASK >> (k)) & 1u) tmark = __builtin_amdgcn_s_memrealtime(); } while (0)
#define PE(k) do { if ((PROBE_MASK >> (k)) & 1u) tacc += __builtin_amdgcn_s_memrealtime() - tmark; } while (0)
#else
#define PB(k) do {} while (0)
#define PE(k) do {} while (0)
#endif
    for (int layer = 0; layer < 4; ++layer) {
        const int j = layer >> 1; const bool even = (layer & 1) == 0;
        int z = 0; asm volatile("" : "+s"(z));
        unsigned char* ws = a.ws + z; float* out = a.out + z;
        LAS unsigned char* ldsl = (LAS unsigned char*)lds;
        float* sm = (float*)lds;

        PB(0);
        if (ON(0)) {
            TIDS; const int gw = bx * 8 + wave, NGW = G * 8;
            LAS float* scr = (LAS float*)(ldsl + wave * 16384);
            const float* wi = even ? a.in[1 + z] + (size_t)j * 1024 * 3328 : a.in[19 + z] + (size_t)j * 1024 * 2048;
            const int Nin = even ? 3328 : 2048;
            const float* wo = even ? a.in[18 + z] + (size_t)j * 1024 * 1024 : a.in[25 + z] + (size_t)j * 1024 * 1024;
            const float* wu = a.in[28 + z] + (size_t)layer * 1024 * 5632;
            const float* wd = a.in[31 + z] + (size_t)layer * 2816 * 1024;
            const int I_in = 16 * (Nin / 32), I_out = 16 * 32, I_up = 16 * 176, I_dn = 44 * 32, NIT = I_in + I_out + I_up + I_dn;
            for (int it = gw; it < NIT; it += NGW) {
                int r = it;
                if (r < I_in) { transpose_item(wi, 1024, Nin, ((bf16*)(ws + WS_WIN)), scr, r, lane); continue; } r -= I_in;
                if (r < I_out) { transpose_item(wo, 1024, 1024, ((bf16*)(ws + WS_WOUT)), scr, r, lane); continue; } r -= I_out;
                if (r < I_up) { transpose_item(wu, 1024, 5632, ((bf16*)(ws + WS_WUP)), scr, r, lane); continue; } r -= I_up;
                transpose_item(wd, 2816, 1024, ((bf16*)(ws + WS_WDN)), scr, r, lane);
            }
            if (!even) { const float* wsrc = a.in[23 + z] + (size_t)j * 8 * 128 * 128;
                for (int i = bx * NTHR + tid; i < 8 * 128 * 128; i += G * NTHR) { const int t = (i >> 7) & 127, s = i & 127; ((bf16*)(ws + WS_WSP))[i] = (bf16)f2bf(s <= t ? wsrc[i] : 0.f); } }
            if (layer == 0) { const f32x4* xs = (const f32x4*)a.in[0 + z]; f32x4* xo = (f32x4*)out; v2u* xn = (v2u*)((bf16*)(ws + WS_XN));
                for (int i = bx * NTHR + tid; i < NTOK * 1024 / 4; i += G * NTHR) { const f32x4 v = xs[i]; xo[i] = v; v2u w; w.x = pk2(v[0], v[1]); w.y = pk2(v[2], v[3]); xn[i] = w; } }
        }
        xcd_barrier(xbar);
        PE(0);
        if (even) {
            PB(1);
            if (ON(1)) {   pg8::Gemm g{((bf16*)(ws + WS_XN)), ((bf16*)(ws + WS_WIN)), NTOK, 3328, 1024}; pg8::StaticOrder S; S.init(NTOK, 3328, G, bx);
                pg8::EpiBf16<0> E{((bf16*)(ws + WS_P)), 3328, nullptr, 0, 0, 1.f};
                pg8::gemm_phase<pg8::EpiBf16<0>, pg8::StaticOrder, PG8_ALIGN, PG8_SP2>(ldsl, g, S, E); }
            xcd_barrier(xbar);
            PE(1);
            PB(2);
            if (ON(2)) { RwkvW rw{a.in[2 + z] + j * 1792, a.in[3 + z] + j * 512, a.in[4 + z] + (size_t)j * 64 * 512, a.in[5 + z] + j * 512, a.in[6 + z] + (size_t)j * 64 * 512, a.in[7 + z] + (size_t)j * 128 * 512,
                     a.in[8 + z] + j * 512, a.in[9 + z] + j * 512, a.in[10 + z] + j * 512, a.in[11 + z] + j * 512, a.in[12 + z] + j * 512}; rwkv_phase1(sm, ((bf16*)(ws + WS_P)), rw, ((float*)(ws + WS_GH)), bx, G); }
            PB(3);
            if (ON(3)) phase_rope(((bf16*)(ws + WS_P)), bx, G);
            xcd_barrier(xbar);
            PE(2);
            PE(3);
            PB(4);
            if (ON(4)) if (bx < 64) rwkv_phase2(sm, ((float*)(ws + WS_GH)), bx);
            xcd_barrier(xbar);
            PE(4);
            PB(5);
            if (ON(5)) {
                __syncthreads();
                const int nun = (G == 256) ? 8 : (2048 - bx + G - 1) / G;
                for (int i = 0; i < nun; ++i) {
                    int bhv, qb;
                    if (G == 256) { const int vcu = (bx % 8) * (G / 8) + bx / 8, s = vcu & 7, grp = i >> 1; bhv = vcu >> 3; qb = (i & 1) ? (16 * grp + 15 - s) : (16 * grp + s); }
                    else { const int u = bx + i * G; bhv = u & 31; qb = 63 - (u >> 5); }
                    const int b = bhv >> 4, vh = bhv & 15, hd = vh >> 2, cm = (vh >> 1) & 1, vhalf = vh & 1;
                    const attn_body::bf16* Q = (const attn_body::bf16*)(((bf16*)(ws + WS_P)) + 1792 + (hd * 2 + cm) * 64); const attn_body::bf16* K = (const attn_body::bf16*)(((bf16*)(ws + WS_P)) + 2304 + (hd * 2 + cm) * 64);
                    const attn_body::bf16* Vv = (const attn_body::bf16*)(((bf16*)(ws + WS_P)) + 2816 + hd * 128 + vhalf * 64); attn_body::bf16* O = (attn_body::bf16*)(((bf16*)(ws + WS_XN)) + vh * 64);
                    attn_body::attn_unit<8>(b, 0, qb, Q, K, Vv, O, (char*)lds);
                }
            }
            xcd_barrier(xbar);
            PE(5);
            PB(6);
            if (ON(6)) { RwkvW rw{a.in[2 + z] + j * 1792, a.in[3 + z] + j * 512, a.in[4 + z] + (size_t)j * 64 * 512, a.in[5 + z] + j * 512, a.in[6 + z] + (size_t)j * 64 * 512, a.in[7 + z] + (size_t)j * 128 * 512,
                     a.in[8 + z] + j * 512, a.in[9 + z] + j * 512, a.in[10 + z] + j * 512, a.in[11 + z] + j * 512, a.in[12 + z] + j * 512}; rwkv_phase3(sm, ((bf16*)(ws + WS_P)), rw, ((float*)(ws + WS_GH)), ((bf16*)(ws + WS_CAT)), bx, G); }
            PB(7);
            if (ON(7)) phase_attn_post(((bf16*)(ws + WS_XN)), ((bf16*)(ws + WS_CAT)), a.in[13 + z] + j * 64, a.in[14 + z] + j * 64, a.in[15 + z] + j * 64, a.in[16 + z] + j * 64, a.in[17 + z] + j * 128, layer == 0 ? 0.2f : 0.4707130183435842f, bx, G);
            xcd_barrier(xbar);
            PE(6);
            PE(7);
            PB(8);
            if (ON(8)) {   pg8::Gemm g{((bf16*)(ws + WS_CAT)), ((bf16*)(ws + WS_WOUT)), NTOK, 1024, 1024}; pg8::StaticOrder S; S.init(NTOK, 1024, G, bx);
                pg8::EpiResid E{out, 1024, ALPHA};
                pg8::gemm_phase<pg8::EpiResid, pg8::StaticOrder, PG8_ALIGN, PG8_SP2>(ldsl, g, S, E); }
        } else {
            PB(9);
            if (ON(9)) {   pg8::Gemm g{((bf16*)(ws + WS_XN)), ((bf16*)(ws + WS_WIN)), NTOK, 2048, 1024}; pg8::StaticOrder S; S.init(NTOK, 2048, G, bx);
                pg8::EpiBf16<1> E{((bf16*)(ws + WS_U)), 1024, a.in[20 + z] + j * 2048, 1024, (size_t)(WS_V - WS_U) / 2, 1.f};
                pg8::gemm_phase<pg8::EpiBf16<1>, pg8::StaticOrder, PG8_ALIGN, PG8_SP2>(ldsl, g, S, E); }
            xcd_barrier(xbar);
            PE(9);
            PB(10);
            if (ON(10)) phase_lnv(((bf16*)(ws + WS_V)), a.in[21 + z] + j * 1024, a.in[22 + z] + j * 1024, bx, G);
            xcd_barrier(xbar);
            PE(10);
            PB(11);
            if (ON(11)) phase_mix(lds, ((bf16*)(ws + WS_U)), ((bf16*)(ws + WS_V)), ((bf16*)(ws + WS_WSP)), a.in[24 + z] + j * 1024, bx, G);
            xcd_barrier(xbar);
            PE(11);
            PB(12);
            if (ON(12)) {   pg8::Gemm g{((bf16*)(ws + WS_U)), ((bf16*)(ws + WS_WOUT)), NTOK, 1024, 1024}; pg8::StaticOrder S; S.init(NTOK, 1024, G, bx);
                pg8::EpiResid E{out, 1024, ALPHA};
                pg8::gemm_phase<pg8::EpiResid, pg8::StaticOrder, PG8_ALIGN, PG8_SP2>(ldsl, g, S, E); }
        }
        xcd_barrier(xbar);
        if (even) PE(8); else PE(12);
        PB(13);
        if (ON(13)) phase_ln(out, ((bf16*)(ws + WS_XN)), a.in[26 + z] + layer * 1024, a.in[27 + z] + layer * 1024, bx, G);
        xcd_barrier(xbar);
        PE(13);
        PB(14);
        if (ON(14)) {   pg8::Gemm g{((bf16*)(ws + WS_XN)), ((bf16*)(ws + WS_WUP)), NTOK, 5632, 1024}; pg8::StaticOrder S; S.init(NTOK, 5632, G, bx);
            pg8::EpiBf16<0> E{((bf16*)(ws + WS_GATE)), 2816, nullptr, 2816, (size_t)(WS_VAL - WS_GATE) / 2, 1.f};
            pg8::gemm_phase<pg8::EpiBf16<0>, pg8::StaticOrder, PG8_ALIGN, PG8_SP2>(ldsl, g, S, E); }
        xcd_barrier(xbar);
        PE(14);
        PB(15);
        if (ON(15)) phase_conv(((bf16*)(ws + WS_GATE)), ((bf16*)(ws + WS_VAL)), a.in[29 + z] + (size_t)layer * 3 * DFF, a.in[30 + z] + layer * DFF, bx, G);
        xcd_barrier(xbar);
        PE(15);
        PB(16);
        if (ON(16)) {   pg8::Gemm g{((bf16*)(ws + WS_VAL)), ((bf16*)(ws + WS_WDN)), NTOK, 1024, 2816}; pg8::StaticOrder S; S.init(NTOK, 1024, G, bx);
            pg8::EpiResid E{out, 1024, ALPHA};
            pg8::gemm_phase<pg8::EpiResid, pg8::StaticOrder, PG8_ALIGN, PG8_SP2>(ldsl, g, S, E); }
        xcd_barrier(xbar);
        PE(16);
        PB(17);
#ifdef EXTRA_SYNCS
        for (int es = 0; es < EXTRA_SYNCS; ++es) xcd_barrier(xbar);
#endif
        if (ON(17)) phase_ln(out, ((bf16*)(ws + WS_XN)), a.in[32 + z] + layer * 1024, a.in[33 + z] + layer * 1024, bx, G);
        xcd_barrier(xbar);
        PE(17);
    }
#if defined(SEC_B)
    if (bx == 0 && threadIdx.x == 0) { const unsigned long long tacc2 = ((volatile unsigned long long*)((char*)lds + (LDS_TOTAL - 48)))[0]; const unsigned long long t0 = __builtin_amdgcn_s_memrealtime(); while (__builtin_amdgcn_s_memrealtime() - t0 < 4ull * tacc2) __builtin_amdgcn_s_sleep(8); }
#endif
#ifdef PROBE_MASK
    if (bx == 0 && threadIdx.x == 0) { const unsigned long long t0 = __builtin_amdgcn_s_memrealtime(); while (__builtin_amdgcn_s_memrealtime() - t0 < 4ull * tacc) __builtin_amdgcn_s_sleep(8); }
#endif
}

extern "C" void kernel_launch(void* const* d_in, const int* in_sizes, int n_in, void* d_out, int out_size, void* d_ws, size_t ws_size, hipStream_t stream) {
    static int grid = 0;
    if (grid == 0) {
        if (n_in != 34 || out_size != NTOK * 1024 || ws_size < WS_END) { fprintf(stderr, "kernel_launch: unexpected shapes (n_in %d out %d ws %zu)\n", n_in, out_size, ws_size); grid = -1; return; }
        int dev = 0, cus = 0, per_cu = 0;
        hipGetDevice(&dev); hipDeviceGetAttribute(&cus, hipDeviceAttributeMultiprocessorCount, dev);
        if (hipFuncSetAttribute((const void*)mega_fwd, hipFuncAttributeMaxDynamicSharedMemorySize, LDS_TOTAL) != hipSuccess) { fprintf(stderr, "kernel_launch: hipFuncSetAttribute failed\n"); grid = -1; return; }
        if (hipOccupancyMaxActiveBlocksPerMultiprocessor(&per_cu, (const void*)mega_fwd, NTHR, LDS_TOTAL) != hipSuccess || per_cu < 1) per_cu = 1;
        (void)hipGetLastError();
        grid = cus * per_cu;
        fprintf(stderr, "kernel_launch: grid %d (cus %d x %d)\n", grid, cus, per_cu);
    }
    if (grid < 0) return;
    Args a{};
    for (int i = 0; i < 34; ++i) a.in[i] = (const float*)d_in[i];
    a.out = (float*)d_out; a.ws = (unsigned char*)d_ws;
    void* args[] = {&a};
    hipError_t e = hipLaunchCooperativeKernel((const void*)mega_fwd, dim3(grid), dim3(NTHR), args, LDS_TOTAL, stream);
    if (e != hipSuccess) fprintf(stderr, "kernel_launch: cooperative launch failed: %s (grid %d)\n", hipGetErrorString(e), grid);
}
```

```cpp
#include <hip/hip_runtime.h>
#include <hip/hip_cooperative_groups.h>
#include <cstdio>
#include <cstdint>
namespace cg = cooperative_groups;
namespace pg8 {
#define PG8_LAS __attribute__((address_space(3)))
typedef unsigned short bf16_t;
typedef short bf16x8 __attribute__((ext_vector_type(8)));
typedef float f32x4 __attribute__((ext_vector_type(4)));
typedef unsigned u32x4 __attribute__((ext_vector_type(4)));
constexpr int BM = 256, BK = 64, HALF = 128, HTB = HALF * BK * 2  , STAGE_BYTES = 8 * HTB, NXCD = 8, WGM = 8;

__host__ __device__ __forceinline__ int lds_byte(int r, int c) { const int st = (r >> 4) * 2 + (c >> 5), rr = r & 15, cc = c & 31, ob = rr * 64 + cc * 2; return st * 1024 + (ob ^ (((ob >> 9) & 1) << 5)); }
__host__ __device__ __forceinline__ void stage_rc(int b, int& R, int& C) { const int st = b / 1024, sb = b % 1024, swz = sb ^ (((sb >> 9) & 1) << 5); R = (st >> 1) * 16 + swz / 64; C = (st & 1) * 32 + (swz % 64) / 2; }
__host__ __device__ __forceinline__ int perm32(int rho) { const int n = rho >> 4, i = rho & 15; return 8 * (i >> 2) + 4 * n + (i & 3); }

struct Unit { int pm, pn; };
struct Gemm { const bf16_t* A; const bf16_t* Bt; int M, N, K; };

struct StaticOrder {
    int nM, nN, nwg, G, c;
    __host__ __device__ void init(int M, int N, int G_, int c_) { nM = M / BM; nN = N / BM; nwg = nM * nN; G = G_; c = c_; }
    __host__ __device__ bool next(int i, Unit& u) const {
        const long L = (long)i * G + c; if (L >= nwg) return false;
        int wgid = (int)L; { const int q = nwg / NXCD, r = nwg % NXCD, xcd = wgid % NXCD, off = wgid / NXCD; wgid = (xcd < r ? xcd * (q + 1) : r * (q + 1) + (xcd - r) * q) + off; }
        const int nig = WGM * nN, gid = wgid / nig, fm = gid * WGM, gsz = (nM - fm) < WGM ? (nM - fm) : WGM;
        u.pm = fm + ((wgid % nig) % gsz); u.pn = (wgid % nig) / gsz; return true;
    }
    __device__ __forceinline__ void a_ready(const Unit&) const {}
    __device__ __forceinline__ void done(const Unit&) const {}
};

__device__ __forceinline__ unsigned cvt_pk_bf16(float lo, float hi) { unsigned r; asm volatile("v_cvt_pk_bf16_f32 %0, %1, %2" : "=v"(r) : "v"(lo), "v"(hi)); return r; }
typedef float f32x2 __attribute__((ext_vector_type(2)));
__device__ __forceinline__ f32x2 gelu_pk(f32x2 v) {
    const f32x2 av = __builtin_elementwise_abs(v), d = av * 0.2316418882f + 1.0f;
    f32x2 t; t.x = __builtin_amdgcn_rcpf(d.x); t.y = __builtin_amdgcn_rcpf(d.y);
    f32x2 q = t * 0.5307027145f + (-0.7265760135f); q = q * t + 0.7107068705f; q = q * t + (-0.142248368f); q = q * t + 0.127414796f; q = q * t;
    const f32x2 s = (v * v) * (-0.72134752044f);
    f32x2 e; e.x = __builtin_amdgcn_exp2f(s.x); e.y = __builtin_amdgcn_exp2f(s.y);
    const f32x2 m = v * (q * e), r = v - m;
    f32x2 o; o.x = v.x < 0.f ? m.x : r.x; o.y = v.y < 0.f ? m.y : r.y; return o;
}

template <int ACT  > struct EpiBf16 {
    static constexpr bool PERM = true, AFTER_DRAIN = false; static_assert(ACT == 0 || ACT == 1, "EpiBf16: ACT is 0 (none) or 1 (gelu_pk)");
    bf16_t* O; int ldc; const float* bias; int split_cols; size_t split_stride; float scale0;
    __device__ __forceinline__ void operator()(const f32x4 (&acc)[2][2][4][2], const Unit& u, int wr, int wc, int fr, int fq) const {
        const int row0 = u.pm * BM + wr * 64 + fr; int colt = u.pn * BM; bf16_t* base = O;
        float sc = 1.f; if (split_cols) { const int t = colt / split_cols; base += (size_t)t * split_stride; colt -= t * split_cols; if (t == 0) sc = scale0; }
        const int col0 = colt + wc * 32 + 8 * fq, bcol0 = u.pn * BM + wc * 32 + 8 * fq;
        f32x4 bv[2][2];
#pragma unroll
        for (int bj = 0; bj < 2; ++bj)
#pragma unroll
            for (int n = 0; n < 2; ++n) bv[bj][n] = bias ? *(const f32x4*)(bias + bcol0 + bj * HALF + 4 * n) : (f32x4){0.f, 0.f, 0.f, 0.f};
#pragma unroll
        for (int ai = 0; ai < 2; ++ai)
#pragma unroll
            for (int m = 0; m < 4; ++m) { bf16_t* rowp = base + (size_t)(row0 + ai * HALF + m * 16) * ldc + col0;
#pragma unroll
                for (int bj = 0; bj < 2; ++bj) { f32x4 v0 = acc[ai][bj][m][0] + bv[bj][0], v1 = acc[ai][bj][m][1] + bv[bj][1];
                    if (ACT == 1) { f32x2 a = gelu_pk((f32x2){v0[0], v0[1]}), b = gelu_pk((f32x2){v0[2], v0[3]}), c = gelu_pk((f32x2){v1[0], v1[1]}), d = gelu_pk((f32x2){v1[2], v1[3]});
                        v0 = (f32x4){a.x, a.y, b.x, b.y}; v1 = (f32x4){c.x, c.y, d.x, d.y}; }
                    v0 = v0 * sc; v1 = v1 * sc; u32x4 w; w.x = cvt_pk_bf16(v0[0], v0[1]); w.y = cvt_pk_bf16(v0[2], v0[3]); w.z = cvt_pk_bf16(v1[0], v1[1]); w.w = cvt_pk_bf16(v1[2], v1[3]);
                    *(u32x4*)(rowp + bj * HALF) = w; } }
    }
};

struct PanelStats {
    unsigned* xbuf;
    unsigned* cnt;
    unsigned* tmo;
    int ntn; float eps;
    unsigned code;
    __device__ __forceinline__ bool run(const f32x4 (&v)[2][2][4][2], const Unit& u, int wr, int wc, int fr, int fq, PG8_LAS unsigned char* lds, int wid, int lane) const {
        typedef float f32x2v __attribute__((ext_vector_type(2)));
        PG8_LAS f32x2v* P = (PG8_LAS f32x2v*)lds;
        PG8_LAS f32x2v* S = (PG8_LAS f32x2v*)(lds + 8192);
        PG8_LAS unsigned* flag = (PG8_LAS unsigned*)(lds + 8192 + 2048);
#pragma unroll
        for (int ai = 0; ai < 2; ++ai)
#pragma unroll
            for (int m = 0; m < 4; ++m) {
                float s = 0.f;
#pragma unroll
                for (int bj = 0; bj < 2; ++bj)
#pragma unroll
                    for (int n = 0; n < 2; ++n) { const f32x4 x = v[ai][bj][m][n]; s += (x[0] + x[1]) + (x[2] + x[3]); }
                s += __shfl_xor(s, 16); s += __shfl_xor(s, 32);
                const float mw = s * (1.0f / 64.0f); float q = 0.f;
#pragma unroll
                for (int bj = 0; bj < 2; ++bj)
#pragma unroll
                    for (int n = 0; n < 2; ++n) { const f32x4 d = v[ai][bj][m][n] - mw; q += (d[0] * d[0] + d[1] * d[1]) + (d[2] * d[2] + d[3] * d[3]); }
                q += __shfl_xor(q, 16); q += __shfl_xor(q, 32);
                if (fq == 0) P[(ai * HALF + wr * 64 + m * 16 + fr) * 4 + wc] = (f32x2v){mw, q};
            }
        asm volatile("s_waitcnt lgkmcnt(0)" ::: "memory"); __builtin_amdgcn_s_barrier(); asm volatile("" ::: "memory");
#if defined(BROKEN_EXCHANGE_NO_WAIT)
#warning BROKEN CONTROL BUILD: the row-statistics exchange does not wait; results are wrong by design
        if (blockIdx.x >= 64) { const long long t0_ = clock64(); while (clock64() - t0_ < 60000) __builtin_amdgcn_s_sleep(8); }
#endif
        const int row = wid * 32 + (lane & 31);
        if (lane < 32) {
            const f32x2v a = P[row * 4 + 0], b = P[row * 4 + 1], c = P[row * 4 + 2], d = P[row * 4 + 3];
            const float mt = (a.x + b.x + c.x + d.x) * 0.25f;
            const float da = a.x - mt, db = b.x - mt, dc = c.x - mt, dd = d.x - mt;
            const float m2 = (a.y + b.y) + (c.y + d.y) + 64.0f * ((da * da + db * db) + (dc * dc + dd * dd));
            unsigned long long* slot = (unsigned long long*)xbuf + ((size_t)(u.pm * BM + row) * 4 + u.pn);
            __hip_atomic_store(slot, ((unsigned long long)__float_as_uint(m2) << 32) | __float_as_uint(mt), __ATOMIC_RELAXED, __HIP_MEMORY_SCOPE_AGENT);
        }
        asm volatile("s_waitcnt vmcnt(0)" ::: "memory");
        if (lane == 0) __hip_atomic_fetch_add(cnt + 64 * u.pm, 1u, __ATOMIC_RELAXED, __HIP_MEMORY_SCOPE_AGENT);
        if (wid == 0) {
            bool dead = false; const unsigned long long t0 = __builtin_amdgcn_s_memrealtime(); const unsigned want = 8u * (unsigned)ntn;
            for (;;) {
#if defined(BROKEN_EXCHANGE_NO_WAIT)
                break;
#endif
                if ((unsigned)__builtin_amdgcn_readfirstlane(__hip_atomic_load(cnt + 64 * u.pm, __ATOMIC_RELAXED, __HIP_MEMORY_SCOPE_AGENT)) >= want) break;
                if (__builtin_amdgcn_s_memrealtime() - t0 > 2000000ull) {
                    if (lane == 0) { unsigned expect = 0u; __hip_atomic_compare_exchange_strong(tmo + 1, &expect, code | (unsigned)(u.pm & 0xff), __ATOMIC_RELAXED, __ATOMIC_RELAXED, __HIP_MEMORY_SCOPE_AGENT);
                                     __hip_atomic_store(tmo, 1u, __ATOMIC_RELAXED, __HIP_MEMORY_SCOPE_AGENT); }
                    dead = true; break; }
                __builtin_amdgcn_s_sleep(2);
            }
            __builtin_amdgcn_fence(__ATOMIC_ACQUIRE, "agent");
            if (lane == 0) flag[0] = dead ? 1u : 0u;
        }
        asm volatile("s_waitcnt vmcnt(0) lgkmcnt(0)" ::: "memory"); __builtin_amdgcn_s_barrier(); asm volatile("" ::: "memory");
        const bool bad = flag[0] != 0u;
        if (lane < 32) {
            const unsigned long long* slot = (const unsigned long long*)xbuf + (size_t)(u.pm * BM + row) * 4; float mt[4], m2[4]; float ms = 0.f;
#pragma unroll
            for (int t = 0; t < 4; ++t) { if (t < ntn) { const unsigned long long w = __hip_atomic_load(slot + t, __ATOMIC_RELAXED, __HIP_MEMORY_SCOPE_AGENT); mt[t] = __uint_as_float((unsigned)w); m2[t] = __uint_as_float((unsigned)(w >> 32)); } else { mt[t] = 0.f; m2[t] = 0.f; } ms += mt[t]; }
            const float mean = ms / (float)ntn; float q = 0.f;
#pragma unroll
            for (int t = 0; t < 4; ++t) if (t < ntn) { const float dm = mt[t] - mean; q += m2[t] + 256.0f * dm * dm; }
            S[row] = (f32x2v){mean, 1.0f / sqrtf(q / (256.0f * (float)ntn) + eps)};
        }
        asm volatile("s_waitcnt lgkmcnt(0)" ::: "memory"); __builtin_amdgcn_s_barrier(); asm volatile("" ::: "memory");
        return bad;
    }
};
struct EpiLnRes {
    static constexpr bool PERM = false, AFTER_DRAIN = true;
    const float* base; float* out; int ldc; const float* bias; PanelStats st; unsigned poison;
    __device__ __forceinline__ void fused(f32x4 (&acc)[2][2][4][2], const Unit& u, int wr, int wc, int fr, int fq, PG8_LAS unsigned char* lds, int wid, int lane) const {
        typedef float f32x2v __attribute__((ext_vector_type(2)));
        const PG8_LAS f32x2v* S = (const PG8_LAS f32x2v*)(lds + 8192);
        const int col0 = u.pn * BM + wc * 32 + 4 * fq;
#pragma unroll
        for (int bj = 0; bj < 2; ++bj)
#pragma unroll
            for (int n = 0; n < 2; ++n) { const f32x4 bv = bias ? *(const f32x4*)(bias + col0 + bj * HALF + n * 16) : (f32x4){0.f, 0.f, 0.f, 0.f};
#pragma unroll
                for (int ai = 0; ai < 2; ++ai)
#pragma unroll
                    for (int m = 0; m < 4; ++m) acc[ai][bj][m][n] += bv; }
        f32x4 pre[4][2][2];
#pragma unroll
        for (int m = 0; m < 4; ++m) { const size_t off = (size_t)(u.pm * BM + wr * 64 + m * 16 + fr) * ldc + col0;
#pragma unroll
            for (int bj = 0; bj < 2; ++bj)
#pragma unroll
                for (int n = 0; n < 2; ++n) pre[m][bj][n] = *(const f32x4*)(base + off + bj * HALF + n * 16); }
        const bool bad = st.run(acc, u, wr, wc, fr, fq, lds, wid, lane) || poison != 0u;
        const float qnan = __builtin_nanf("");
#pragma unroll
        for (int ai = 0; ai < 2; ++ai)
#pragma unroll
            for (int m = 0; m < 4; ++m) { const int r = ai * HALF + wr * 64 + m * 16 + fr; const f32x2v sr = S[r]; const size_t off = (size_t)(u.pm * BM + r) * ldc + col0;
#pragma unroll
                for (int bj = 0; bj < 2; ++bj)
#pragma unroll
                    for (int n = 0; n < 2; ++n) { const f32x4 bs = ai == 0 ? pre[m][bj][n] : *(const f32x4*)(base + off + bj * HALF + n * 16); f32x4 o = bs + (acc[ai][bj][m][n] - sr.x) * sr.y;
                        if (bad) o = (f32x4){qnan, qnan, qnan, qnan}; *(f32x4*)(out + off + bj * HALF + n * 16) = o; }
                if (m & 1) asm volatile("" ::: "memory"); }
    }
};
struct EpiLnResLn {
    static constexpr bool PERM = false, AFTER_DRAIN = true;
    const float* base; float* out; bf16_t* xn; int ldc; const float* bias; PanelStats st1, st2; unsigned poison;
    __device__ __forceinline__ void fused(f32x4 (&acc)[2][2][4][2], const Unit& u, int wr, int wc, int fr, int fq, PG8_LAS unsigned char* lds, int wid, int lane) const {
        typedef float f32x2v __attribute__((ext_vector_type(2))); typedef unsigned u32x2v __attribute__((ext_vector_type(2)));
        const PG8_LAS f32x2v* S = (const PG8_LAS f32x2v*)(lds + 8192);
        const int col0 = u.pn * BM + wc * 32 + 4 * fq;
#pragma unroll
        for (int bj = 0; bj < 2; ++bj)
#pragma unroll
            for (int n = 0; n < 2; ++n) { const f32x4 bv = bias ? *(const f32x4*)(bias + col0 + bj * HALF + n * 16) : (f32x4){0.f, 0.f, 0.f, 0.f};
#pragma unroll
                for (int ai = 0; ai < 2; ++ai)
#pragma unroll
                    for (int m = 0; m < 4; ++m) acc[ai][bj][m][n] += bv; }
        bool bad = st1.run(acc, u, wr, wc, fr, fq, lds, wid, lane) || poison != 0u;
        const float qnan = __builtin_nanf("");
#pragma unroll
        for (int ai = 0; ai < 2; ++ai)
#pragma unroll
            for (int m = 0; m < 4; ++m) { const int r = ai * HALF + wr * 64 + m * 16 + fr; const f32x2v sr = S[r]; const size_t off = (size_t)(u.pm * BM + r) * ldc + col0;
#pragma unroll
                for (int bj = 0; bj < 2; ++bj)
#pragma unroll
                    for (int n = 0; n < 2; ++n) { const f32x4 bs = *(const f32x4*)(base + off + bj * HALF + n * 16); acc[ai][bj][m][n] = bs + (acc[ai][bj][m][n] - sr.x) * sr.y; }
                asm volatile("" : "+v"(acc[ai][0][m][0]), "+v"(acc[ai][0][m][1]), "+v"(acc[ai][1][m][0]), "+v"(acc[ai][1][m][1]));
                if (m & 1) asm volatile("" ::: "memory"); }
        const bool bad1 = bad;
        bad = st2.run(acc, u, wr, wc, fr, fq, lds, wid, lane) || bad;
#pragma unroll
        for (int ai = 0; ai < 2; ++ai)
#pragma unroll
            for (int m = 0; m < 4; ++m) { const int r = ai * HALF + wr * 64 + m * 16 + fr; const f32x2v sr = S[r]; const size_t off = (size_t)(u.pm * BM + r) * ldc + col0;
#pragma unroll
                for (int bj = 0; bj < 2; ++bj)
#pragma unroll
                    for (int n = 0; n < 2; ++n) { const f32x4 x1 = acc[ai][bj][m][n]; *(f32x4*)(out + off + bj * HALF + n * 16) = bad1 ? (f32x4){qnan, qnan, qnan, qnan} : x1;
                        const f32x4 o = (x1 - sr.x) * sr.y; u32x2v w; w.x = cvt_pk_bf16(o[0], o[1]); w.y = cvt_pk_bf16(o[2], o[3]);
                        if (bad) { w.x = 0x7fc07fc0u; w.y = 0x7fc07fc0u; } *(u32x2v*)(xn + off + bj * HALF + n * 16) = w; }
                asm volatile("" ::: "memory"); }
    }
};

template <class Epi, class Sched, bool ALIGN_EPI = false, bool SP2 = false>
__device__ __forceinline__ void gemm_phase(PG8_LAS unsigned char* lds, const Gemm g, const Sched& S, const Epi& E) {
    int tid_ = threadIdx.x; asm volatile("" : "+v"(tid_));
    const int tid = tid_, wid = __builtin_amdgcn_readfirstlane(tid >> 6), lane = tid & 63, wr = wid >> 2, wc = wid & 3, fr = lane & 15, fq = lane >> 4;
    const int K = g.K, nt = K / BK;
    unsigned voffA[2], voffB[2];
#pragma unroll
    for (int i = 0; i < 2; ++i) { int R, C; stage_rc(tid * 16 + i * 8192, R, C); const int Rb = Epi::PERM ? ((R & ~31) + perm32(R & 31)) : R;
        voffA[i] = (unsigned)(R * K + C) * 2u; voffB[i] = (unsigned)(Rb * K + C) * 2u; }
    const size_t kstep = (size_t)(BK * 2);
    const size_t hstep = (size_t)HALF * K * 2;
    const size_t tstep = 2 * hstep;
    const unsigned ldsw = (unsigned)wid * 1024u;
    const int aoff = lds_byte(wr * 64 + fr, fq * 8), boff = lds_byte(wc * 32 + fr, fq * 8);
#define PG8_SA(b, h) (((b) * 2 + (h)) * HTB)
#define PG8_SB(b, h) ((4 + (b) * 2 + (h)) * HTB)
#define PG8_STAGE(bufoff, gbase, voff) do { _Pragma("unroll") for (int _i = 0; _i < 2; ++_i) \
        __builtin_amdgcn_global_load_lds((const unsigned*)((const char*)(gbase) + (voff)[_i]), (PG8_LAS unsigned*)(lds + (bufoff) + ldsw + _i * 8192), 16, 0, 0); } while (0)
#define PG8_LDA(dst, b, h) do { _Pragma("unroll") for (int m = 0; m < 4; ++m) _Pragma("unroll") for (int k = 0; k < 2; ++k) dst[m][k] = *(const PG8_LAS bf16x8*)(lds + PG8_SA(b, h) + aoff + m * 2048 + k * 1024); } while (0)
#define PG8_LDB(dst, b, h) do { _Pragma("unroll") for (int n = 0; n < 2; ++n) _Pragma("unroll") for (int k = 0; k < 2; ++k) dst[n][k] = *(const PG8_LAS bf16x8*)(lds + PG8_SB(b, h) + boff + n * 2048 + k * 1024); } while (0)
#define PG8_MMA(ai, bj, At, Bt) do { __builtin_amdgcn_s_setprio(1); _Pragma("unroll") for (int m = 0; m < 4; ++m) _Pragma("unroll") for (int n = 0; n < 2; ++n) _Pragma("unroll") for (int k = 0; k < 2; ++k) \
        acc[ai][bj][m][n] = __builtin_amdgcn_mfma_f32_16x16x32_bf16(Bt[n][k], At[m][k], acc[ai][bj][m][n], 0, 0, 0); __builtin_amdgcn_s_setprio(0); } while (0)
#define PG8_WAIT_V(n) asm volatile("s_waitcnt vmcnt(" #n ")" ::: "memory")
#define PG8_WAIT_L(n) asm volatile("s_waitcnt lgkmcnt(" #n ")" ::: "memory")
#define PG8_BAR __builtin_amdgcn_s_barrier()
#define PG8_SCHED __builtin_amdgcn_sched_barrier(0)
    Unit cur, nxt; int ui = 0;
    if (!S.next(0, cur)) return;
    f32x4 acc[2][2][4][2];
#pragma unroll
    for (int a = 0; a < 2; ++a)
#pragma unroll
        for (int b = 0; b < 2; ++b)
#pragma unroll
            for (int m = 0; m < 4; ++m)
#pragma unroll
                for (int n = 0; n < 2; ++n) acc[a][b][m][n] = (f32x4){0.f, 0.f, 0.f, 0.f};
    bf16x8 At[4][2], B0[2][2], B1[2][2];
    const char* cA = (const char*)g.A + (size_t)cur.pm * tstep; const char* cB = (const char*)g.Bt + (size_t)cur.pn * tstep;
    S.a_ready(cur);
    if constexpr (SP2) {
        PG8_STAGE(PG8_SB(0, 0), cB, voffB); PG8_STAGE(PG8_SB(0, 1), cB + hstep, voffB); PG8_STAGE(PG8_SA(0, 0), cA, voffA); PG8_STAGE(PG8_SA(0, 1), cA + hstep, voffA);
        if (wr == 1) PG8_BAR;
        PG8_WAIT_V(2); PG8_BAR;
        PG8_STAGE(PG8_SB(1, 0), cB + kstep, voffB); PG8_STAGE(PG8_SA(1, 0), cA + kstep, voffA); PG8_STAGE(PG8_SB(1, 1), cB + hstep + kstep, voffB);
        PG8_WAIT_V(6); PG8_BAR;
    } else {
        PG8_STAGE(PG8_SB(0, 0), cB, voffB); PG8_STAGE(PG8_SA(0, 0), cA, voffA); PG8_STAGE(PG8_SB(0, 1), cB + hstep, voffB); PG8_STAGE(PG8_SA(0, 1), cA + hstep, voffA);
        if (wr == 1) PG8_BAR;
        PG8_WAIT_V(4); PG8_BAR;
        PG8_STAGE(PG8_SB(1, 0), cB + kstep, voffB); PG8_STAGE(PG8_SA(1, 0), cA + kstep, voffA); PG8_STAGE(PG8_SB(1, 1), cB + hstep + kstep, voffB);
        PG8_WAIT_V(6); PG8_BAR;
    }
    for (;;) {
        const bool has_next = S.next(ui + 1, nxt);
        const char* nA = has_next ? (const char*)g.A + (size_t)nxt.pm * tstep : cA; const char* nB = has_next ? (const char*)g.Bt + (size_t)nxt.pn * tstep : cB;
        for (int t = 0; t < nt; t += 2) {
            const bool last = (t == nt - 2);
            const char* a1 = cA + (size_t)(t + 1) * kstep;
            const char* a2 = last ? nA : cA + (size_t)(t + 2) * kstep; const char* b2 = last ? nB : cB + (size_t)(t + 2) * kstep;
            const char* a3 = a2 + kstep; const char* b3 = b2 + kstep;
            if (last && has_next) S.a_ready(nxt);
            if constexpr (SP2) {
            PG8_LDB(B0, 0, 0); PG8_LDB(B1, 0, 1); PG8_SCHED; PG8_LDA(At, 0, 0); PG8_STAGE(PG8_SA(1, 1), a1 + hstep, voffA);
            PG8_WAIT_V(8); PG8_WAIT_L(0); PG8_BAR; PG8_MMA(0, 0, At, B0); PG8_MMA(0, 1, At, B1); PG8_BAR; PG8_SCHED;
            PG8_LDA(At, 0, 1); PG8_STAGE(PG8_SB(0, 0), b2, voffB); PG8_STAGE(PG8_SB(0, 1), b2 + hstep, voffB); PG8_STAGE(PG8_SA(0, 0), a2, voffA);
            PG8_WAIT_V(8); PG8_WAIT_L(0); PG8_BAR; PG8_MMA(1, 0, At, B0); PG8_MMA(1, 1, At, B1); PG8_BAR; PG8_SCHED;
            PG8_LDB(B0, 1, 0); PG8_LDB(B1, 1, 1); PG8_SCHED; PG8_LDA(At, 1, 0); PG8_STAGE(PG8_SA(0, 1), a2 + hstep, voffA);
            PG8_WAIT_V(8); PG8_WAIT_L(0); PG8_BAR; PG8_MMA(0, 0, At, B0); PG8_MMA(0, 1, At, B1); PG8_BAR; PG8_SCHED;
            PG8_LDA(At, 1, 1); PG8_STAGE(PG8_SB(1, 0), b3, voffB); PG8_STAGE(PG8_SB(1, 1), b3 + hstep, voffB); PG8_STAGE(PG8_SA(1, 0), a3, voffA);
            PG8_WAIT_V(8); PG8_WAIT_L(0); PG8_BAR; PG8_MMA(1, 0, At, B0); PG8_MMA(1, 1, At, B1); PG8_BAR; PG8_SCHED;
            } else {
            PG8_LDB(B0, 0, 0); PG8_SCHED; PG8_LDA(At, 0, 0); PG8_STAGE(PG8_SA(1, 1), a1 + hstep, voffA);
            PG8_WAIT_L(8); PG8_BAR; PG8_WAIT_L(0); PG8_MMA(0, 0, At, B0); PG8_BAR; PG8_SCHED;
            PG8_LDB(B1, 0, 1); PG8_STAGE(PG8_SB(0, 0), b2, voffB);
            PG8_BAR; PG8_WAIT_L(0); PG8_MMA(0, 1, At, B1); PG8_BAR;
            PG8_LDA(At, 0, 1); PG8_STAGE(PG8_SA(0, 0), a2, voffA);
            PG8_BAR; PG8_WAIT_L(0); PG8_MMA(1, 0, At, B0); PG8_BAR; PG8_SCHED;
            PG8_STAGE(PG8_SB(0, 1), b2 + hstep, voffB);
            PG8_WAIT_V(6); PG8_BAR; PG8_MMA(1, 1, At, B1); PG8_BAR;
            PG8_LDB(B0, 1, 0); PG8_SCHED; PG8_LDA(At, 1, 0); PG8_STAGE(PG8_SA(0, 1), a2 + hstep, voffA);
            PG8_WAIT_L(8); PG8_BAR; PG8_WAIT_L(0); PG8_MMA(0, 0, At, B0); PG8_BAR; PG8_SCHED;
            PG8_LDB(B1, 1, 1); PG8_STAGE(PG8_SB(1, 0), b3, voffB);
            PG8_BAR; PG8_WAIT_L(0); PG8_MMA(0, 1, At, B1); PG8_BAR;
            PG8_LDA(At, 1, 1); PG8_STAGE(PG8_SA(1, 0), a3, voffA);
            PG8_BAR; PG8_WAIT_L(0); PG8_MMA(1, 0, At, B0); PG8_BAR; PG8_SCHED;
            PG8_STAGE(PG8_SB(1, 1), b3 + hstep, voffB);
            PG8_WAIT_V(6); PG8_BAR; PG8_MMA(1, 1, At, B1); PG8_BAR;
            }
        }
        if constexpr (ALIGN_EPI) { if (wr == 0) PG8_BAR; }
        if constexpr (!Epi::AFTER_DRAIN) { E(acc, cur, wr, wc, fr, fq); S.done(cur); }
        if (!has_next) break;
#pragma unroll
        for (int a = 0; a < 2; ++a)
#pragma unroll
            for (int b = 0; b < 2; ++b)
#pragma unroll
                for (int m = 0; m < 4; ++m)
#pragma unroll
                    for (int n = 0; n < 2; ++n) acc[a][b][m][n] = (f32x4){0.f, 0.f, 0.f, 0.f};
        cur = nxt; cA = nA; cB = nB; ++ui;
        if constexpr (ALIGN_EPI) { if (wr == 1) PG8_BAR; }
    }
    PG8_WAIT_V(0);
    if constexpr (!ALIGN_EPI) { if (wr == 0) PG8_BAR; }
    PG8_BAR;
    if constexpr (Epi::AFTER_DRAIN) { E.fused(acc, cur, wr, wc, fr, fq, lds, wid, lane); S.done(cur); }
#undef PG8_SA
#undef PG8_SB
#undef PG8_STAGE
#undef PG8_LDA
#undef PG8_LDB
#undef PG8_MMA
#undef PG8_WAIT_V
#undef PG8_WAIT_L
#undef PG8_BAR
#undef PG8_SCHED
}
}
namespace pg8 {
struct EpiResid {
    static constexpr bool PERM = false, AFTER_DRAIN = false;
    float* x; int ldc; float alpha;
    __device__ __forceinline__ void operator()(const f32x4 (&acc)[2][2][4][2], const Unit& u, int wr, int wc, int fr, int fq) const {
        const int col0 = u.pn * BM + wc * 32 + 4 * fq;
#pragma unroll
        for (int ai = 0; ai < 2; ++ai)
#pragma unroll
            for (int m = 0; m < 4; ++m) { const int r = ai * HALF + wr * 64 + m * 16 + fr; const size_t off = (size_t)(u.pm * BM + r) * ldc + col0;
#pragma unroll
                for (int bj = 0; bj < 2; ++bj)
#pragma unroll
                    for (int n = 0; n < 2; ++n) { float* p = x + off + bj * HALF + n * 16; f32x4 v = *(const f32x4*)p; v = v * alpha + acc[ai][bj][m][n]; *(f32x4*)p = v; }
                if (m & 1) asm volatile("" ::: "memory"); }
    }
};

__device__ __forceinline__ float dpp_ror1(float v) { return __builtin_bit_cast(float, __builtin_amdgcn_update_dpp(0, __builtin_bit_cast(int, v), 0x121, 0xf, 0xf, false)); }
__device__ __forceinline__ float dpp_ror2(float v) { return __builtin_bit_cast(float, __builtin_amdgcn_update_dpp(0, __builtin_bit_cast(int, v), 0x122, 0xf, 0xf, false)); }
struct EpiConv {
    static constexpr bool PERM = false, AFTER_DRAIN = false;
    bf16_t* H; bf16_t* Gs; const float* cw; const float* cb; int nff;
    __device__ __forceinline__ void operator()(const f32x4 (&acc)[2][2][4][2], const Unit& u, int wr, int wc, int fr, int fq) const {
        typedef unsigned u32x2v __attribute__((ext_vector_type(2)));
        const int ch0 = u.pn * HALF + wc * 32 + 4 * fq;
        f32x4 w0[2], w1[2], w2[2], bb[2];
#pragma unroll
        for (int n = 0; n < 2; ++n) { w0[n] = *(const f32x4*)(cw + ch0 + 16 * n); w1[n] = *(const f32x4*)(cw + nff + ch0 + 16 * n); w2[n] = *(const f32x4*)(cw + 2 * nff + ch0 + 16 * n); bb[n] = *(const f32x4*)(cb + ch0 + 16 * n); }
#pragma unroll
        for (int ai = 0; ai < 2; ++ai)
#pragma unroll
            for (int m = 0; m < 4; ++m) { const size_t off = (size_t)(u.pm * BM + ai * HALF + wr * 64 + m * 16 + fr) * nff + ch0;
#pragma unroll
                for (int n = 0; n < 2; ++n) { const f32x4 g = acc[ai][0][m][n], v = acc[ai][1][m][n], gp = acc[ai][0][m > 0 ? m - 1 : 0][n];
                    f32x4 o;
#pragma unroll
                    for (int j = 0; j < 4; ++j) { const float a1 = dpp_ror1(g[j]), b1 = dpp_ror1(gp[j]), a2 = dpp_ror2(g[j]), b2 = dpp_ror2(gp[j]);
                        const float g1 = fr >= 1 ? a1 : b1, g2 = fr >= 2 ? a2 : b2;
                        const float cv = bb[n][j] + w0[n][j] * g2 + w1[n][j] * g1 + w2[n][j] * g[j];
                        o[j] = cv * __builtin_amdgcn_rcpf(1.0f + __expf(-cv)) * v[j]; }
                    const bool first2 = (m == 0) && (fr < 2);
                    if (first2) o = v;
                    u32x2v w; w.x = cvt_pk_bf16(o[0], o[1]); w.y = cvt_pk_bf16(o[2], o[3]);
                    *(u32x2v*)(H + off + 16 * n) = w;
                    if (first2 || ((m == 3) && (fr >= 14))) { u32x2v gw; gw.x = cvt_pk_bf16(g[0], g[1]); gw.y = cvt_pk_bf16(g[2], g[3]); *(u32x2v*)(Gs + off + 16 * n) = gw; }
                }
            }
    }
};
}
#define PG8_SP2 true
#define PG8_ALIGN true
#include <hip/hip_bf16.h>
#include <cmath>
namespace attn_body {
using bf16=__hip_bfloat16;
using bf16x8=__attribute__((ext_vector_type(8)))short;
using s16x4=__attribute__((ext_vector_type(4)))short;
using f32x16=__attribute__((ext_vector_type(16)))float;
using u32x4=__attribute__((ext_vector_type(4)))unsigned;
constexpr int BATCH=2,NHEAD=16,SEQ=16384,D=64,DM=3328,DMO=1024;
constexpr int NW=8,QBLK=32,QB=QBLK*NW,KVBLK=64,NQB=SEQ/QB;
constexpr int ATTN_PITCH=DM, ATTN_UNIT_ROWS=QB;
__device__ __forceinline__ int crow(int r,int hi){return (r&3)+8*(r>>2)+4*hi;}
#define SBAR() __builtin_amdgcn_sched_barrier(0)
__device__ __forceinline__ void cmask(f32x16&p0,f32x16&p1,int jb,int qrel,int hi){
  const float NEG=-INFINITY; int kb=64*jb+4*hi;
  #pragma unroll
  for(int r=0;r<16;++r){int kv=kb+(r&3)+8*(r>>2); if(kv>qrel)p0[r]=NEG; if(kv+32>qrel)p1[r]=NEG;}
}

constexpr int NSLOT=3, SLOTB=8192;
constexpr int LDS_K=0, LDS_V=NSLOT*SLOTB, LDS_WS=2*NSLOT*SLOTB, LDS_OST=LDS_WS+NW*64*4, LDS_BYTES=LDS_OST+NW*4096;
constexpr float C2=0.125f*1.4426950408889634f;
__device__ __forceinline__ void glds16(const void*gsrc,unsigned lds_dst){unsigned keep;
  asm volatile("s_mov_b32 %0, m0\n\ts_mov_b32 m0, %2\n\ts_nop 0\n\tglobal_load_lds_dwordx4 %1, off\n\ts_mov_b32 m0, %0":"=&s"(keep):"v"(gsrc),"s"(lds_dst):"memory");}
__device__ __forceinline__ float max3f(float a,float b,float c){float r;asm("v_max3_f32 %0, %1, %2, %3":"=v"(r):"v"(a),"v"(b),"v"(c));return r;}
__device__ __forceinline__ float max2f(float a,float b){float r;asm("v_max_f32_e32 %0, %1, %2":"=v"(r):"v"(a),"v"(b));return r;}
__device__ __forceinline__ float fadd_s(float a,float b){float r;asm("v_add_f32_e32 %0, %1, %2":"=v"(r):"v"(a),"v"(b));return r;}
__device__ __forceinline__ float fsub_s(float a,float b){float r;asm("v_sub_f32_e32 %0, %1, %2":"=v"(r):"v"(a),"v"(b));return r;}
typedef float f32x2_t __attribute__((ext_vector_type(2))); typedef __bf16 bf16x2_t __attribute__((ext_vector_type(2)));
__device__ __forceinline__ unsigned cvtpk_s(float lo,float hi){f32x2_t v={lo,hi};bf16x2_t b=__builtin_convertvector(v,bf16x2_t);return __builtin_bit_cast(unsigned,b);}
#define WAIT_BAR(N) asm volatile("s_waitcnt vmcnt(" #N ") lgkmcnt(0)\n\ts_barrier":::"memory")

__device__ __forceinline__ void qkt(f32x16&p0,f32x16&p1,const char*Kslot,const bf16x8*qr,const f32x16&negm,int r32,int hi){
  const char*kb=Kslot+hi*1024+r32*16;
  #pragma unroll
  for(int d0=0;d0<4;++d0){
    const bf16x8 b0=*reinterpret_cast<const bf16x8*>(kb+d0*2048);
    const bf16x8 b1=*reinterpret_cast<const bf16x8*>(kb+d0*2048+512);
    if(d0==0){p0=__builtin_amdgcn_mfma_f32_32x32x16_bf16(b0,qr[0],negm,0,0,0);p1=__builtin_amdgcn_mfma_f32_32x32x16_bf16(b1,qr[0],negm,0,0,0);}
    else{p0=__builtin_amdgcn_mfma_f32_32x32x16_bf16(b0,qr[d0],p0,0,0,0);p1=__builtin_amdgcn_mfma_f32_32x32x16_bf16(b1,qr[d0],p1,0,0,0);}}
}
typedef __attribute__((address_space(3))) const char* lds_cptr;
typedef short v4i16_t __attribute__((ext_vector_type(4)));
__device__ __forceinline__ void kload8(bf16x8*kf,lds_cptr kp){
  kf[0]=*(const __attribute__((address_space(3))) bf16x8*)(kp);      kf[1]=*(const __attribute__((address_space(3))) bf16x8*)(kp+512);
  kf[2]=*(const __attribute__((address_space(3))) bf16x8*)(kp+2048); kf[3]=*(const __attribute__((address_space(3))) bf16x8*)(kp+2560);
  kf[4]=*(const __attribute__((address_space(3))) bf16x8*)(kp+4096); kf[5]=*(const __attribute__((address_space(3))) bf16x8*)(kp+4608);
  kf[6]=*(const __attribute__((address_space(3))) bf16x8*)(kp+6144); kf[7]=*(const __attribute__((address_space(3))) bf16x8*)(kp+6656);
}
__device__ __forceinline__ void kload2(bf16x8*kf,lds_cptr kp,int j){ kf[2*j]=*(const __attribute__((address_space(3))) bf16x8*)(kp+j*2048); kf[2*j+1]=*(const __attribute__((address_space(3))) bf16x8*)(kp+j*2048+512); }
__device__ __forceinline__ s16x4 vtr(lds_cptr p){ return __builtin_bit_cast(s16x4,__builtin_amdgcn_ds_read_tr16_b64_v4i16((__attribute__((address_space(3))) v4i16_t*)p)); }
__device__ __forceinline__ float rowmax(const f32x16&p0,const f32x16&p1){
  float a=max3f(p0[0],p0[1],p1[0]),b=max3f(p0[2],p0[3],p1[1]);a=max3f(a,p1[2],p1[3]);
  #pragma unroll
  for(int r=4;r<16;r+=4){a=max3f(a,p0[r],p0[r+1]);b=max3f(b,p0[r+2],p0[r+3]);a=max3f(a,p1[r],p1[r+1]);b=max3f(b,p1[r+2],p1[r+3]);}
  const float m=max2f(a,b);
  auto rr=__builtin_amdgcn_permlane32_swap(__float_as_uint(m),__float_as_uint(m),false,false);
  return max2f(__uint_as_float(rr[0]),__uint_as_float(rr[1]));
}
__device__ __forceinline__ void pv(f32x16*o,int vb,bf16x8 pa0,bf16x8 pa1,bf16x8 pa2,bf16x8 pa3){
  #pragma unroll
  for(int d0=0;d0<2;++d0){s16x4 lo[4],hi[4];
    #pragma unroll
    for(int ks=0;ks<4;++ks){
      asm volatile("ds_read_b64_tr_b16 %0,%1 offset:%c2":"=&v"(lo[ks]):"v"(vb),"i"(d0*4096+ks*1024):"memory");
      asm volatile("ds_read_b64_tr_b16 %0,%1 offset:%c2":"=&v"(hi[ks]):"v"(vb),"i"(d0*4096+ks*1024+512):"memory");}
    asm volatile("s_waitcnt lgkmcnt(0)":::"memory");SBAR();
    #define PK(k) (bf16x8){lo[k][0],lo[k][1],lo[k][2],lo[k][3],hi[k][0],hi[k][1],hi[k][2],hi[k][3]}
    o[d0]=__builtin_amdgcn_mfma_f32_32x32x16_bf16(pa0,PK(0),o[d0],0,0,0);
    o[d0]=__builtin_amdgcn_mfma_f32_32x32x16_bf16(pa1,PK(1),o[d0],0,0,0);
    o[d0]=__builtin_amdgcn_mfma_f32_32x32x16_bf16(pa2,PK(2),o[d0],0,0,0);
    o[d0]=__builtin_amdgcn_mfma_f32_32x32x16_bf16(pa3,PK(3),o[d0],0,0,0);
    #undef PK
  }
}

#ifndef ATTN_STORE16
#define ATTN_STORE16(p,v) (*(u32x4*)(p)=(v))
#endif
template<int THRL> __device__ __forceinline__ void attn_unit(int b,int h,int qb,const bf16*Q,const bf16*__restrict__ K,const bf16*__restrict__ V,bf16*O,char*shm){
  int tid_=threadIdx.x; asm volatile("":"+v"(tid_)); const int tid=tid_,lane=tid&63,r32=lane&31,hi=lane>>5; const int wid=__builtin_amdgcn_readfirstlane(tid>>6);
  const long rowbase=(long)b*SEQ; const int q0=qb*QB;
  const bf16*Qw=Q+(rowbase+q0+wid*QBLK)*DM+h*D;
  const bf16*Kh=K+rowbase*DM+h*D,*Vh=V+rowbase*DM+h*D;
  const unsigned lds0=(unsigned)(uintptr_t)shm;
  float*wsf=(float*)(shm+LDS_WS)+wid*64;
  const bf16*ksrc=Kh+(long)lane*DM+wid*8;
  const bf16*vsrc=Vh+(long)(16*(wid&3)+(lane>>2))*DM+(wid>>2)*32+(lane&3)*8;
  const unsigned kdst=lds0+LDS_K+wid*1024, vdst=lds0+LDS_V+wid*1024;
  #define DMA_K(t,slot) glds16(ksrc+(long)(t)*KVBLK*DM,(unsigned)__builtin_amdgcn_readfirstlane(kdst+(slot)))
  #define DMA_V(t,slot) glds16(vsrc+(long)(t)*KVBLK*DM,(unsigned)__builtin_amdgcn_readfirstlane(vdst+(slot)))
  const int vb0=(int)(lds0+LDS_V)+((lane>>4)&1)*32+(lane&3)*8+(4*hi+((lane&15)>>2))*64;
  const char*Kbase=shm+LDS_K; bf16x8 kf[8];
  const lds_cptr shm3=(lds_cptr)shm; const lds_cptr kp0=shm3+LDS_K+hi*1024+r32*16; const lds_cptr vp0=shm3+LDS_V+((lane>>4)&1)*32+(lane&3)*8+(4*hi+((lane&15)>>2))*64;
  const int NT=(q0+QB)/KVBLK;
  DMA_K(0,0);DMA_V(0,0);DMA_K(1,SLOTB);
  bf16x8 qr[4];
  #pragma unroll
  for(int d0=0;d0<4;++d0)qr[d0]=*reinterpret_cast<const bf16x8*>(&Qw[(long)r32*DM+d0*16+hi*8]);
  float mhat=0.f,l_reg=0.f;f32x16 o[2];o[0]=f32x16{};o[1]=f32x16{};f32x16 negm=f32x16{};asm volatile("":"+v"(negm));
  const int qrel=wid*QBLK+r32;
  #define CMASK(P0,P1,t) do{int jb_=(t)-(NT-4); if(jb_>=0)cmask(P0,P1,jb_,qrel,hi);}while(0)
  bool resc=false;
  #define START(P0,P1) do{ const float rm=rowmax(P0,P1); resc=false; \
    { const float dl=rm; mhat=fadd_s(mhat,dl); \
      _Pragma("unroll") for(int r=0;r<16;++r){P0[r]=fsub_s(P0[r],dl);P1[r]=fsub_s(P1[r],dl);} \
      _Pragma("unroll") for(int r=0;r<16;++r)negm[r]=-mhat; asm volatile("":"+v"(negm)); } \
    _Pragma("unroll") for(int r=0;r<16;++r)P0[r]=__builtin_amdgcn_exp2f(P0[r]); }while(0)
  #define RESC() do{ if(resc){ asm volatile("s_waitcnt lgkmcnt(0)":::"memory"); \
      _Pragma("unroll") for(int d_=0;d_<2;++d_) _Pragma("unroll") for(int r=0;r<16;++r)o[d_][r]*=wsf[crow(r,hi)]; } }while(0)
  f32x16 pA0,pA1,pB0,pB1;
  int sl_prev=0,sl_cur=0,sl_next=SLOTB;
  #define ROT() do{sl_prev=sl_cur;sl_cur=sl_next;sl_next=(sl_next==(NSLOT-1)*SLOTB)?0:sl_next+SLOTB;}while(0)
  DMA_K(2,2*SLOTB);
  WAIT_BAR(3);
  qkt(pA0,pA1,Kbase,qr,negm,r32,hi);asm volatile("s_nop 15\n\ts_nop 7":"+v"(pA0),"+v"(pA1));CMASK(pA0,pA1,0);
  START(pA0,pA1);
  _Pragma("unroll") for(int r=0;r<16;++r)pA1[r]=__builtin_amdgcn_exp2f(pA1[r]);
  WAIT_BAR(0);
  DMA_K(3,0);DMA_V(1,SLOTB);
  ROT();
  kload8(kf,kp0+sl_cur);
  WAIT_BAR(2);
  s16x4 vlo[8],vhi[8]; u32x4 pw0,pw1,pw2,pw3;
  #define PKW(P,B) cvtpk_s(P[B],P[B+1])
  #define PAF(k) __builtin_bit_cast(bf16x8,pw##k)
  #define VFR(i) (bf16x8){vlo[i][0],vlo[i][1],vlo[i][2],vlo[i][3],vhi[i][0],vhi[i][1],vhi[i][2],vhi[i][3]}
  #define PIN(x) asm volatile("":"+v"(x))
  #define MX3(a,b,c) __builtin_fmaxf(__builtin_fmaxf((a),(b)),(c))
  #define GAPA(MF,A0,A1,A2,A3,W0,W1,PW) do{ MF; sacc+=A0; sacc+=A1; sacc+=A2; sacc+=A3; PIN(sacc); W0; W1; PIN(PW); SBAR(); }while(0)
  #define EX(v) __builtin_amdgcn_exp2f(v)
  #define GAPB(MF,X,B) do{ MF; X[B]=EX(X[B]); X[B+1]=EX(X[B+1]); X[B+2]=EX(X[B+2]); X[B+3]=EX(X[B+3]); PIN(X); SBAR(); }while(0)
  #define VRD(i) do{ vlo[i]=vtr(vp_+(((i)>>2)*4096+((i)&3)*1024)); vhi[i]=vtr(vp_+(((i)>>2)*4096+((i)&3)*1024+512)); }while(0)
  #define KRD(G,j) do{ if(G){ kload2(kf,kp0+sl_next,j); SBAR(); } }while(0)
  #define STEP(C0,C1,P0,P1,t,GK,GV,GL) do{ SBAR(); \
    const lds_cptr vp_=vp0+sl_prev; \
    VRD(0); SBAR(); float sacc=(P0[0]+P0[1]); \
    GAPA(C0=__builtin_amdgcn_mfma_f32_32x32x16_bf16(kf[0],qr[0],negm,0,0,0), P0[2],P0[3],P0[4],P0[5],     pw0[0]=PKW(P0,0), pw0[1]=PKW(P0,2), pw0); \
    VRD(4); SBAR(); GAPA(C1=__builtin_amdgcn_mfma_f32_32x32x16_bf16(kf[1],qr[0],negm,0,0,0), P0[6],P0[7],P0[8],P0[9],     pw0[2]=PKW(P0,4), pw0[3]=PKW(P0,6), pw0); \
    VRD(1); SBAR(); GAPA(C0=__builtin_amdgcn_mfma_f32_32x32x16_bf16(kf[2],qr[1],C0,0,0,0),   P0[10],P0[11],P0[12],P0[13], pw1[0]=PKW(P0,8), pw1[1]=PKW(P0,10), pw1); \
    VRD(5); SBAR(); GAPA(C1=__builtin_amdgcn_mfma_f32_32x32x16_bf16(kf[3],qr[1],C1,0,0,0),   P0[14],P0[15],P1[0],P1[1],   pw1[2]=PKW(P0,12),pw1[3]=PKW(P0,14), pw1); \
    VRD(2); SBAR(); GAPA(C0=__builtin_amdgcn_mfma_f32_32x32x16_bf16(kf[4],qr[2],C0,0,0,0),   P1[2],P1[3],P1[4],P1[5],     pw2[0]=PKW(P1,0), pw2[1]=PKW(P1,2), pw2); \
    VRD(6); SBAR(); GAPA(C1=__builtin_amdgcn_mfma_f32_32x32x16_bf16(kf[5],qr[2],C1,0,0,0),   P1[6],P1[7],P1[8],P1[9],     pw2[2]=PKW(P1,4), pw2[3]=PKW(P1,6), pw2); \
    VRD(3); SBAR(); GAPA(C0=__builtin_amdgcn_mfma_f32_32x32x16_bf16(kf[6],qr[3],C0,0,0,0),   P1[10],P1[11],P1[12],P1[13], pw3[0]=PKW(P1,8), pw3[1]=PKW(P1,10), pw3); \
    VRD(7); SBAR(); GAPA(C1=__builtin_amdgcn_mfma_f32_32x32x16_bf16(kf[7],qr[3],C1,0,0,0),   P1[14],P1[15],0.f,0.f,       pw3[2]=PKW(P1,12),pw3[3]=PKW(P1,14), pw3); \
    l_reg+=sacc; \
    if(GK){DMA_K((t)+3,sl_cur);} if(GV){DMA_V((t)+1,sl_next);} \
    CMASK(C0,C1,t); \
    { float a=MX3(C0[0],C0[1],C1[0]),b=MX3(C0[2],C0[3],C1[1]); a=MX3(a,C1[2],C1[3]); \
      _Pragma("unroll") for(int r=4;r<16;r+=4){a=MX3(a,C0[r],C0[r+1]);b=MX3(b,C0[r+2],C0[r+3]);a=MX3(a,C1[r],C1[r+1]);b=MX3(b,C1[r+2],C1[r+3]);} \
      float rm=__builtin_fmaxf(a,b); { auto rr=__builtin_amdgcn_permlane32_swap(__float_as_uint(rm),__float_as_uint(rm),false,false); rm=__builtin_fmaxf(__uint_as_float(rr[0]),__uint_as_float(rr[1])); } \
      resc=false; \
      if(__builtin_expect(__any(rm>(float)THRL),0)){ const float dl=__builtin_fmaxf(rm,0.f); mhat+=dl; \
        _Pragma("unroll") for(int r=0;r<16;++r){C0[r]-=dl;C1[r]-=dl;} \
        _Pragma("unroll") for(int r=0;r<16;++r)negm[r]=-mhat; asm volatile("":"+v"(negm)); \
        const float f=__builtin_amdgcn_exp2f(-dl); l_reg*=f; if(hi==0)wsf[r32]=f; resc=true; } } \
    SBAR(); \
    GAPB(o[0]=__builtin_amdgcn_mfma_f32_32x32x16_bf16(PAF(0),VFR(0),o[0],0,0,0), C0,0); \
    GAPB(o[1]=__builtin_amdgcn_mfma_f32_32x32x16_bf16(PAF(0),VFR(4),o[1],0,0,0), C0,4); \
    KRD(GL,0); GAPB(o[0]=__builtin_amdgcn_mfma_f32_32x32x16_bf16(PAF(1),VFR(1),o[0],0,0,0), C0,8); \
    KRD(GL,1); GAPB(o[1]=__builtin_amdgcn_mfma_f32_32x32x16_bf16(PAF(1),VFR(5),o[1],0,0,0), C0,12); \
    KRD(GL,2); GAPB(o[0]=__builtin_amdgcn_mfma_f32_32x32x16_bf16(PAF(2),VFR(2),o[0],0,0,0), C1,0); \
    KRD(GL,3); GAPB(o[1]=__builtin_amdgcn_mfma_f32_32x32x16_bf16(PAF(2),VFR(6),o[1],0,0,0), C1,4); \
    GAPB(o[0]=__builtin_amdgcn_mfma_f32_32x32x16_bf16(PAF(3),VFR(3),o[0],0,0,0), C1,8); \
    GAPB(o[1]=__builtin_amdgcn_mfma_f32_32x32x16_bf16(PAF(3),VFR(7),o[1],0,0,0), C1,12); \
    }while(0)
  int t=1;
  #undef CMASK
  #define CMASK(P0,P1,t) do{}while(0)
  for(;t+5<NT;t+=2){
    STEP(pB0,pB1,pA0,pA1,t,true,true,true);     WAIT_BAR(2); RESC(); ROT();
    STEP(pA0,pA1,pB0,pB1,t+1,true,true,true);   WAIT_BAR(2); RESC(); ROT();
  }
  #undef CMASK
  #define CMASK(P0,P1,t) do{int jb_=(t)-(NT-4); if(jb_>=0)cmask(P0,P1,jb_,qrel,hi);}while(0)
  #define ENDW(tt) do{ if((tt)+3<NT){WAIT_BAR(2);} else if((tt)+2<NT){WAIT_BAR(1);} else {WAIT_BAR(0);} }while(0)
  for(;t+1<NT;t+=2){
    STEP(pB0,pB1,pA0,pA1,t,(t+3<NT),(t+1<NT),(t+1<NT));       ENDW(t);   RESC(); ROT();
    STEP(pA0,pA1,pB0,pB1,t+1,(t+4<NT),(t+2<NT),(t+2<NT));     ENDW(t+1); RESC(); ROT();
  }
  STEP(pB0,pB1,pA0,pA1,NT-1,false,false,false); RESC();
  { float sacc=pB0[0]+pB0[1]; _Pragma("unroll") for(int r=2;r<16;++r)sacc+=pB0[r]; _Pragma("unroll") for(int r=0;r<16;++r)sacc+=pB1[r]; l_reg+=sacc;
    pw0=(u32x4){PKW(pB0,0),PKW(pB0,2),PKW(pB0,4),PKW(pB0,6)};pw1=(u32x4){PKW(pB0,8),PKW(pB0,10),PKW(pB0,12),PKW(pB0,14)};pw2=(u32x4){PKW(pB1,0),PKW(pB1,2),PKW(pB1,4),PKW(pB1,6)};pw3=(u32x4){PKW(pB1,8),PKW(pB1,10),PKW(pB1,12),PKW(pB1,14)};
    SBAR(); pv(o,vb0+sl_cur,PAF(0),PAF(1),PAF(2),PAF(3)); }
  #undef PKW
  #undef PAF
  #undef VFR
  #undef PIN
  #undef MX3
  #undef GAPA
  #undef GAPB
  #undef EX
  #undef VRD
  #undef KRD
  #undef STEP
  #undef ENDW
  {auto rr=__builtin_amdgcn_permlane32_swap(__float_as_uint(l_reg),__float_as_uint(l_reg),false,false);l_reg=__uint_as_float(rr[0])+__uint_as_float(rr[1]);}
  if(hi==0)wsf[32+r32]=l_reg;asm volatile("s_waitcnt lgkmcnt(0)":::"memory");
  float rli[16];
  #pragma unroll
  for(int r=0;r<16;++r)rli[r]=__builtin_amdgcn_rcpf(wsf[32+crow(r,hi)]);
  bf16*Ow=O+(rowbase+q0+wid*QBLK)*DMO+h*D;
  { bf16*stg=(bf16*)(shm+LDS_OST)+wid*2048;
    #pragma unroll
    for(int r=0;r<16;++r){const int orow=crow(r,hi);
      #pragma unroll
      for(int d0=0;d0<2;++d0)stg[orow*64+d0*32+r32]=__float2bfloat16(o[d0][r]*rli[r]);}
    asm volatile("s_waitcnt lgkmcnt(0)":::"memory");
    #pragma unroll
    for(int i=0;i<4;++i){const int row=i*8+(lane>>3),ch=lane&7; const u32x4 v=*(const u32x4*)(stg+row*64+ch*8); ATTN_STORE16(Ow+(long)row*DMO+ch*8,v);} }
  asm volatile("s_waitcnt lgkmcnt(0)\n\ts_barrier":::"memory");
  #undef DMA_K
  #undef DMA_V
  #undef CMASK
  #undef START
  #undef RESC
  #undef ROT
}
constexpr int ATTN_LDS_BYTES=LDS_BYTES;
#undef SBAR
#undef WAIT_BAR
}
#define LAS __attribute__((address_space(3)))
#define XB_TMO      128
#define XB_XCNT(j)  (256  + 64 * (j))
#define XB_XSUB(j)  (1280 + 64 * (j))
#define XB_XGEN(j)  (2304 + 64 * (j))
#define XB_TOP      3328
#define XB_TOPGEN   3392
#define XCD_BAR_WORDS 3456
#define XB_SPIN_CAP (1u << 18)

__device__ __forceinline__ unsigned xb_ld(unsigned* p)              { return __hip_atomic_load(p, __ATOMIC_RELAXED, __HIP_MEMORY_SCOPE_AGENT); }
__device__ __forceinline__ unsigned xb_add(unsigned* p, unsigned v) { return __hip_atomic_fetch_add(p, v, __ATOMIC_RELAXED, __HIP_MEMORY_SCOPE_AGENT); }
__device__ __forceinline__ unsigned xb_xcc_id() { return (unsigned)__builtin_amdgcn_s_getreg((3 << 11) | 20) & 0xFu; }
#define XB_SPIN(cond, bar) do { unsigned _sp = 0; while (cond) { __builtin_amdgcn_s_sleep(1); \
    if ((++_sp & 255u) == 0u) { if (xb_ld(&(bar)[XB_TMO])) break; if (_sp > XB_SPIN_CAP) { atomicAdd(&(bar)[XB_TMO], 1u); break; } } } } while (0)

struct XcdBarrier {
    unsigned* bar; unsigned x;
    volatile LAS unsigned* st;
};

__device__ __forceinline__ XcdBarrier xcd_barrier_post(unsigned* bar, volatile LAS unsigned* st) {
    XcdBarrier b; b.bar = bar; b.x = xb_xcc_id(); b.st = st;
    if (threadIdx.x == 0) (void)xb_add(&bar[XB_XCNT(b.x)], 1u);
    return b;
}
__device__ __forceinline__ void xcd_barrier_complete(unsigned* bar, unsigned x, unsigned& nloc, unsigned& nx) {
    const unsigned G = gridDim.x * gridDim.y * gridDim.z;
    unsigned sum, cnt, mine, sp = 0u;
    for (;;) {
        sum = 0u; cnt = 0u; mine = 0u;
#pragma unroll
        for (unsigned j = 0; j < 16; ++j) { const unsigned c = xb_ld(&bar[XB_XCNT(j)]); sum += c; cnt += (c > 0u) ? 1u : 0u; mine = (j == x) ? c : mine; }
        if (sum == G) break;
        __builtin_amdgcn_s_sleep(1);
        if ((++sp & 255u) == 0u) { if (xb_ld(&bar[XB_TMO])) break; if (sp > XB_SPIN_CAP) { atomicAdd(&bar[XB_TMO], 1u); break; } }
    }
    nloc = mine > 0u ? mine : 1u; nx = cnt > 0u ? cnt : 1u;
}

__device__ __forceinline__ void xcd_barrier(const XcdBarrier& b) {
    asm volatile("s_waitcnt vmcnt(0)" ::: "memory");
    __syncthreads();
    if (threadIdx.x == 0) {
        unsigned* bar = b.bar;
        __builtin_amdgcn_s_waitcnt(0);
        unsigned nloc = b.st[0], nx = b.st[1];
        if (nloc == 0u) { xcd_barrier_complete(bar, b.x, nloc, nx); b.st[0] = nloc; b.st[1] = nx; }
        const unsigned old = xb_add(&bar[XB_XSUB(b.x)], 1u);
        const unsigned gen = old / nloc;
        if (old + 1u == (gen + 1u) * nloc) {
            __builtin_amdgcn_fence(__ATOMIC_RELEASE, "agent");
            asm volatile("s_waitcnt vmcnt(0)" ::: "memory");
            const unsigned og = xb_add(&bar[XB_TOP], 1u);
            const unsigned tg = og / nx;
            if (og + 1u == (tg + 1u) * nx) xb_add(&bar[XB_TOPGEN], 1u);
            else XB_SPIN(xb_ld(&bar[XB_TOPGEN]) == tg, bar);
            __builtin_amdgcn_fence(__ATOMIC_ACQUIRE, "agent");
            xb_add(&bar[XB_XGEN(b.x)], 1u);
            asm volatile("s_waitcnt vmcnt(0)" ::: "memory");
        } else {
            XB_SPIN(xb_ld(&bar[XB_XGEN(b.x)]) == gen, bar);
            __builtin_amdgcn_fence(__ATOMIC_ACQUIRE, "agent");
            asm volatile("s_waitcnt vmcnt(0)" ::: "memory");
        }
    }
    __syncthreads();
}
typedef unsigned short bf16;
typedef unsigned v4u __attribute__((ext_vector_type(4)));
typedef unsigned v2u __attribute__((ext_vector_type(2)));
typedef float f32x4 __attribute__((ext_vector_type(4)));
typedef float f32x2 __attribute__((ext_vector_type(2)));
typedef short bf16x8 __attribute__((ext_vector_type(8)));

constexpr int NTOK = 32768, DMOD = 1024, SEQL = 16384, PW = 3328, DFF = 2816;
constexpr float ALPHA = 1.681792830507429f;
constexpr size_t MiB = 1u << 20;
constexpr size_t WS_WIN = 0, WS_WOUT = 7 * MiB, WS_WUP = 9 * MiB, WS_WDN = 20 * MiB, WS_WSP = 26 * MiB;
constexpr size_t WS_XN = 32 * MiB, WS_P = 96 * MiB, WS_GH = 304 * MiB, WS_CAT = 432 * MiB;
constexpr size_t WS_GATE = 96 * MiB, WS_VAL = 272 * MiB, WS_U = 96 * MiB, WS_V = 160 * MiB, WS_END = 496 * MiB;
constexpr int LDS_TOTAL = 147456;
constexpr size_t WS_CTL = 28 * MiB;
constexpr int NTHR = 512;

__device__ __forceinline__ float bflo(unsigned w) { return __uint_as_float(w << 16); }
__device__ __forceinline__ float bfhi(unsigned w) { return __uint_as_float(w & 0xffff0000u); }
__device__ __forceinline__ unsigned f2bf(float f) { unsigned u = __float_as_uint(f); return (u + 0x7fffu + ((u >> 16) & 1u)) >> 16; }
__device__ __forceinline__ unsigned pk2(float lo, float hi) { return f2bf(lo) | (f2bf(hi) << 16); }
__device__ __forceinline__ void unpack8(const v4u w, float* o) { o[0] = bflo(w.x); o[1] = bfhi(w.x); o[2] = bflo(w.y); o[3] = bfhi(w.y); o[4] = bflo(w.z); o[5] = bfhi(w.z); o[6] = bflo(w.w); o[7] = bfhi(w.w); }
__device__ __forceinline__ v4u pack8(const float* o) { v4u w; w.x = pk2(o[0], o[1]); w.y = pk2(o[2], o[3]); w.z = pk2(o[4], o[5]); w.w = pk2(o[6], o[7]); return w; }
__device__ __forceinline__ float wave_sum(float v) {
#pragma unroll
    for (int o = 1; o < 64; o <<= 1) v += __shfl_xor(v, o);
    return v;
}
__device__ __forceinline__ int opaque_tid() { int t = threadIdx.x; asm volatile("" : "+v"(t)); return t; }
#define TIDS const int tid = opaque_tid(), lane = tid & 63, wave = __builtin_amdgcn_readfirstlane(tid >> 6); (void)lane; (void)wave
#if defined(SEC_B)
#define SECT(n) do { if (tid == 0) { volatile unsigned long long* pa_ = (volatile unsigned long long*)((char*)sm + (LDS_TOTAL - 48)); \
    if ((n) == SEC_E || (n) == SEC_E2) pa_[0] += __builtin_amdgcn_s_memrealtime() - pa_[1]; if ((n) == SEC_B || (n) == SEC_B2) pa_[1] = __builtin_amdgcn_s_memrealtime(); } } while (0)
#else
#define SECT(n) do {} while (0)
#endif
__device__ __forceinline__ float sigmoidf_(float x) { return 1.f / (1.f + __expf(-x)); }
__device__ __forceinline__ float tanhf_(float x) { const float e = __expf(2.f * x); return 1.f - 2.f / (e + 1.f); }

template <bool GV = false  >
__device__ __forceinline__ void transpose_item(const float* W, int K, int N, bf16* WT, LAS float* scr, int item, int lane) {
    const int nblk = N / 32, kb = item / nblk, nb = item % nblk, k0 = 64 * kb, n0 = 32 * nb;
    const int half = N / 2, cg = GV ? (n0 >= half ? n0 - half : n0) : 0, r0 = GV ? ((cg >> 7) * 256 + (n0 >= half ? 128 : 0) + (cg & 127)) : n0;
#pragma unroll 8
    for (int i = 0; i < 32; ++i) { const int kk = 2 * i + (lane >> 5); scr[kk * 33 + (lane & 31)] = W[(size_t)(k0 + kk) * N + n0 + (lane & 31)]; }
    asm volatile("s_waitcnt lgkmcnt(0)" ::: "memory");
    const int c = lane & 7;
#pragma unroll
    for (int j = 0; j < 4; ++j) { const int n = (lane >> 3) + 8 * j; const LAS float* s = scr + (8 * c) * 33 + n;
        v4u o; o.x = pk2(s[0 * 33], s[1 * 33]); o.y = pk2(s[2 * 33], s[3 * 33]); o.z = pk2(s[4 * 33], s[5 * 33]); o.w = pk2(s[6 * 33], s[7 * 33]);
        *(v4u*)(WT + (size_t)(r0 + n) * K + k0 + 8 * c) = o; }
    asm volatile("s_waitcnt lgkmcnt(0)" ::: "memory");
}

constexpr int LD = 68, BUFF = 64 * LD;
__device__ __forceinline__ int mm_tm(int wave) { return wave < 4 ? (wave >> 1) : 3 - ((wave - 4) >> 1); }
struct KMin { const float* p; __device__ __forceinline__ f32x4 ld(int idx, int k) const { return *(const f32x4*)(p + idx * LD + k); } };
struct KMaj { const float* p; __device__ __forceinline__ f32x4 ld(int idx, int k) const { f32x4 v; v[0] = p[k * LD + idx]; v[1] = p[(k + 1) * LD + idx]; v[2] = p[(k + 2) * LD + idx]; v[3] = p[(k + 3) * LD + idx]; return v; } };
template <int KD, bool TRI  , class OA, class OB>
__device__ __forceinline__ void mm_acc_t(f32x4& c0, f32x4& c1, int wave, int lane, OA oa, OB ob) {
    const int tm = mm_tm(wave), tn0 = (wave & 1) * 2, li = lane & 15, lk = lane >> 4;
    const int kend = TRI ? 16 * (tm + 1) : KD;
    f32x4 a = oa.ld(tm * 16 + li, 4 * lk), b0 = ob.ld(tn0 * 16 + li, 4 * lk), b1 = ob.ld(tn0 * 16 + 16 + li, 4 * lk);
#pragma nounroll
    for (int kb = 0; kb < kend; kb += 16) {
        const int kn = ((kb + 16 < kend) ? kb + 16 : kb) + 4 * lk;
        const f32x4 an = oa.ld(tm * 16 + li, kn), b0n = ob.ld(tn0 * 16 + li, kn), b1n = ob.ld(tn0 * 16 + 16 + li, kn);
#pragma unroll
        for (int q = 0; q < 4; ++q) { c0 = __builtin_amdgcn_mfma_f32_16x16x4f32(a[q], b0[q], c0, 0, 0, 0); c1 = __builtin_amdgcn_mfma_f32_16x16x4f32(a[q], b1[q], c1, 0, 0, 0); }
        a = an; b0 = b0n; b1 = b1n;
    }
}
template <int KD, class OA, class OB>
__device__ __forceinline__ void mm_acc(f32x4& c0, f32x4& c1, int wave, int lane, OA oa, OB ob) { mm_acc_t<KD, false>(c0, c1, wave, lane, oa, ob); }
template <class FC>
__device__ __forceinline__ void mm_store(const f32x4& c0, const f32x4& c1, int wave, int lane, FC fc) {
    const int tm = mm_tm(wave), tn0 = (wave & 1) * 2, li = lane & 15, lk = lane >> 4;
#pragma unroll
    for (int r = 0; r < 4; ++r) { fc(tm * 16 + 4 * lk + r, tn0 * 16 + li, c0[r]); fc(tm * 16 + 4 * lk + r, tn0 * 16 + 16 + li, c1[r]); }
}

struct LsRaw { v4u cur, prv; };
__device__ __forceinline__ LsRaw ls_issue(const bf16* P, int tok0, int col0, bool seq_start, int tid) {
    const int row = tid >> 3, c8 = (tid & 7) * 8;
    const bf16* pr = P + (size_t)(tok0 + row) * PW + col0 + c8;
    LsRaw r; r.cur = *(const v4u*)pr; r.prv = (v4u){0u, 0u, 0u, 0u};
    if (!(seq_start && row == 0)) r.prv = *(const v4u*)(pr - PW);
    return r;
}
template <int ACT  >
__device__ __forceinline__ void ls_commit(float* dst, const LsRaw& r, const float* mu  , int tid) {
    const int row = tid >> 3, c8 = (tid & 7) * 8;
    float c[8], p[8]; unpack8(r.cur, c); unpack8(r.prv, p);
    const f32x4 m0 = *(const f32x4*)(mu + c8), m1 = *(const f32x4*)(mu + c8 + 4);
    const float m[8] = {m0[0], m0[1], m0[2], m0[3], m1[0], m1[1], m1[2], m1[3]};
    float x[8];
#pragma unroll
    for (int e = 0; e < 8; ++e) { x[e] = c[e] + m[e] * (p[e] - c[e]); if (ACT == 1) x[e] = tanhf_(x[e]); if (ACT == 2) x[e] = sigmoidf_(x[e]); }
    *(f32x4*)(dst + row * LD + c8) = (f32x4){x[0], x[1], x[2], x[3]}; *(f32x4*)(dst + row * LD + c8 + 4) = (f32x4){x[4], x[5], x[6], x[7]};
}
struct WRaw { f32x4 a, b; };
__device__ __forceinline__ WRaw w_issue(const float* W, int ldw, int row0, int col0, int tid) {
    const int row = tid >> 3, c8 = (tid & 7) * 8; const float* s = W + (size_t)(row0 + row) * ldw + col0 + c8;
    WRaw r; r.a = *(const f32x4*)s; r.b = *(const f32x4*)(s + 4); return r;
}
__device__ __forceinline__ void w_commit(float* dst, const WRaw& r, int tid) {
    const int row = tid >> 3, c8 = (tid & 7) * 8; *(f32x4*)(dst + row * LD + c8) = r.a; *(f32x4*)(dst + row * LD + c8 + 4) = r.b;
}
template <int K, class FA, class FB>
__device__ __forceinline__ f32x4 tile_mm(int lane, FA fa, FB fb) {
    const int li = lane & 15, lk = lane >> 4; f32x4 acc = {0.f, 0.f, 0.f, 0.f};
#pragma unroll
    for (int k0 = 0; k0 < K; k0 += 4) acc = __builtin_amdgcn_mfma_f32_16x16x4f32(fa(li, k0 + lk), fb(k0 + lk, li), acc, 0, 0, 0);
    return acc;
}
__device__ __forceinline__ void tri_inverse(float* T, const float* A, float* M, int tid, int wave, int lane) {
    for (int i = tid; i < 64 * LD; i += NTHR) T[i] = 0.f;
    __syncthreads();
    if (tid < 64) { const int d = tid >> 4, j = tid & 15; const float* Ad = A + (16 * d) * LD + 16 * d; float x[16];
#pragma unroll
        for (int t = 0; t < 16; ++t) { float acc = (t == j) ? 1.f : 0.f;
            f32x4 rw[4];
#pragma unroll
            for (int q4 = 0; q4 < 4; ++q4) if (4 * q4 < t) rw[q4] = *(const f32x4*)(Ad + t * LD + 4 * q4);
#pragma unroll
            for (int q = 0; q < t; ++q) acc += rw[q >> 2][q & 3] * x[q];
            x[t] = acc; asm volatile("" ::: "memory"); }
#pragma unroll
        for (int t = 0; t < 16; ++t) T[(16 * d + t) * LD + 16 * d + j] = x[t];
    }
    __syncthreads();
    const int li = lane & 15, lk = lane >> 4;
    if (wave < 2) { const int r0 = 16 * (2 * wave + 1), c0 = 16 * (2 * wave);
        const f32x4 acc = tile_mm<16>(lane, [=](int i, int k) { return A[(r0 + i) * LD + c0 + k]; }, [=](int k, int jj) { return T[(c0 + k) * LD + c0 + jj]; });
#pragma unroll
        for (int r = 0; r < 4; ++r) M[(r0 + 4 * lk + r) * LD + c0 + li] = acc[r]; }
    __syncthreads();
    if (wave < 2) { const int r0 = 16 * (2 * wave + 1), c0 = 16 * (2 * wave);
        const f32x4 acc = tile_mm<16>(lane, [=](int i, int k) { return T[(r0 + i) * LD + r0 + k]; }, [=](int k, int jj) { return M[(r0 + k) * LD + c0 + jj]; });
#pragma unroll
        for (int r = 0; r < 4; ++r) T[(r0 + 4 * lk + r) * LD + c0 + li] = acc[r]; }
    __syncthreads();
    if (wave < 4) { const int r0 = 32 + 16 * (wave >> 1), c0 = 16 * (wave & 1);
        const f32x4 acc = tile_mm<32>(lane, [=](int i, int k) { return A[(r0 + i) * LD + k]; }, [=](int k, int jj) { return T[k * LD + c0 + jj]; });
#pragma unroll
        for (int r = 0; r < 4; ++r) M[(r0 + 4 * lk + r) * LD + c0 + li] = acc[r]; }
    __syncthreads();
    if (wave < 4) { const int r0 = 32 + 16 * (wave >> 1), c0 = 16 * (wave & 1);
        const f32x4 acc = tile_mm<32>(lane, [=](int i, int k) { return T[(r0 + i) * LD + 32 + k]; }, [=](int k, int jj) { return M[(32 + k) * LD + c0 + jj]; });
#pragma unroll
        for (int r = 0; r < 4; ++r) T[(r0 + 4 * lk + r) * LD + c0 + li] = acc[r]; }
    __syncthreads();
}

struct RwkvW { const float *mu, *w0, *w2, *a0, *a2, *g2, *kk, *ka, *rk, *lg, *lb; };

constexpr int PK = 0, PV = 64, PXW = 128, PXA = 192, PR = 256, PXG = 320, PW0 = 448, PA0 = 512, PKK = 576, PKA = 640, PRK = 704, PLG = 768, PLB = 832, PAR_OFF = 8 * BUFF + 640;
__device__ __forceinline__ void stage_params(float* par, const RwkvW& w, int h, int tid) {
    const int seg = tid >> 6, l = tid & 63;
    const float* s1 = seg == 0 ? w.mu + 512 + h * 64 : seg == 1 ? w.mu + 1024 + h * 64 : seg == 2 ? w.mu + 1536 : seg == 3 ? w.mu + 1600 : seg == 4 ? w.mu + h * 64 : seg == 5 ? w.mu + 1664 : seg == 6 ? w.mu + 1728 : w.w0 + h * 64;
    par[seg * 64 + l] = s1[l];
    if (seg < 6) { const float* s2 = (seg == 0 ? w.a0 : seg == 1 ? w.kk : seg == 2 ? w.ka : seg == 3 ? w.rk : seg == 4 ? w.lg : w.lb) + h * 64; par[(8 + seg) * 64 + l] = s2[l]; }
}
template <bool WITH_R>
__device__ __forceinline__ unsigned rwkv_front(float* sm, const bf16* P, const RwkvW& w, int tok0, int h, bool ss, bool has_next, int tid, int wave, int lane) {
    float *B0 = sm, *B1 = sm + BUFF, *B2 = sm + 2 * BUFF, *B3 = sm + 3 * BUFF, *B4 = sm + 4 * BUFF, *B5 = sm + 5 * BUFF, *B6 = sm + 6 * BUFF, *B7 = sm + 7 * BUFF;
    float* part = sm + 8 * BUFF; float* bon = part + 512 + 64; const float* par = sm + PAR_OFF;
    unsigned touch = 0u;
    {
        const LsRaw rk = ls_issue(P, tok0, 512 + h * 64, ss, tid), rv = ls_issue(P, tok0, 1024 + h * 64, ss, tid), rxw = ls_issue(P, tok0, 1536, ss, tid), rxa = ls_issue(P, tok0, 1600, ss, tid);
        const WRaw ww = w_issue(w.w2, 512, 0, h * 64, tid), wa = w_issue(w.a2, 512, 0, h * 64, tid);
        if (has_next) { const int blk = tid & 7; const int col = blk == 0 ? 512 + h * 64 : blk == 1 ? 1024 + h * 64 : blk == 2 ? 1536 : blk == 3 ? 1600 : blk == 4 ? h * 64 : blk == 5 ? 1664 : blk == 6 ? 1728 : 1536;
            touch = *(const unsigned*)(P + (size_t)(tok0 + 64 + (tid >> 3)) * PW + col); }
        ls_commit<0>(B0, rk, par + PK, tid); ls_commit<0>(B1, rv, par + PV, tid); ls_commit<1>(B2, rxw, par + PXW, tid); ls_commit<0>(B3, rxa, par + PXA, tid);
        w_commit(B4, ww, tid); w_commit(B5, wa, tid);
    }
    LsRaw rr; if (WITH_R) rr = ls_issue(P, tok0, h * 64, ss, tid);
    __syncthreads();
    SECT(20);
    { f32x4 c0 = {0.f, 0.f, 0.f, 0.f}, c1 = c0; mm_acc<64>(c0, c1, wave, lane, KMin{B2}, KMaj{B4});
      mm_store(c0, c1, wave, lane, [=](int r, int c, float v) { const float wi = v + par[PW0 + c]; const float z = -wi; const float sp = fmaxf(z, 0.f) + __logf(1.f + __expf(-fabsf(z))); B6[r * LD + c] = -__expf(-sp - 0.5f); }); }
    { f32x4 c0 = {0.f, 0.f, 0.f, 0.f}, c1 = c0; mm_acc<64>(c0, c1, wave, lane, KMin{B3}, KMaj{B5});
      mm_store(c0, c1, wave, lane, [=](int r, int c, float v) { B7[r * LD + c] = sigmoidf_(v + par[PA0 + c]); }); }
    __syncthreads();
    SECT(21);
    if (WITH_R) ls_commit<0>(B4, rr, par + PR, tid);
    {
        const int row = tid >> 3, c8 = (tid & 7) * 8;
        float kx[8], kkv[8]; float ssq = 0.f;
#pragma unroll
        for (int e = 0; e < 8; ++e) { kx[e] = B0[row * LD + c8 + e]; kkv[e] = kx[e] * par[PKK + c8 + e]; ssq += kkv[e] * kkv[e]; }
        ssq += __shfl_xor(ssq, 1); ssq += __shfl_xor(ssq, 2); ssq += __shfl_xor(ssq, 4);
        const float inv = 1.f / fmaxf(sqrtf(ssq), 1e-12f);
        float bsum = 0.f;
#pragma unroll
        for (int e = 0; e < 8; ++e) { const float al = B7[row * LD + c8 + e]; const float kn = kkv[e] * inv; const float kad = kx[e] * (1.f + (al - 1.f) * par[PKA + c8 + e]);
            B2[row * LD + c8 + e] = -kn; B3[row * LD + c8 + e] = kn * al; B0[row * LD + c8 + e] = kad;
            if (WITH_R) bsum += B4[row * LD + c8 + e] * kad * par[PRK + c8 + e]; }
        if (WITH_R) { bsum += __shfl_xor(bsum, 1); bsum += __shfl_xor(bsum, 2); bsum += __shfl_xor(bsum, 4); if ((tid & 7) == 0) bon[row] = bsum; }
    }
    {
        const int ch = tid & 63, seg = tid >> 6; float s = 0.f;
#pragma unroll
        for (int i = 0; i < 8; ++i) s += B6[(seg * 8 + i) * LD + ch];
        part[seg * 64 + ch] = s;
    }
    __syncthreads();
    {   const int ch = tid & 63, seg = tid >> 6; float cex = 0.f;
        for (int s = 0; s < seg; ++s) cex += part[s * 64 + ch];
#pragma unroll
        for (int i = 0; i < 8; ++i) { const int t = seg * 8 + i; const float lw = B6[t * LD + ch]; B2[t * LD + ch] *= __expf(cex); cex += lw; B6[t * LD + ch] = cex; }
    }
    __syncthreads();
    return touch;
}

__device__ __forceinline__ void rwkv_phase1(float* sm, const bf16* P, const RwkvW& w, float* GH, int bx, int G) {
    float *B0 = sm, *B1 = sm + BUFF, *B2 = sm + 2 * BUFF, *B3 = sm + 3 * BUFF, *B4 = sm + 4 * BUFF, *B5 = sm + 5 * BUFF, *B6 = sm + 6 * BUFF, *B7 = sm + 7 * BUFF;
    float* gl = sm + 8 * BUFF + 512;
    int hprev = -1;
    for (int unit = (4096 * bx) / G, uend = (4096 * (bx + 1)) / G; unit < uend; ++unit) {
        TIDS;
        const int bh = unit >> 8, c = unit & 255, b = bh >> 3, h = bh & 7, tok0 = b * SEQL + c * 64;
        if (h != hprev) { __syncthreads(); stage_params(sm + PAR_OFF, w, h, tid); hprev = h; }
        __syncthreads();
        SECT(10);
        const unsigned touch = rwkv_front<false>(sm, P, w, tok0, h, c == 0, (c != 255) && (unit + 1 < uend), tid, wave, lane);
        SECT(11);
        for (int idx = tid; idx < 4096; idx += NTHR) { const int t = idx >> 6, ch = idx & 63; const float cu = B6[t * LD + ch], cl = B6[63 * LD + ch];
            const float em = __expf(-cu), eh = __expf(cl - cu), bv = B3[t * LD + ch], kv = B0[t * LD + ch];
            B4[t * LD + ch] = bv * em; B5[t * LD + ch] = kv * em; B3[t * LD + ch] = bv * eh; B0[t * LD + ch] = kv * eh; }
        if (tid < 64) gl[tid] = __expf(B6[63 * LD + tid]);
        __syncthreads();
        { f32x4 c0 = {0.f, 0.f, 0.f, 0.f}, c1 = c0; mm_acc<64>(c0, c1, wave, lane, KMin{B2}, KMin{B4}); mm_store(c0, c1, wave, lane, [=](int r, int cc, float v) { B7[r * LD + cc] = (cc < r) ? v : 0.f; }); }
        { f32x4 c0 = {0.f, 0.f, 0.f, 0.f}, c1 = c0; mm_acc<64>(c0, c1, wave, lane, KMin{B2}, KMin{B5}); mm_store(c0, c1, wave, lane, [=](int r, int cc, float v) { B6[r * LD + cc] = (cc < r) ? v : 0.f; }); }
        __syncthreads();
        { f32x4 c0 = {0.f, 0.f, 0.f, 0.f}, c1 = c0; mm_acc_t<64, true>(c0, c1, wave, lane, KMin{B6}, KMaj{B1}); mm_store(c0, c1, wave, lane, [=](int r, int cc, float v) { B4[r * LD + cc] = v; }); }
        SECT(12);
        tri_inverse(B5, B7, B6, tid, wave, lane);
        SECT(13);
        { f32x4 c0 = {0.f, 0.f, 0.f, 0.f}, c1 = c0; mm_acc_t<64, true>(c0, c1, wave, lane, KMin{B5}, KMaj{B2}); mm_store(c0, c1, wave, lane, [=](int r, int cc, float v) { B6[r * LD + cc] = v; }); }
        { f32x4 c0 = {0.f, 0.f, 0.f, 0.f}, c1 = c0; mm_acc_t<64, true>(c0, c1, wave, lane, KMin{B5}, KMaj{B4}); mm_store(c0, c1, wave, lane, [=](int r, int cc, float v) { B7[r * LD + cc] = v; }); }
        __syncthreads();
        float* Gg = GH + (size_t)unit * 8192; float* Hg = Gg + 4096;
        { f32x4 c0 = {0.f, 0.f, 0.f, 0.f}, c1 = c0; mm_acc<64>(c0, c1, wave, lane, KMaj{B6}, KMaj{B3}); mm_store(c0, c1, wave, lane, [=](int r, int cc, float v) { Gg[r * 64 + cc] = v + ((r == cc) ? gl[r] : 0.f); }); }
        { f32x4 c0 = {0.f, 0.f, 0.f, 0.f}, c1 = c0; mm_acc<64>(c0, c1, wave, lane, KMaj{B7}, KMaj{B3}); mm_acc<64>(c0, c1, wave, lane, KMaj{B1}, KMaj{B0}); mm_store(c0, c1, wave, lane, [=](int r, int cc, float v) { Hg[r * 64 + cc] = v; }); }
        SECT(14);
        asm volatile("" :: "v"(touch));
    }
}

__device__ __forceinline__ void rwkv_phase2(float* sm, float* GH, int wg) {
    TIDS;
    const int bh = wg >> 2, rb = wg & 3;
    float* Ss = sm; float* Gs = sm + 16 * LD; float* Hs = Gs + 64 * LD;
    for (int i = tid; i < 16 * LD; i += NTHR) Ss[i] = 0.f;
    float* base = GH + (size_t)(bh * 256) * 8192;
    const int grow = tid >> 3, gc8 = (tid & 7) * 8, hrow = tid >> 5, hc2 = (tid & 31) * 2;
    const size_t goff = (size_t)grow * 64 + gc8, hoff = 4096 + (size_t)(rb * 16 + hrow) * 64 + hc2;
    f32x4 ga[4], gb[4]; f32x2 hv[4];
#pragma unroll
    for (int i = 0; i < 4; ++i) { const float* u = base + (size_t)i * 8192; ga[i] = *(const f32x4*)(u + goff); gb[i] = *(const f32x4*)(u + goff + 4); hv[i] = *(const f32x2*)(u + hoff); }
    const int li = lane & 15, lk = lane >> 4;
    for (int c4 = 0; c4 < 256; c4 += 4) {
#pragma unroll
        for (int i = 0; i < 4; ++i) {
            const int c = c4 + i;
            *(f32x4*)(Gs + grow * LD + gc8) = ga[i]; *(f32x4*)(Gs + grow * LD + gc8 + 4) = gb[i]; *(f32x2*)(Hs + hrow * LD + hc2) = hv[i];
            __syncthreads();
            float* u = base + (size_t)c * 8192;
            if (c + 4 < 256) { const float* un = u + (size_t)4 * 8192; ga[i] = *(const f32x4*)(un + goff); gb[i] = *(const f32x4*)(un + goff + 4); hv[i] = *(const f32x2*)(un + hoff); }
            *(f32x2*)(u + hoff) = *(const f32x2*)(Ss + hrow * LD + hc2);
            f32x4 acc = {0.f, 0.f, 0.f, 0.f};
            if (wave < 4) {
#pragma unroll
                for (int r = 0; r < 4; ++r) acc[r] = Hs[(4 * lk + r) * LD + 16 * wave + li];
#pragma unroll 4
                for (int k0 = 0; k0 < 64; k0 += 4) acc = __builtin_amdgcn_mfma_f32_16x16x4f32(Ss[li * LD + k0 + lk], Gs[(k0 + lk) * LD + 16 * wave + li], acc, 0, 0, 0);
            }
            __syncthreads();
            if (wave < 4) {
#pragma unroll
                for (int r = 0; r < 4; ++r) Ss[(4 * lk + r) * LD + 16 * wave + li] = acc[r];
            }
        }
    }
    __syncthreads();
}

__device__ __forceinline__ void rwkv_phase3(float* sm, const bf16* P, const RwkvW& w, const float* GH, bf16* CAT, int bx, int G) {
    float *B0 = sm, *B1 = sm + BUFF, *B2 = sm + 2 * BUFF, *B3 = sm + 3 * BUFF, *B4 = sm + 4 * BUFF, *B5 = sm + 5 * BUFF, *B6 = sm + 6 * BUFF, *B7 = sm + 7 * BUFF;
    float* bon = sm + 8 * BUFF + 512 + 64;
    int hprev = -1;
    for (int unit = (4096 * bx) / G, uend = (4096 * (bx + 1)) / G; unit < uend; ++unit) {
        TIDS;
        const int bh = unit >> 8, c = unit & 255, b = bh >> 3, h = bh & 7, tok0 = b * SEQL + c * 64; const bool ss = (c == 0);
        if (h != hprev) { __syncthreads(); stage_params(sm + PAR_OFF, w, h, tid); hprev = h; }
        __syncthreads();
        SECT(0);
        const unsigned touch = rwkv_front<true>(sm, P, w, tok0, h, ss, (c != 255) && (unit + 1 < uend), tid, wave, lane);
        SECT(1);
        const WRaw s0raw = w_issue(GH + (size_t)unit * 8192 + 4096, 64, 0, 0, tid);
        const LsRaw xg0 = ls_issue(P, tok0, 1664, ss, tid), xg1 = ls_issue(P, tok0, 1728, ss, tid);
        const WRaw g2a = w_issue(w.g2, 512, 0, h * 64, tid), g2b = w_issue(w.g2, 512, 64, h * 64, tid);
        for (int idx = tid; idx < 4096; idx += NTHR) { const int t = idx >> 6, ch = idx & 63; const float cu = B6[t * LD + ch]; const float em = __expf(-cu);
            B5[t * LD + ch] = B3[t * LD + ch] * em; B0[t * LD + ch] *= em; B4[t * LD + ch] *= __expf(cu); }
        __syncthreads();
        { f32x4 c0 = {0.f, 0.f, 0.f, 0.f}, c1 = c0; mm_acc<64>(c0, c1, wave, lane, KMin{B2}, KMin{B5}); mm_store(c0, c1, wave, lane, [=](int r, int cc, float v) { B3[r * LD + cc] = (cc < r) ? v : 0.f; }); }
        { f32x4 c0 = {0.f, 0.f, 0.f, 0.f}, c1 = c0; mm_acc<64>(c0, c1, wave, lane, KMin{B2}, KMin{B0}); mm_store(c0, c1, wave, lane, [=](int r, int cc, float v) { B6[r * LD + cc] = (cc < r) ? v : 0.f; }); }
        { f32x4 c0 = {0.f, 0.f, 0.f, 0.f}, c1 = c0; mm_acc<64>(c0, c1, wave, lane, KMin{B4}, KMin{B5}); mm_store(c0, c1, wave, lane, [=](int r, int cc, float v) { B7[r * LD + cc] = (cc <= r) ? v : 0.f; }); }
        __syncthreads();
        { f32x4 c0 = {0.f, 0.f, 0.f, 0.f}, c1 = c0; mm_acc<64>(c0, c1, wave, lane, KMin{B4}, KMin{B0}); mm_store(c0, c1, wave, lane, [=](int r, int cc, float v) { B5[r * LD + cc] = (cc <= r) ? v : 0.f; }); }
        __syncthreads();
        SECT(2);
        w_commit(B0, s0raw, tid);
        __syncthreads();
        { f32x4 c0 = {0.f, 0.f, 0.f, 0.f}, c1 = c0; mm_acc<64>(c0, c1, wave, lane, KMin{B2}, KMin{B0}); mm_acc_t<64, true>(c0, c1, wave, lane, KMin{B6}, KMaj{B1}); __syncthreads();
          mm_store(c0, c1, wave, lane, [=](int r, int cc, float v) { B2[r * LD + cc] = v; }); }
        __syncthreads();
        SECT(3);
        f32x4 y0 = {0.f, 0.f, 0.f, 0.f}, y1 = y0;
        mm_acc<64>(y0, y1, wave, lane, KMin{B4}, KMin{B0}); mm_acc_t<64, true>(y0, y1, wave, lane, KMin{B5}, KMaj{B1});
        SECT(4);
        tri_inverse(B6, B3, B0, tid, wave, lane);
        SECT(5);
        { f32x4 c0 = {0.f, 0.f, 0.f, 0.f}, c1 = c0; mm_acc_t<64, true>(c0, c1, wave, lane, KMin{B6}, KMaj{B2}); mm_store(c0, c1, wave, lane, [=](int r, int cc, float v) { B4[r * LD + cc] = v; }); }
        __syncthreads();
        mm_acc_t<64, true>(y0, y1, wave, lane, KMin{B7}, KMaj{B4});
        ls_commit<2>(B3, xg0, sm + PAR_OFF + PXG, tid); ls_commit<2>(B5, xg1, sm + PAR_OFF + PXG + 64, tid); w_commit(B0, g2a, tid); w_commit(B2, g2b, tid);
        mm_store(y0, y1, wave, lane, [=](int r, int cc, float v) { B6[r * LD + cc] = v; });
        __syncthreads();
        { f32x4 c0 = {0.f, 0.f, 0.f, 0.f}, c1 = c0; mm_acc<64>(c0, c1, wave, lane, KMin{B3}, KMaj{B0}); mm_acc<64>(c0, c1, wave, lane, KMin{B5}, KMaj{B2});
        SECT(6);
          mm_store(c0, c1, wave, lane, [=](int r, int cc, float v) { B4[r * LD + cc] = v; }); }
        __syncthreads();
        {   const int row = tid >> 3, c8 = (tid & 7) * 8; float y[8], s = 0.f;
#pragma unroll
            for (int e = 0; e < 8; ++e) { y[e] = B6[row * LD + c8 + e]; s += y[e]; }
            s += __shfl_xor(s, 1); s += __shfl_xor(s, 2); s += __shfl_xor(s, 4);
            const float mu = s * (1.f / 64.f); float q = 0.f;
#pragma unroll
            for (int e = 0; e < 8; ++e) { y[e] -= mu; q += y[e] * y[e]; }
            q += __shfl_xor(q, 1); q += __shfl_xor(q, 2); q += __shfl_xor(q, 4);
            const float rs = 1.f / sqrtf(q * (1.f / 64.f) + 64e-5f); const float bn = bon[row];
            float o[8];
#pragma unroll
            for (int e = 0; e < 8; ++e) { const float yn = y[e] * rs * sm[PAR_OFF + PLG + c8 + e] + sm[PAR_OFF + PLB + c8 + e]; o[e] = (yn + bn * B1[row * LD + c8 + e]) * B4[row * LD + c8 + e]; }
            *(v4u*)(CAT + (size_t)(tok0 + row) * 1024 + h * 64 + c8) = pack8(o);
        }
        SECT(7);
        asm volatile("" :: "v"(touch));
    }
}

__device__ __forceinline__ void phase_rope(bf16* P, int bx, int G) {
    TIDS;
    constexpr float INVF[8] = {1.0f, 0.1939227432012558f, 0.03760603070259094f, 0.007292664609849453f, 0.0014142135623842478f, 0.00027424818836152554f, 5.318296098266728e-05f, 1.0313386155758053e-05f};
    for (int it = bx * NTHR + tid; it < NTOK * 16; it += G * NTHR) {
        const int tok = it >> 4, hh = it & 15, s = tok & (SEQL - 1);
        bf16* p = P + (size_t)tok * PW + 1792 + hh * 64;
        float x1[8], x2[8]; unpack8(*(const v4u*)p, x1); unpack8(*(const v4u*)(p + 8), x2);
        const float sc = (hh < 8) ? attn_body::C2 : 1.f;
        float o1[8], o2[8];
#pragma unroll
        for (int d = 0; d < 8; ++d) { const float ang = (float)s * INVF[d]; double rev = (double)ang * 0.15915494309189535; rev -= rint(rev); const float fr = (float)rev;
            const float sn = __builtin_amdgcn_sinf(fr), cs = __builtin_amdgcn_cosf(fr);
            o1[d] = (x1[d] * cs - x2[d] * sn) * sc; o2[d] = (x1[d] * sn + x2[d] * cs) * sc; }
        *(v4u*)p = pack8(o1); *(v4u*)(p + 8) = pack8(o2);
        if (hh < 8) {
#pragma unroll
            for (int q = 2; q < 8; ++q) { float x[8]; unpack8(*(const v4u*)(p + 8 * q), x);
#pragma unroll
                for (int e = 0; e < 8; ++e) x[e] *= sc;
                *(v4u*)(p + 8 * q) = pack8(x); }
        }
    }
}

__device__ __forceinline__ void phase_attn_post(const bf16* OB, bf16* CAT, const float* q1, const float* k1, const float* q2, const float* k2, const float* sg, float lam_init, int bx, int G) {
    TIDS; const int gw = bx * 8 + wave, NGW = G * 8;
    const float d1 = wave_sum(q1[lane] * k1[lane]), d2 = wave_sum(q2[lane] * k2[lane]);
    const float lam = expf(d1) - expf(d2) + lam_init;
    const int h = lane >> 4, d0 = (lane & 15) * 8, vhalf = d0 >> 6, dd = d0 & 63;
    float g[8];
#pragma unroll
    for (int e = 0; e < 8; ++e) g[e] = sg[d0 + e] * (1.f - lam_init);
    for (int tok = gw; tok < NTOK; tok += NGW) {
        const bf16* r = OB + (size_t)tok * 1024;
        float a[8], b[8]; unpack8(*(const v4u*)(r + ((h * 2 + 0) * 2 + vhalf) * 64 + dd), a); unpack8(*(const v4u*)(r + ((h * 2 + 1) * 2 + vhalf) * 64 + dd), b);
        float o[8], q = 0.f;
#pragma unroll
        for (int e = 0; e < 8; ++e) { o[e] = a[e] - lam * b[e]; q += o[e] * o[e]; }
        q += __shfl_xor(q, 1); q += __shfl_xor(q, 2); q += __shfl_xor(q, 4); q += __shfl_xor(q, 8);
        const float rs = 1.f / sqrtf(q * (1.f / 128.f) + 1e-5f);
#pragma unroll
        for (int e = 0; e < 8; ++e) o[e] = o[e] * rs * g[e];
        *(v4u*)(CAT + (size_t)tok * 1024 + 512 + h * 128 + d0) = pack8(o);
    }
}

__device__ __forceinline__ void phase_ln(float* X, bf16* XN, const float* g, const float* b, int bx, int G) {
    TIDS; const int gw = bx * 8 + wave, NGW = G * 8;
    for (int m = gw; m < NTOK; m += NGW) {
        f32x4* xr = (f32x4*)(X + (size_t)m * 1024) + lane;
        f32x4 v[4]; float s = 0.f;
#pragma unroll
        for (int j = 0; j < 4; ++j) { v[j] = xr[64 * j]; s += (v[j][0] + v[j][1]) + (v[j][2] + v[j][3]); }
        const float mean = wave_sum(s) * (1.f / 1024.f); float s2 = 0.f;
#pragma unroll
        for (int j = 0; j < 4; ++j) { v[j] = v[j] - mean; s2 += (v[j][0] * v[j][0] + v[j][1] * v[j][1]) + (v[j][2] * v[j][2] + v[j][3] * v[j][3]); }
        const float rstd = 1.f / sqrtf(wave_sum(s2) * (1.f / 1024.f) + 1e-5f);
        v2u* o8 = (v2u*)(XN + (size_t)m * 1024) + lane;
#pragma unroll
        for (int j = 0; j < 4; ++j) { const f32x4 gg = *(const f32x4*)(g + 4 * lane + 256 * j), bb = *(const f32x4*)(b + 4 * lane + 256 * j);
            const f32x4 o = v[j] * rstd * gg + bb; xr[64 * j] = o; v2u w; w.x = pk2(o[0], o[1]); w.y = pk2(o[2], o[3]); o8[64 * j] = w; }
    }
}
__device__ __forceinline__ void phase_lnv(bf16* V, const float* g, const float* b, int bx, int G) {
    TIDS; const int gw = bx * 8 + wave, NGW = G * 8;
    for (int m = gw; m < NTOK; m += NGW) {
        bf16* r = V + (size_t)m * 1024;
        float x[16]; unpack8(*(const v4u*)(r + lane * 8), x); unpack8(*(const v4u*)(r + 512 + lane * 8), x + 8);
        float s = 0.f;
#pragma unroll
        for (int e = 0; e < 16; ++e) s += x[e];
        const float mean = wave_sum(s) * (1.f / 1024.f); float s2 = 0.f;
#pragma unroll
        for (int e = 0; e < 16; ++e) { x[e] -= mean; s2 += x[e] * x[e]; }
        const float rstd = 1.f / sqrtf(wave_sum(s2) * (1.f / 1024.f) + 1e-5f);
#pragma unroll
        for (int e = 0; e < 16; ++e) { const int col = (e < 8) ? lane * 8 + e : 512 + lane * 8 + (e - 8); x[e] = x[e] * rstd * g[col] + b[col]; }
        *(v4u*)(r + lane * 8) = pack8(x); *(v4u*)(r + 512 + lane * 8) = pack8(x + 8);
    }
}

__device__ __forceinline__ void phase_conv(const bf16* GATE, bf16* VAL, const float* cw, const float* cb, int bx, int G) {
    TIDS;
    constexpr int NCG = DFF / 8, NIT = (NTOK / 64) * 2 * NCG;
    for (int it = bx * NTHR + tid; it < NIT; it += G * NTHR) {
        const int rr = it / NCG, c0 = (it % NCG) * 8, t = (rr >> 1) * 64 + (rr & 1), s = t & (SEQL - 1);
        float gg[8], g1[8], g2[8], vv[8], o[8];
        const size_t off = (size_t)t * DFF + c0;
        unpack8(*(const v4u*)(GATE + off), gg); unpack8(*(const v4u*)(VAL + off), vv);
        if (s >= 1) unpack8(*(const v4u*)(GATE + off - DFF), g1); else {
#pragma unroll
            for (int e = 0; e < 8; ++e) g1[e] = 0.f; }
        if (s >= 2) unpack8(*(const v4u*)(GATE + off - 2 * DFF), g2); else {
#pragma unroll
            for (int e = 0; e < 8; ++e) g2[e] = 0.f; }
#pragma unroll
        for (int e = 0; e < 8; ++e) { const float cv = cb[c0 + e] + cw[c0 + e] * g2[e] + cw[DFF + c0 + e] * g1[e] + cw[2 * DFF + c0 + e] * gg[e]; o[e] = cv * sigmoidf_(cv) * vv[e]; }
        *(v4u*)(VAL + off) = pack8(o);
    }
}

__device__ __forceinline__ void phase_mix(unsigned char* ldsb, bf16* U, const bf16* V, const bf16* WSP, const float* bs, int bx, int G) {
    TIDS;
    bf16* Vt = (bf16*)ldsb;
    for (int unit = bx; unit < 2048; unit += G) {
        const int cidx = unit >> 3, g = unit & 7, tok0 = cidx * 128;
        __syncthreads();
        {   const int s = tid >> 2, q = tid & 3;
#pragma unroll
            for (int i = 0; i < 4; ++i) { const v4u w = *(const v4u*)(V + (size_t)(tok0 + s) * 1024 + g * 128 + q * 32 + i * 8); const int d0 = q * 32 + i * 8;
                Vt[(d0 + 0) * 136 + s] = (bf16)(w.x & 0xffffu); Vt[(d0 + 1) * 136 + s] = (bf16)(w.x >> 16); Vt[(d0 + 2) * 136 + s] = (bf16)(w.y & 0xffffu); Vt[(d0 + 3) * 136 + s] = (bf16)(w.y >> 16);
                Vt[(d0 + 4) * 136 + s] = (bf16)(w.z & 0xffffu); Vt[(d0 + 5) * 136 + s] = (bf16)(w.z >> 16); Vt[(d0 + 6) * 136 + s] = (bf16)(w.w & 0xffffu); Vt[(d0 + 7) * 136 + s] = (bf16)(w.w >> 16); }
        }
        __syncthreads();
        f32x4 acc[8];
#pragma unroll
        for (int tn = 0; tn < 8; ++tn) acc[tn] = (f32x4){0.f, 0.f, 0.f, 0.f};
        const int li = lane & 15, lk = lane >> 4, nks = (16 * wave + 15) / 32 + 1;
        for (int ks = 0; ks < nks; ++ks) {
            const bf16x8 a = *(const bf16x8*)(WSP + (size_t)g * 16384 + (16 * wave + li) * 128 + ks * 32 + lk * 8);
#pragma unroll
            for (int tn = 0; tn < 8; ++tn) { const bf16x8 bq = *(const bf16x8*)(Vt + (16 * tn + li) * 136 + ks * 32 + lk * 8); acc[tn] = __builtin_amdgcn_mfma_f32_16x16x32_bf16(a, bq, acc[tn], 0, 0, 0); }
        }
#pragma unroll
        for (int r = 0; r < 4; ++r) { const int t = 16 * wave + 4 * lk + r; const float bias = bs[g * 128 + t];
#pragma unroll
            for (int tn = 0; tn < 8; ++tn) { bf16* up = U + (size_t)(tok0 + t) * 1024 + g * 128 + 16 * tn + li; const float u = __uint_as_float(((unsigned)*up) << 16); *up = (bf16)f2bf(u * (acc[tn][r] + bias)); } }
    }
}

#ifndef PHASE_SEL
#define PHASE_SEL 0xffffffffu
#endif
#define ON(k) (((PHASE_SEL) >> (k)) & 1u)
struct Args { const float* in[34]; float* out; unsigned char* ws; };

__global__ void __launch_bounds__(NTHR, 2) mega_fwd(Args a) {
    extern __shared__ __attribute__((aligned(16))) unsigned char lds[];
    cg::grid_group grid = cg::this_grid();
    const int G = gridDim.x, bx = blockIdx.x;
    unsigned* barw = (unsigned*)(a.ws + WS_CTL);
    volatile LAS unsigned* bst = (volatile LAS unsigned*)((LAS unsigned char*)lds + (LDS_TOTAL - 16));
    if (threadIdx.x < 2) bst[threadIdx.x] = 0u;
#if defined(SEC_B)
    if (threadIdx.x == 0) { volatile unsigned long long* pa_ = (volatile unsigned long long*)((char*)lds + (LDS_TOTAL - 48)); pa_[0] = 0ull; pa_[1] = 0ull; }
#endif
    if (bx == 0) for (int i = threadIdx.x; i < XCD_BAR_WORDS; i += NTHR) barw[i] = 0u;
    __threadfence();
    grid.sync();
    const XcdBarrier xbar = xcd_barrier_post(barw, bst);
#ifdef PROBE_MASK
    unsigned long long tacc = 0, tmark = 0;
#define PB(k) do { if ((PROBE_MASK >> (k)) & 1u) tmark = __builtin_amdgcn_s_memrealtime(); } while (0)
#define PE(k) do { if ((PROBE_MASK >> (k)) & 1u) tacc += __builtin_amdgcn_s_memrealtime() - tmark; } while (0)
#else
#define PB(k) do {} while (0)
#define PE(k) do {} while (0)
#endif
    for (int layer = 0; layer < 4; ++layer) {
        const int j = layer >> 1; const bool even = (layer & 1) == 0;
        int z = 0; asm volatile("" : "+s"(z));
        unsigned char* ws = a.ws + z; float* out = a.out + z;
        LAS unsigned char* ldsl = (LAS unsigned char*)lds;
        float* sm = (float*)lds;

        PB(0);
        if (ON(0)) {
            TIDS; const int gw = bx * 8 + wave, NGW = G * 8;
            LAS float* scr = (LAS float*)(ldsl + wave * 16384);
            const float* wi = even ? a.in[1 + z] + (size_t)j * 1024 * 3328 : a.in[19 + z] + (size_t)j * 1024 * 2048;
            const int Nin = even ? 3328 : 2048;
            const float* wo = even ? a.in[18 + z] + (size_t)j * 1024 * 1024 : a.in[25 + z] + (size_t)j * 1024 * 1024;
            const float* wu = a.in[28 + z] + (size_t)layer * 1024 * 5632;
            const float* wd = a.in[31 + z] + (size_t)layer * 2816 * 1024;
            const int I_in = 16 * (Nin / 32), I_out = 16 * 32, I_up = 16 * 176, I_dn = 44 * 32, NIT = I_in + I_out + I_up + I_dn;
            for (int it = gw; it < NIT; it += NGW) {
                int r = it;
                if (r < I_in) { transpose_item(wi, 1024, Nin, ((bf16*)(ws + WS_WIN)), scr, r, lane); continue; } r -= I_in;
                if (r < I_out) { transpose_item(wo, 1024, 1024, ((bf16*)(ws + WS_WOUT)), scr, r, lane); continue; } r -= I_out;
                if (r < I_up) { transpose_item<true>(wu, 1024, 5632, ((bf16*)(ws + WS_WUP)), scr, r, lane); continue; } r -= I_up;
                transpose_item(wd, 2816, 1024, ((bf16*)(ws + WS_WDN)), scr, r, lane);
            }
            if (!even) { const float* wsrc = a.in[23 + z] + (size_t)j * 8 * 128 * 128;
                for (int i = bx * NTHR + tid; i < 8 * 128 * 128; i += G * NTHR) { const int t = (i >> 7) & 127, s = i & 127; ((bf16*)(ws + WS_WSP))[i] = (bf16)f2bf(s <= t ? wsrc[i] : 0.f); } }
            if (layer == 0) { const f32x4* xs = (const f32x4*)a.in[0 + z]; f32x4* xo = (f32x4*)out; v2u* xn = (v2u*)((bf16*)(ws + WS_XN));
                for (int i = bx * NTHR + tid; i < NTOK * 1024 / 4; i += G * NTHR) { const f32x4 v = xs[i]; xo[i] = v; v2u w; w.x = pk2(v[0], v[1]); w.y = pk2(v[2], v[3]); xn[i] = w; } }
        }
        xcd_barrier(xbar);
        PE(0);
        if (even) {
            PB(1);
            if (ON(1)) {   pg8::Gemm g{((bf16*)(ws + WS_XN)), ((bf16*)(ws + WS_WIN)), NTOK, 3328, 1024}; pg8::StaticOrder S; S.init(NTOK, 3328, G, bx);
                pg8::EpiBf16<0> E{((bf16*)(ws + WS_P)), 3328, nullptr, 0, 0, 1.f};
                pg8::gemm_phase<pg8::EpiBf16<0>, pg8::StaticOrder, PG8_ALIGN, PG8_SP2>(ldsl, g, S, E); }
            xcd_barrier(xbar);
            PE(1);
            PB(2);
            if (ON(2)) { RwkvW rw{a.in[2 + z] + j * 1792, a.in[3 + z] + j * 512, a.in[4 + z] + (size_t)j * 64 * 512, a.in[5 + z] + j * 512, a.in[6 + z] + (size_t)j * 64 * 512, a.in[7 + z] + (size_t)j * 128 * 512,
                     a.in[8 + z] + j * 512, a.in[9 + z] + j * 512, a.in[10 + z] + j * 512, a.in[11 + z] + j * 512, a.in[12 + z] + j * 512}; rwkv_phase1(sm, ((bf16*)(ws + WS_P)), rw, ((float*)(ws + WS_GH)), bx, G); }
            PB(3);
            if (ON(3)) phase_rope(((bf16*)(ws + WS_P)), bx, G);
            xcd_barrier(xbar);
            PE(2);
            PE(3);
            PB(4);
            if (ON(4)) if (bx < 64) rwkv_phase2(sm, ((float*)(ws + WS_GH)), bx);
            xcd_barrier(xbar);
            PE(4);
            PB(5);
            if (ON(5)) {
                __syncthreads();
                const int nun = (G == 256) ? 8 : (2048 - bx + G - 1) / G;
                for (int i = 0; i < nun; ++i) {
                    int bhv, qb;
                    if (G == 256) { const int vcu = (bx % 8) * (G / 8) + bx / 8, s = vcu & 7, grp = i >> 1; bhv = vcu >> 3; qb = (i & 1) ? (16 * grp + 15 - s) : (16 * grp + s); }
                    else { const int u = bx + i * G; bhv = u & 31; qb = 63 - (u >> 5); }
                    const int b = bhv >> 4, vh = bhv & 15, hd = vh >> 2, cm = (vh >> 1) & 1, vhalf = vh & 1;
                    const attn_body::bf16* Q = (const attn_body::bf16*)(((bf16*)(ws + WS_P)) + 1792 + (hd * 2 + cm) * 64); const attn_body::bf16* K = (const attn_body::bf16*)(((bf16*)(ws + WS_P)) + 2304 + (hd * 2 + cm) * 64);
                    const attn_body::bf16* Vv = (const attn_body::bf16*)(((bf16*)(ws + WS_P)) + 2816 + hd * 128 + vhalf * 64); attn_body::bf16* O = (attn_body::bf16*)(((bf16*)(ws + WS_XN)) + vh * 64);
                    attn_body::attn_unit<8>(b, 0, qb, Q, K, Vv, O, (char*)lds);
                }
            }
            xcd_barrier(xbar);
            PE(5);
            PB(6);
            if (ON(6)) { RwkvW rw{a.in[2 + z] + j * 1792, a.in[3 + z] + j * 512, a.in[4 + z] + (size_t)j * 64 * 512, a.in[5 + z] + j * 512, a.in[6 + z] + (size_t)j * 64 * 512, a.in[7 + z] + (size_t)j * 128 * 512,
                     a.in[8 + z] + j * 512, a.in[9 + z] + j * 512, a.in[10 + z] + j * 512, a.in[11 + z] + j * 512, a.in[12 + z] + j * 512}; rwkv_phase3(sm, ((bf16*)(ws + WS_P)), rw, ((float*)(ws + WS_GH)), ((bf16*)(ws + WS_CAT)), bx, G); }
            PB(7);
            if (ON(7)) phase_attn_post(((bf16*)(ws + WS_XN)), ((bf16*)(ws + WS_CAT)), a.in[13 + z] + j * 64, a.in[14 + z] + j * 64, a.in[15 + z] + j * 64, a.in[16 + z] + j * 64, a.in[17 + z] + j * 128, layer == 0 ? 0.2f : 0.4707130183435842f, bx, G);
            xcd_barrier(xbar);
            PE(6);
            PE(7);
            PB(8);
            if (ON(8)) {   pg8::Gemm g{((bf16*)(ws + WS_CAT)), ((bf16*)(ws + WS_WOUT)), NTOK, 1024, 1024}; pg8::StaticOrder S; S.init(NTOK, 1024, G, bx);
                pg8::EpiResid E{out, 1024, ALPHA};
                pg8::gemm_phase<pg8::EpiResid, pg8::StaticOrder, PG8_ALIGN, PG8_SP2>(ldsl, g, S, E); }
        } else {
            PB(9);
            if (ON(9)) {   pg8::Gemm g{((bf16*)(ws + WS_XN)), ((bf16*)(ws + WS_WIN)), NTOK, 2048, 1024}; pg8::StaticOrder S; S.init(NTOK, 2048, G, bx);
                pg8::EpiBf16<1> E{((bf16*)(ws + WS_U)), 1024, a.in[20 + z] + j * 2048, 1024, (size_t)(WS_V - WS_U) / 2, 1.f};
                pg8::gemm_phase<pg8::EpiBf16<1>, pg8::StaticOrder, PG8_ALIGN, PG8_SP2>(ldsl, g, S, E); }
            xcd_barrier(xbar);
            PE(9);
            PB(10);
            if (ON(10)) phase_lnv(((bf16*)(ws + WS_V)), a.in[21 + z] + j * 1024, a.in[22 + z] + j * 1024, bx, G);
            xcd_barrier(xbar);
            PE(10);
            PB(11);
            if (ON(11)) phase_mix(lds, ((bf16*)(ws + WS_U)), ((bf16*)(ws + WS_V)), ((bf16*)(ws + WS_WSP)), a.in[24 + z] + j * 1024, bx, G);
            xcd_barrier(xbar);
            PE(11);
            PB(12);
            if (ON(12)) {   pg8::Gemm g{((bf16*)(ws + WS_U)), ((bf16*)(ws + WS_WOUT)), NTOK, 1024, 1024}; pg8::StaticOrder S; S.init(NTOK, 1024, G, bx);
                pg8::EpiResid E{out, 1024, ALPHA};
                pg8::gemm_phase<pg8::EpiResid, pg8::StaticOrder, PG8_ALIGN, PG8_SP2>(ldsl, g, S, E); }
        }
        xcd_barrier(xbar);
        if (even) PE(8); else PE(12);
        PB(13);
        if (ON(13)) phase_ln(out, ((bf16*)(ws + WS_XN)), a.in[26 + z] + layer * 1024, a.in[27 + z] + layer * 1024, bx, G);
        xcd_barrier(xbar);
        PE(13);
        PB(14);
        if (ON(14)) {   pg8::Gemm g{((bf16*)(ws + WS_XN)), ((bf16*)(ws + WS_WUP)), NTOK, 5632, 1024}; pg8::StaticOrder S; S.init(NTOK, 5632, G, bx);
            pg8::EpiConv E{((bf16*)(ws + WS_VAL)), ((bf16*)(ws + WS_GATE)), a.in[29 + z] + (size_t)layer * 3 * DFF, a.in[30 + z] + layer * DFF, DFF};
            pg8::gemm_phase<pg8::EpiConv, pg8::StaticOrder, PG8_ALIGN, PG8_SP2>(ldsl, g, S, E); }
        xcd_barrier(xbar);
        PE(14);
        PB(15);
        if (ON(15)) phase_conv(((bf16*)(ws + WS_GATE)), ((bf16*)(ws + WS_VAL)), a.in[29 + z] + (size_t)layer * 3 * DFF, a.in[30 + z] + layer * DFF, bx, G);
        xcd_barrier(xbar);
        PE(15);
        PB(16);
        if (ON(16)) {   pg8::Gemm g{((bf16*)(ws + WS_VAL)), ((bf16*)(ws + WS_WDN)), NTOK, 1024, 2816}; pg8::StaticOrder S; S.init(NTOK, 1024, G, bx);
            pg8::EpiResid E{out, 1024, ALPHA};
            pg8::gemm_phase<pg8::EpiResid, pg8::StaticOrder, PG8_ALIGN, PG8_SP2>(ldsl, g, S, E); }
        xcd_barrier(xbar);
        PE(16);
        PB(17);
#ifdef EXTRA_SYNCS
        for (int es = 0; es < EXTRA_SYNCS; ++es) xcd_barrier(xbar);
#endif
        if (ON(17)) phase_ln(out, ((bf16*)(ws + WS_XN)), a.in[32 + z] + layer * 1024, a.in[33 + z] + layer * 1024, bx, G);
        xcd_barrier(xbar);
        PE(17);
    }
#if defined(SEC_B)
    if (bx == 0 && threadIdx.x == 0) { const unsigned long long tacc2 = ((volatile unsigned long long*)((char*)lds + (LDS_TOTAL - 48)))[0]; const unsigned long long t0 = __builtin_amdgcn_s_memrealtime(); while (__builtin_amdgcn_s_memrealtime() - t0 < 4ull * tacc2) __builtin_amdgcn_s_sleep(8); }
#endif
#ifdef PROBE_MASK
    if (bx == 0 && threadIdx.x == 0) { const unsigned long long t0 = __builtin_amdgcn_s_memrealtime(); while (__builtin_amdgcn_s_memrealtime() - t0 < 4ull * tacc) __builtin_amdgcn_s_sleep(8); }
#endif
}

extern "C" void kernel_launch(void* const* d_in, const int* in_sizes, int n_in, void* d_out, int out_size, void* d_ws, size_t ws_size, hipStream_t stream) {
    static int grid = 0;
    if (grid == 0) {
        if (n_in != 34 || out_size != NTOK * 1024 || ws_size < WS_END) { fprintf(stderr, "kernel_launch: unexpected shapes (n_in %d out %d ws %zu)\n", n_in, out_size, ws_size); grid = -1; return; }
        int dev = 0, cus = 0, per_cu = 0;
        hipGetDevice(&dev); hipDeviceGetAttribute(&cus, hipDeviceAttributeMultiprocessorCount, dev);
        if (hipFuncSetAttribute((const void*)mega_fwd, hipFuncAttributeMaxDynamicSharedMemorySize, LDS_TOTAL) != hipSuccess) { fprintf(stderr, "kernel_launch: hipFuncSetAttribute failed\n"); grid = -1; return; }
        if (hipOccupancyMaxActiveBlocksPerMultiprocessor(&per_cu, (const void*)mega_fwd, NTHR, LDS_TOTAL) != hipSuccess || per_cu < 1) per_cu = 1;
        (void)hipGetLastError();
        grid = cus * per_cu;
        fprintf(stderr, "kernel_launch: grid %d (cus %d x %d)\n", grid, cus, per_cu);
    }
    if (grid < 0) return;
    Args a{};
    for (int i = 0; i < 34; ++i) a.in[i] = (const float*)d_in[i];
    a.out = (float*)d_out; a.ws = (unsigned char*)d_ws;
    void* args[] = {&a};
    hipError_t e = hipLaunchCooperativeKernel((const void*)mega_fwd, dim3(grid), dim3(NTHR), args, LDS_TOTAL, stream);
    if (e != hipSuccess) fprintf(stderr, "kernel_launch: cooperative launch failed: %s (grid %d)\n", hipGetErrorString(e), grid);
}
```

```cpp
#include <hip/hip_runtime.h>
#include <hip/hip_cooperative_groups.h>
#include <cstdio>
#include <cstdint>
namespace cg = cooperative_groups;
namespace pg8 {
#define PG8_LAS __attribute__((address_space(3)))
typedef unsigned short bf16_t;
typedef short bf16x8 __attribute__((ext_vector_type(8)));
typedef float f32x4 __attribute__((ext_vector_type(4)));
typedef unsigned u32x4 __attribute__((ext_vector_type(4)));
constexpr int BM = 256, BK = 64, HALF = 128, HTB = HALF * BK * 2  , STAGE_BYTES = 8 * HTB, NXCD = 8, WGM = 8;

__host__ __device__ __forceinline__ int lds_byte(int r, int c) { const int st = (r >> 4) * 2 + (c >> 5), rr = r & 15, cc = c & 31, ob = rr * 64 + cc * 2; return st * 1024 + (ob ^ (((ob >> 9) & 1) << 5)); }
__host__ __device__ __forceinline__ void stage_rc(int b, int& R, int& C) { const int st = b / 1024, sb = b % 1024, swz = sb ^ (((sb >> 9) & 1) << 5); R = (st >> 1) * 16 + swz / 64; C = (st & 1) * 32 + (swz % 64) / 2; }
__host__ __device__ __forceinline__ int perm32(int rho) { const int n = rho >> 4, i = rho & 15; return 8 * (i >> 2) + 4 * n + (i & 3); }

struct Unit { int pm, pn; };
struct Gemm { const bf16_t* A; const bf16_t* Bt; int M, N, K; };

struct StaticOrder {
    int nM, nN, nwg, G, c;
    __host__ __device__ void init(int M, int N, int G_, int c_) { nM = M / BM; nN = N / BM; nwg = nM * nN; G = G_; c = c_; }
    __host__ __device__ bool next(int i, Unit& u) const {
        const long L = (long)i * G + c; if (L >= nwg) return false;
        int wgid = (int)L; { const int q = nwg / NXCD, r = nwg % NXCD, xcd = wgid % NXCD, off = wgid / NXCD; wgid = (xcd < r ? xcd * (q + 1) : r * (q + 1) + (xcd - r) * q) + off; }
        const int nig = WGM * nN, gid = wgid / nig, fm = gid * WGM, gsz = (nM - fm) < WGM ? (nM - fm) : WGM;
        u.pm = fm + ((wgid % nig) % gsz); u.pn = (wgid % nig) / gsz; return true;
    }
    __device__ __forceinline__ void a_ready(const Unit&) const {}
    __device__ __forceinline__ void done(const Unit&) const {}
};

__device__ __forceinline__ unsigned cvt_pk_bf16(float lo, float hi) { unsigned r; asm volatile("v_cvt_pk_bf16_f32 %0, %1, %2" : "=v"(r) : "v"(lo), "v"(hi)); return r; }
typedef float f32x2 __attribute__((ext_vector_type(2)));
__device__ __forceinline__ f32x2 gelu_pk(f32x2 v) {
    const f32x2 av = __builtin_elementwise_abs(v), d = av * 0.2316418882f + 1.0f;
    f32x2 t; t.x = __builtin_amdgcn_rcpf(d.x); t.y = __builtin_amdgcn_rcpf(d.y);
    f32x2 q = t * 0.5307027145f + (-0.7265760135f); q = q * t + 0.7107068705f; q = q * t + (-0.142248368f); q = q * t + 0.127414796f; q = q * t;
    const f32x2 s = (v * v) * (-0.72134752044f);
    f32x2 e; e.x = __builtin_amdgcn_exp2f(s.x); e.y = __builtin_amdgcn_exp2f(s.y);
    const f32x2 m = v * (q * e), r = v - m;
    f32x2 o; o.x = v.x < 0.f ? m.x : r.x; o.y = v.y < 0.f ? m.y : r.y; return o;
}

template <int ACT  > struct EpiBf16 {
    static constexpr bool PERM = true, AFTER_DRAIN = false; static_assert(ACT == 0 || ACT == 1, "EpiBf16: ACT is 0 (none) or 1 (gelu_pk)");
    bf16_t* O; int ldc; const float* bias; int split_cols; size_t split_stride; float scale0;
    __device__ __forceinline__ void operator()(const f32x4 (&acc)[2][2][4][2], const Unit& u, int wr, int wc, int fr, int fq) const {
        const int row0 = u.pm * BM + wr * 64 + fr; int colt = u.pn * BM; bf16_t* base = O;
        float sc = 1.f; if (split_cols) { const int t = colt / split_cols; base += (size_t)t * split_stride; colt -= t * split_cols; if (t == 0) sc = scale0; }
        const int col0 = colt + wc * 32 + 8 * fq, bcol0 = u.pn * BM + wc * 32 + 8 * fq;
        f32x4 bv[2][2];
#pragma unroll
        for (int bj = 0; bj < 2; ++bj)
#pragma unroll
            for (int n = 0; n < 2; ++n) bv[bj][n] = bias ? *(const f32x4*)(bias + bcol0 + bj * HALF + 4 * n) : (f32x4){0.f, 0.f, 0.f, 0.f};
#pragma unroll
        for (int ai = 0; ai < 2; ++ai)
#pragma unroll
            for (int m = 0; m < 4; ++m) { bf16_t* rowp = base + (size_t)(row0 + ai * HALF + m * 16) * ldc + col0;
#pragma unroll
                for (int bj = 0; bj < 2; ++bj) { f32x4 v0 = acc[ai][bj][m][0] + bv[bj][0], v1 = acc[ai][bj][m][1] + bv[bj][1];
                    if (ACT == 1) { f32x2 a = gelu_pk((f32x2){v0[0], v0[1]}), b = gelu_pk((f32x2){v0[2], v0[3]}), c = gelu_pk((f32x2){v1[0], v1[1]}), d = gelu_pk((f32x2){v1[2], v1[3]});
                        v0 = (f32x4){a.x, a.y, b.x, b.y}; v1 = (f32x4){c.x, c.y, d.x, d.y}; }
                    v0 = v0 * sc; v1 = v1 * sc; u32x4 w; w.x = cvt_pk_bf16(v0[0], v0[1]); w.y = cvt_pk_bf16(v0[2], v0[3]); w.z = cvt_pk_bf16(v1[0], v1[1]); w.w = cvt_pk_bf16(v1[2], v1[3]);
                    *(u32x4*)(rowp + bj * HALF) = w; } }
    }
};

struct PanelStats {
    unsigned* xbuf;
    unsigned* cnt;
    unsigned* tmo;
    int ntn; float eps;
    unsigned code;
    __device__ __forceinline__ bool run(const f32x4 (&v)[2][2][4][2], const Unit& u, int wr, int wc, int fr, int fq, PG8_LAS unsigned char* lds, int wid, int lane) const {
        typedef float f32x2v __attribute__((ext_vector_type(2)));
        PG8_LAS f32x2v* P = (PG8_LAS f32x2v*)lds;
        PG8_LAS f32x2v* S = (PG8_LAS f32x2v*)(lds + 8192);
        PG8_LAS unsigned* flag = (PG8_LAS unsigned*)(lds + 8192 + 2048);
#pragma unroll
        for (int ai = 0; ai < 2; ++ai)
#pragma unroll
            for (int m = 0; m < 4; ++m) {
                float s = 0.f;
#pragma unroll
                for (int bj = 0; bj < 2; ++bj)
#pragma unroll
                    for (int n = 0; n < 2; ++n) { const f32x4 x = v[ai][bj][m][n]; s += (x[0] + x[1]) + (x[2] + x[3]); }
                s += __shfl_xor(s, 16); s += __shfl_xor(s, 32);
                const float mw = s * (1.0f / 64.0f); float q = 0.f;
#pragma unroll
                for (int bj = 0; bj < 2; ++bj)
#pragma unroll
                    for (int n = 0; n < 2; ++n) { const f32x4 d = v[ai][bj][m][n] - mw; q += (d[0] * d[0] + d[1] * d[1]) + (d[2] * d[2] + d[3] * d[3]); }
                q += __shfl_xor(q, 16); q += __shfl_xor(q, 32);
                if (fq == 0) P[(ai * HALF + wr * 64 + m * 16 + fr) * 4 + wc] = (f32x2v){mw, q};
            }
        asm volatile("s_waitcnt lgkmcnt(0)" ::: "memory"); __builtin_amdgcn_s_barrier(); asm volatile("" ::: "memory");
#if defined(BROKEN_EXCHANGE_NO_WAIT)
#warning BROKEN CONTROL BUILD: the row-statistics exchange does not wait; results are wrong by design
        if (blockIdx.x >= 64) { const long long t0_ = clock64(); while (clock64() - t0_ < 60000) __builtin_amdgcn_s_sleep(8); }
#endif
        const int row = wid * 32 + (lane & 31);
        if (lane < 32) {
            const f32x2v a = P[row * 4 + 0], b = P[row * 4 + 1], c = P[row * 4 + 2], d = P[row * 4 + 3];
            const float mt = (a.x + b.x + c.x + d.x) * 0.25f;
            const float da = a.x - mt, db = b.x - mt, dc = c.x - mt, dd = d.x - mt;
            const float m2 = (a.y + b.y) + (c.y + d.y) + 64.0f * ((da * da + db * db) + (dc * dc + dd * dd));
            unsigned long long* slot = (unsigned long long*)xbuf + ((size_t)(u.pm * BM + row) * 4 + u.pn);
            __hip_atomic_store(slot, ((unsigned long long)__float_as_uint(m2) << 32) | __float_as_uint(mt), __ATOMIC_RELAXED, __HIP_MEMORY_SCOPE_AGENT);
        }
        asm volatile("s_waitcnt vmcnt(0)" ::: "memory");
        if (lane == 0) __hip_atomic_fetch_add(cnt + 64 * u.pm, 1u, __ATOMIC_RELAXED, __HIP_MEMORY_SCOPE_AGENT);
        if (wid == 0) {
            bool dead = false; const unsigned long long t0 = __builtin_amdgcn_s_memrealtime(); const unsigned want = 8u * (unsigned)ntn;
            for (;;) {
#if defined(BROKEN_EXCHANGE_NO_WAIT)
                break;
#endif
                if ((unsigned)__builtin_amdgcn_readfirstlane(__hip_atomic_load(cnt + 64 * u.pm, __ATOMIC_RELAXED, __HIP_MEMORY_SCOPE_AGENT)) >= want) break;
                if (__builtin_amdgcn_s_memrealtime() - t0 > 2000000ull) {
                    if (lane == 0) { unsigned expect = 0u; __hip_atomic_compare_exchange_strong(tmo + 1, &expect, code | (unsigned)(u.pm & 0xff), __ATOMIC_RELAXED, __ATOMIC_RELAXED, __HIP_MEMORY_SCOPE_AGENT);
                                     __hip_atomic_store(tmo, 1u, __ATOMIC_RELAXED, __HIP_MEMORY_SCOPE_AGENT); }
                    dead = true; break; }
                __builtin_amdgcn_s_sleep(2);
            }
            __builtin_amdgcn_fence(__ATOMIC_ACQUIRE, "agent");
            if (lane == 0) flag[0] = dead ? 1u : 0u;
        }
        asm volatile("s_waitcnt vmcnt(0) lgkmcnt(0)" ::: "memory"); __builtin_amdgcn_s_barrier(); asm volatile("" ::: "memory");
        const bool bad = flag[0] != 0u;
        if (lane < 32) {
            const unsigned long long* slot = (const unsigned long long*)xbuf + (size_t)(u.pm * BM + row) * 4; float mt[4], m2[4]; float ms = 0.f;
#pragma unroll
            for (int t = 0; t < 4; ++t) { if (t < ntn) { const unsigned long long w = __hip_atomic_load(slot + t, __ATOMIC_RELAXED, __HIP_MEMORY_SCOPE_AGENT); mt[t] = __uint_as_float((unsigned)w); m2[t] = __uint_as_float((unsigned)(w >> 32)); } else { mt[t] = 0.f; m2[t] = 0.f; } ms += mt[t]; }
            const float mean = ms / (float)ntn; float q = 0.f;
#pragma unroll
            for (int t = 0; t < 4; ++t) if (t < ntn) { const float dm = mt[t] - mean; q += m2[t] + 256.0f * dm * dm; }
            S[row] = (f32x2v){mean, 1.0f / sqrtf(q / (256.0f * (float)ntn) + eps)};
        }
        asm volatile("s_waitcnt lgkmcnt(0)" ::: "memory"); __builtin_amdgcn_s_barrier(); asm volatile("" ::: "memory");
        return bad;
    }
};
struct EpiLnRes {
    static constexpr bool PERM = false, AFTER_DRAIN = true;
    const float* base; float* out; int ldc; const float* bias; PanelStats st; unsigned poison;
    __device__ __forceinline__ void fused(f32x4 (&acc)[2][2][4][2], const Unit& u, int wr, int wc, int fr, int fq, PG8_LAS unsigned char* lds, int wid, int lane) const {
        typedef float f32x2v __attribute__((ext_vector_type(2)));
        const PG8_LAS f32x2v* S = (const PG8_LAS f32x2v*)(lds + 8192);
        const int col0 = u.pn * BM + wc * 32 + 4 * fq;
#pragma unroll
        for (int bj = 0; bj < 2; ++bj)
#pragma unroll
            for (int n = 0; n < 2; ++n) { const f32x4 bv = bias ? *(const f32x4*)(bias + col0 + bj * HALF + n * 16) : (f32x4){0.f, 0.f, 0.f, 0.f};
#pragma unroll
                for (int ai = 0; ai < 2; ++ai)
#pragma unroll
                    for (int m = 0; m < 4; ++m) acc[ai][bj][m][n] += bv; }
        f32x4 pre[4][2][2];
#pragma unroll
        for (int m = 0; m < 4; ++m) { const size_t off = (size_t)(u.pm * BM + wr * 64 + m * 16 + fr) * ldc + col0;
#pragma unroll
            for (int bj = 0; bj < 2; ++bj)
#pragma unroll
                for (int n = 0; n < 2; ++n) pre[m][bj][n] = *(const f32x4*)(base + off + bj * HALF + n * 16); }
        const bool bad = st.run(acc, u, wr, wc, fr, fq, lds, wid, lane) || poison != 0u;
        const float qnan = __builtin_nanf("");
#pragma unroll
        for (int ai = 0; ai < 2; ++ai)
#pragma unroll
            for (int m = 0; m < 4; ++m) { const int r = ai * HALF + wr * 64 + m * 16 + fr; const f32x2v sr = S[r]; const size_t off = (size_t)(u.pm * BM + r) * ldc + col0;
#pragma unroll
                for (int bj = 0; bj < 2; ++bj)
#pragma unroll
                    for (int n = 0; n < 2; ++n) { const f32x4 bs = ai == 0 ? pre[m][bj][n] : *(const f32x4*)(base + off + bj * HALF + n * 16); f32x4 o = bs + (acc[ai][bj][m][n] - sr.x) * sr.y;
                        if (bad) o = (f32x4){qnan, qnan, qnan, qnan}; *(f32x4*)(out + off + bj * HALF + n * 16) = o; }
                if (m & 1) asm volatile("" ::: "memory"); }
    }
};
struct EpiLnResLn {
    static constexpr bool PERM = false, AFTER_DRAIN = true;
    const float* base; float* out; bf16_t* xn; int ldc; const float* bias; PanelStats st1, st2; unsigned poison;
    __device__ __forceinline__ void fused(f32x4 (&acc)[2][2][4][2], const Unit& u, int wr, int wc, int fr, int fq, PG8_LAS unsigned char* lds, int wid, int lane) const {
        typedef float f32x2v __attribute__((ext_vector_type(2))); typedef unsigned u32x2v __attribute__((ext_vector_type(2)));
        const PG8_LAS f32x2v* S = (const PG8_LAS f32x2v*)(lds + 8192);
        const int col0 = u.pn * BM + wc * 32 + 4 * fq;
#pragma unroll
        for (int bj = 0; bj < 2; ++bj)
#pragma unroll
            for (int n = 0; n < 2; ++n) { const f32x4 bv = bias ? *(const f32x4*)(bias + col0 + bj * HALF + n * 16) : (f32x4){0.f, 0.f, 0.f, 0.f};
#pragma unroll
                for (int ai = 0; ai < 2; ++ai)
#pragma unroll
                    for (int m = 0; m < 4; ++m) acc[ai][bj][m][n] += bv; }
        bool bad = st1.run(acc, u, wr, wc, fr, fq, lds, wid, lane) || poison != 0u;
        const float qnan = __builtin_nanf("");
#pragma unroll
        for (int ai = 0; ai < 2; ++ai)
#pragma unroll
            for (int m = 0; m < 4; ++m) { const int r = ai * HALF + wr * 64 + m * 16 + fr; const f32x2v sr = S[r]; const size_t off = (size_t)(u.pm * BM + r) * ldc + col0;
#pragma unroll
                for (int bj = 0; bj < 2; ++bj)
#pragma unroll
                    for (int n = 0; n < 2; ++n) { const f32x4 bs = *(const f32x4*)(base + off + bj * HALF + n * 16); acc[ai][bj][m][n] = bs + (acc[ai][bj][m][n] - sr.x) * sr.y; }
                asm volatile("" : "+v"(acc[ai][0][m][0]), "+v"(acc[ai][0][m][1]), "+v"(acc[ai][1][m][0]), "+v"(acc[ai][1][m][1]));
                if (m & 1) asm volatile("" ::: "memory"); }
        const bool bad1 = bad;
        bad = st2.run(acc, u, wr, wc, fr, fq, lds, wid, lane) || bad;
#pragma unroll
        for (int ai = 0; ai < 2; ++ai)
#pragma unroll
            for (int m = 0; m < 4; ++m) { const int r = ai * HALF + wr * 64 + m * 16 + fr; const f32x2v sr = S[r]; const size_t off = (size_t)(u.pm * BM + r) * ldc + col0;
#pragma unroll
                for (int bj = 0; bj < 2; ++bj)
#pragma unroll
                    for (int n = 0; n < 2; ++n) { const f32x4 x1 = acc[ai][bj][m][n]; *(f32x4*)(out + off + bj * HALF + n * 16) = bad1 ? (f32x4){qnan, qnan, qnan, qnan} : x1;
                        const f32x4 o = (x1 - sr.x) * sr.y; u32x2v w; w.x = cvt_pk_bf16(o[0], o[1]); w.y = cvt_pk_bf16(o[2], o[3]);
                        if (bad) { w.x = 0x7fc07fc0u; w.y = 0x7fc07fc0u; } *(u32x2v*)(xn + off + bj * HALF + n * 16) = w; }
                asm volatile("" ::: "memory"); }
    }
};

template <class Epi, class Sched, bool ALIGN_EPI = false, bool SP2 = false>
__device__ __forceinline__ void gemm_phase(PG8_LAS unsigned char* lds, const Gemm g, const Sched& S, const Epi& E) {
    int tid_ = threadIdx.x; asm volatile("" : "+v"(tid_));
    const int tid = tid_, wid = __builtin_amdgcn_readfirstlane(tid >> 6), lane = tid & 63, wr = wid >> 2, wc = wid & 3, fr = lane & 15, fq = lane >> 4;
    const int K = g.K, nt = K / BK;
    unsigned voffA[2], voffB[2];
#pragma unroll
    for (int i = 0; i < 2; ++i) { int R, C; stage_rc(tid * 16 + i * 8192, R, C); const int Rb = Epi::PERM ? ((R & ~31) + perm32(R & 31)) : R;
        voffA[i] = (unsigned)(R * K + C) * 2u; voffB[i] = (unsigned)(Rb * K + C) * 2u; }
    const size_t kstep = (size_t)(BK * 2);
    const size_t hstep = (size_t)HALF * K * 2;
    const size_t tstep = 2 * hstep;
    const unsigned ldsw = (unsigned)wid * 1024u;
    const int aoff = lds_byte(wr * 64 + fr, fq * 8), boff = lds_byte(wc * 32 + fr, fq * 8);
#define PG8_SA(b, h) (((b) * 2 + (h)) * HTB)
#define PG8_SB(b, h) ((4 + (b) * 2 + (h)) * HTB)
#define PG8_STAGE(bufoff, gbase, voff) do { _Pragma("unroll") for (int _i = 0; _i < 2; ++_i) \
        __builtin_amdgcn_global_load_lds((const unsigned*)((const char*)(gbase) + (voff)[_i]), (PG8_LAS unsigned*)(lds + (bufoff) + ldsw + _i * 8192), 16, 0, 0); } while (0)
#define PG8_LDA(dst, b, h) do { _Pragma("unroll") for (int m = 0; m < 4; ++m) _Pragma("unroll") for (int k = 0; k < 2; ++k) dst[m][k] = *(const PG8_LAS bf16x8*)(lds + PG8_SA(b, h) + aoff + m * 2048 + k * 1024); } while (0)
#define PG8_LDB(dst, b, h) do { _Pragma("unroll") for (int n = 0; n < 2; ++n) _Pragma("unroll") for (int k = 0; k < 2; ++k) dst[n][k] = *(const PG8_LAS bf16x8*)(lds + PG8_SB(b, h) + boff + n * 2048 + k * 1024); } while (0)
#define PG8_MMA(ai, bj, At, Bt) do { __builtin_amdgcn_s_setprio(1); _Pragma("unroll") for (int m = 0; m < 4; ++m) _Pragma("unroll") for (int n = 0; n < 2; ++n) _Pragma("unroll") for (int k = 0; k < 2; ++k) \
        acc[ai][bj][m][n] = __builtin_amdgcn_mfma_f32_16x16x32_bf16(Bt[n][k], At[m][k], acc[ai][bj][m][n], 0, 0, 0); __builtin_amdgcn_s_setprio(0); } while (0)
#define PG8_WAIT_V(n) asm volatile("s_waitcnt vmcnt(" #n ")" ::: "memory")
#define PG8_WAIT_L(n) asm volatile("s_waitcnt lgkmcnt(" #n ")" ::: "memory")
#define PG8_BAR __builtin_amdgcn_s_barrier()
#define PG8_SCHED __builtin_amdgcn_sched_barrier(0)
    Unit cur, nxt; int ui = 0;
    if (!S.next(0, cur)) return;
    f32x4 acc[2][2][4][2];
#pragma unroll
    for (int a = 0; a < 2; ++a)
#pragma unroll
        for (int b = 0; b < 2; ++b)
#pragma unroll
            for (int m = 0; m < 4; ++m)
#pragma unroll
                for (int n = 0; n < 2; ++n) acc[a][b][m][n] = (f32x4){0.f, 0.f, 0.f, 0.f};
    bf16x8 At[4][2], B0[2][2], B1[2][2];
    const char* cA = (const char*)g.A + (size_t)cur.pm * tstep; const char* cB = (const char*)g.Bt + (size_t)cur.pn * tstep;
    S.a_ready(cur);
    if constexpr (SP2) {
        PG8_STAGE(PG8_SB(0, 0), cB, voffB); PG8_STAGE(PG8_SB(0, 1), cB + hstep, voffB); PG8_STAGE(PG8_SA(0, 0), cA, voffA); PG8_STAGE(PG8_SA(0, 1), cA + hstep, voffA);
        if (wr == 1) PG8_BAR;
        PG8_WAIT_V(2); PG8_BAR;
        PG8_STAGE(PG8_SB(1, 0), cB + kstep, voffB); PG8_STAGE(PG8_SA(1, 0), cA + kstep, voffA); PG8_STAGE(PG8_SB(1, 1), cB + hstep + kstep, voffB);
        PG8_WAIT_V(6); PG8_BAR;
    } else {
        PG8_STAGE(PG8_SB(0, 0), cB, voffB); PG8_STAGE(PG8_SA(0, 0), cA, voffA); PG8_STAGE(PG8_SB(0, 1), cB + hstep, voffB); PG8_STAGE(PG8_SA(0, 1), cA + hstep, voffA);
        if (wr == 1) PG8_BAR;
        PG8_WAIT_V(4); PG8_BAR;
        PG8_STAGE(PG8_SB(1, 0), cB + kstep, voffB); PG8_STAGE(PG8_SA(1, 0), cA + kstep, voffA); PG8_STAGE(PG8_SB(1, 1), cB + hstep + kstep, voffB);
        PG8_WAIT_V(6); PG8_BAR;
    }
    for (;;) {
        const bool has_next = S.next(ui + 1, nxt);
        const char* nA = has_next ? (const char*)g.A + (size_t)nxt.pm * tstep : cA; const char* nB = has_next ? (const char*)g.Bt + (size_t)nxt.pn * tstep : cB;
        for (int t = 0; t < nt; t += 2) {
            const bool last = (t == nt - 2);
            const char* a1 = cA + (size_t)(t + 1) * kstep;
            const char* a2 = last ? nA : cA + (size_t)(t + 2) * kstep; const char* b2 = last ? nB : cB + (size_t)(t + 2) * kstep;
            const char* a3 = a2 + kstep; const char* b3 = b2 + kstep;
            if (last && has_next) S.a_ready(nxt);
            if constexpr (SP2) {
            PG8_LDB(B0, 0, 0); PG8_LDB(B1, 0, 1); PG8_SCHED; PG8_LDA(At, 0, 0); PG8_STAGE(PG8_SA(1, 1), a1 + hstep, voffA);
            PG8_WAIT_V(8); PG8_WAIT_L(0); PG8_BAR; PG8_MMA(0, 0, At, B0); PG8_MMA(0, 1, At, B1); PG8_BAR; PG8_SCHED;
            PG8_LDA(At, 0, 1); PG8_STAGE(PG8_SB(0, 0), b2, voffB); PG8_STAGE(PG8_SB(0, 1), b2 + hstep, voffB); PG8_STAGE(PG8_SA(0, 0), a2, voffA);
            PG8_WAIT_V(8); PG8_WAIT_L(0); PG8_BAR; PG8_MMA(1, 0, At, B0); PG8_MMA(1, 1, At, B1); PG8_BAR; PG8_SCHED;
            PG8_LDB(B0, 1, 0); PG8_LDB(B1, 1, 1); PG8_SCHED; PG8_LDA(At, 1, 0); PG8_STAGE(PG8_SA(0, 1), a2 + hstep, voffA);
            PG8_WAIT_V(8); PG8_WAIT_L(0); PG8_BAR; PG8_MMA(0, 0, At, B0); PG8_MMA(0, 1, At, B1); PG8_BAR; PG8_SCHED;
            PG8_LDA(At, 1, 1); PG8_STAGE(PG8_SB(1, 0), b3, voffB); PG8_STAGE(PG8_SB(1, 1), b3 + hstep, voffB); PG8_STAGE(PG8_SA(1, 0), a3, voffA);
            PG8_WAIT_V(8); PG8_WAIT_L(0); PG8_BAR; PG8_MMA(1, 0, At, B0); PG8_MMA(1, 1, At, B1); PG8_BAR; PG8_SCHED;
            } else {
            PG8_LDB(B0, 0, 0); PG8_SCHED; PG8_LDA(At, 0, 0); PG8_STAGE(PG8_SA(1, 1), a1 + hstep, voffA);
            PG8_WAIT_L(8); PG8_BAR; PG8_WAIT_L(0); PG8_MMA(0, 0, At, B0); PG8_BAR; PG8_SCHED;
            PG8_LDB(B1, 0, 1); PG8_STAGE(PG8_SB(0, 0), b2, voffB);
            PG8_BAR; PG8_WAIT_L(0); PG8_MMA(0, 1, At, B1); PG8_BAR;
            PG8_LDA(At, 0, 1); PG8_STAGE(PG8_SA(0, 0), a2, voffA);
            PG8_BAR; PG8_WAIT_L(0); PG8_MMA(1, 0, At, B0); PG8_BAR; PG8_SCHED;
            PG8_STAGE(PG8_SB(0, 1), b2 + hstep, voffB);
            PG8_WAIT_V(6); PG8_BAR; PG8_MMA(1, 1, At, B1); PG8_BAR;
            PG8_LDB(B0, 1, 0); PG8_SCHED; PG8_LDA(At, 1, 0); PG8_STAGE(PG8_SA(0, 1), a2 + hstep, voffA);
            PG8_WAIT_L(8); PG8_BAR; PG8_WAIT_L(0); PG8_MMA(0, 0, At, B0); PG8_BAR; PG8_SCHED;
            PG8_LDB(B1, 1, 1); PG8_STAGE(PG8_SB(1, 0), b3, voffB);
            PG8_BAR; PG8_WAIT_L(0); PG8_MMA(0, 1, At, B1); PG8_BAR;
            PG8_LDA(At, 1, 1); PG8_STAGE(PG8_SA(1, 0), a3, voffA);
            PG8_BAR; PG8_WAIT_L(0); PG8_MMA(1, 0, At, B0); PG8_BAR; PG8_SCHED;
            PG8_STAGE(PG8_SB(1, 1), b3 + hstep, voffB);
            PG8_WAIT_V(6); PG8_BAR; PG8_MMA(1, 1, At, B1); PG8_BAR;
            }
        }
        if constexpr (ALIGN_EPI) { if (wr == 0) PG8_BAR; }
        if constexpr (!Epi::AFTER_DRAIN) { E(acc, cur, wr, wc, fr, fq); S.done(cur); }
        if (!has_next) break;
#pragma unroll
        for (int a = 0; a < 2; ++a)
#pragma unroll
            for (int b = 0; b < 2; ++b)
#pragma unroll
                for (int m = 0; m < 4; ++m)
#pragma unroll
                    for (int n = 0; n < 2; ++n) acc[a][b][m][n] = (f32x4){0.f, 0.f, 0.f, 0.f};
        cur = nxt; cA = nA; cB = nB; ++ui;
        if constexpr (ALIGN_EPI) { if (wr == 1) PG8_BAR; }
    }
    PG8_WAIT_V(0);
    if constexpr (!ALIGN_EPI) { if (wr == 0) PG8_BAR; }
    PG8_BAR;
    if constexpr (Epi::AFTER_DRAIN) { E.fused(acc, cur, wr, wc, fr, fq, lds, wid, lane); S.done(cur); }
#undef PG8_SA
#undef PG8_SB
#undef PG8_STAGE
#undef PG8_LDA
#undef PG8_LDB
#undef PG8_MMA
#undef PG8_WAIT_V
#undef PG8_WAIT_L
#undef PG8_BAR
#undef PG8_SCHED
}
}
namespace pg8 {
struct EpiResid {
    static constexpr bool PERM = false, AFTER_DRAIN = false;
    float* x; int ldc; float alpha;
    __device__ __forceinline__ void operator()(const f32x4 (&acc)[2][2][4][2], const Unit& u, int wr, int wc, int fr, int fq) const {
        const int col0 = u.pn * BM + wc * 32 + 4 * fq;
#pragma unroll
        for (int ai = 0; ai < 2; ++ai)
#pragma unroll
            for (int m = 0; m < 4; ++m) { const int r = ai * HALF + wr * 64 + m * 16 + fr; const size_t off = (size_t)(u.pm * BM + r) * ldc + col0;
#pragma unroll
                for (int bj = 0; bj < 2; ++bj)
#pragma unroll
                    for (int n = 0; n < 2; ++n) { float* p = x + off + bj * HALF + n * 16; f32x4 v = *(const f32x4*)p; v = v * alpha + acc[ai][bj][m][n]; *(f32x4*)p = v; }
                if (m & 1) asm volatile("" ::: "memory"); }
    }
};

__device__ __forceinline__ float dpp_ror1(float v) { return __builtin_bit_cast(float, __builtin_amdgcn_update_dpp(0, __builtin_bit_cast(int, v), 0x121, 0xf, 0xf, false)); }
__device__ __forceinline__ float dpp_ror2(float v) { return __builtin_bit_cast(float, __builtin_amdgcn_update_dpp(0, __builtin_bit_cast(int, v), 0x122, 0xf, 0xf, false)); }
struct EpiConv {
    static constexpr bool PERM = false, AFTER_DRAIN = false;
    bf16_t* H; bf16_t* Gs; const float* cw; const float* cb; int nff;
    __device__ __forceinline__ void operator()(const f32x4 (&acc)[2][2][4][2], const Unit& u, int wr, int wc, int fr, int fq) const {
        typedef unsigned u32x2v __attribute__((ext_vector_type(2)));
        const int ch0 = u.pn * HALF + wc * 32 + 4 * fq;
        f32x4 w0[2], w1[2], w2[2], bb[2];
#pragma unroll
        for (int n = 0; n < 2; ++n) { w0[n] = *(const f32x4*)(cw + ch0 + 16 * n); w1[n] = *(const f32x4*)(cw + nff + ch0 + 16 * n); w2[n] = *(const f32x4*)(cw + 2 * nff + ch0 + 16 * n); bb[n] = *(const f32x4*)(cb + ch0 + 16 * n); }
#pragma unroll
        for (int ai = 0; ai < 2; ++ai)
#pragma unroll
            for (int m = 0; m < 4; ++m) { const size_t off = (size_t)(u.pm * BM + ai * HALF + wr * 64 + m * 16 + fr) * nff + ch0;
#pragma unroll
                for (int n = 0; n < 2; ++n) { const f32x4 g = acc[ai][0][m][n], v = acc[ai][1][m][n], gp = acc[ai][0][m > 0 ? m - 1 : 0][n];
                    f32x4 o;
#pragma unroll
                    for (int j = 0; j < 4; ++j) { const float a1 = dpp_ror1(g[j]), b1 = dpp_ror1(gp[j]), a2 = dpp_ror2(g[j]), b2 = dpp_ror2(gp[j]);
                        const float g1 = fr >= 1 ? a1 : b1, g2 = fr >= 2 ? a2 : b2;
                        const float cv = bb[n][j] + w0[n][j] * g2 + w1[n][j] * g1 + w2[n][j] * g[j];
                        o[j] = cv * __builtin_amdgcn_rcpf(1.0f + __expf(-cv)) * v[j]; }
                    const bool first2 = (m == 0) && (fr < 2);
                    if (first2) o = v;
                    u32x2v w; w.x = cvt_pk_bf16(o[0], o[1]); w.y = cvt_pk_bf16(o[2], o[3]);
                    *(u32x2v*)(H + off + 16 * n) = w;
                    if (first2 || ((m == 3) && (fr >= 14))) { u32x2v gw; gw.x = cvt_pk_bf16(g[0], g[1]); gw.y = cvt_pk_bf16(g[2], g[3]); *(u32x2v*)(Gs + off + 16 * n) = gw; }
                }
            }
    }
};
}
#define PG8_SP2 true
#define PG8_ALIGN true
#include <hip/hip_bf16.h>
#include <cmath>
namespace attn_body {
using bf16=__hip_bfloat16;
using bf16x8=__attribute__((ext_vector_type(8)))short;
using s16x4=__attribute__((ext_vector_type(4)))short;
using f32x16=__attribute__((ext_vector_type(16)))float;
using u32x4=__attribute__((ext_vector_type(4)))unsigned;
constexpr int BATCH=2,NHEAD=16,SEQ=16384,D=64,DM=3328,DMO=1024;
constexpr int NW=8,QBLK=32,QB=QBLK*NW,KVBLK=64,NQB=SEQ/QB;
constexpr int ATTN_PITCH=DM, ATTN_UNIT_ROWS=QB;
__device__ __forceinline__ int crow(int r,int hi){return (r&3)+8*(r>>2)+4*hi;}
#define SBAR() __builtin_amdgcn_sched_barrier(0)
__device__ __forceinline__ void cmask(f32x16&p0,f32x16&p1,int jb,int qrel,int hi){
  const float NEG=-INFINITY; int kb=64*jb+4*hi;
  #pragma unroll
  for(int r=0;r<16;++r){int kv=kb+(r&3)+8*(r>>2); if(kv>qrel)p0[r]=NEG; if(kv+32>qrel)p1[r]=NEG;}
}

constexpr int NSLOT=3, SLOTB=8192;
constexpr int LDS_K=0, LDS_V=NSLOT*SLOTB, LDS_WS=2*NSLOT*SLOTB, LDS_OST=LDS_WS+NW*64*4, LDS_BYTES=LDS_OST+NW*4096;
constexpr float C2=0.125f*1.4426950408889634f;
__device__ __forceinline__ void glds16(const void*gsrc,unsigned lds_dst){unsigned keep;
  asm volatile("s_mov_b32 %0, m0\n\ts_mov_b32 m0, %2\n\ts_nop 0\n\tglobal_load_lds_dwordx4 %1, off\n\ts_mov_b32 m0, %0":"=&s"(keep):"v"(gsrc),"s"(lds_dst):"memory");}
__device__ __forceinline__ float max3f(float a,float b,float c){float r;asm("v_max3_f32 %0, %1, %2, %3":"=v"(r):"v"(a),"v"(b),"v"(c));return r;}
__device__ __forceinline__ float max2f(float a,float b){float r;asm("v_max_f32_e32 %0, %1, %2":"=v"(r):"v"(a),"v"(b));return r;}
__device__ __forceinline__ float fadd_s(float a,float b){float r;asm("v_add_f32_e32 %0, %1, %2":"=v"(r):"v"(a),"v"(b));return r;}
__device__ __forceinline__ float fsub_s(float a,float b){float r;asm("v_sub_f32_e32 %0, %1, %2":"=v"(r):"v"(a),"v"(b));return r;}
typedef float f32x2_t __attribute__((ext_vector_type(2))); typedef __bf16 bf16x2_t __attribute__((ext_vector_type(2)));
__device__ __forceinline__ unsigned cvtpk_s(float lo,float hi){f32x2_t v={lo,hi};bf16x2_t b=__builtin_convertvector(v,bf16x2_t);return __builtin_bit_cast(unsigned,b);}
#define WAIT_BAR(N) asm volatile("s_waitcnt vmcnt(" #N ") lgkmcnt(0)\n\ts_barrier":::"memory")

__device__ __forceinline__ void qkt(f32x16&p0,f32x16&p1,const char*Kslot,const bf16x8*qr,const f32x16&negm,int r32,int hi){
  const char*kb=Kslot+hi*1024+r32*16;
  #pragma unroll
  for(int d0=0;d0<4;++d0){
    const bf16x8 b0=*reinterpret_cast<const bf16x8*>(kb+d0*2048);
    const bf16x8 b1=*reinterpret_cast<const bf16x8*>(kb+d0*2048+512);
    if(d0==0){p0=__builtin_amdgcn_mfma_f32_32x32x16_bf16(b0,qr[0],negm,0,0,0);p1=__builtin_amdgcn_mfma_f32_32x32x16_bf16(b1,qr[0],negm,0,0,0);}
    else{p0=__builtin_amdgcn_mfma_f32_32x32x16_bf16(b0,qr[d0],p0,0,0,0);p1=__builtin_amdgcn_mfma_f32_32x32x16_bf16(b1,qr[d0],p1,0,0,0);}}
}
typedef __attribute__((address_space(3))) const char* lds_cptr;
typedef short v4i16_t __attribute__((ext_vector_type(4)));
__device__ __forceinline__ void kload8(bf16x8*kf,lds_cptr kp){
  kf[0]=*(const __attribute__((address_space(3))) bf16x8*)(kp);      kf[1]=*(const __attribute__((address_space(3))) bf16x8*)(kp+512);
  kf[2]=*(const __attribute__((address_space(3))) bf16x8*)(kp+2048); kf[3]=*(const __attribute__((address_space(3))) bf16x8*)(kp+2560);
  kf[4]=*(const __attribute__((address_space(3))) bf16x8*)(kp+4096); kf[5]=*(const __attribute__((address_space(3))) bf16x8*)(kp+4608);
  kf[6]=*(const __attribute__((address_space(3))) bf16x8*)(kp+6144); kf[7]=*(const __attribute__((address_space(3))) bf16x8*)(kp+6656);
}
__device__ __forceinline__ void kload2(bf16x8*kf,lds_cptr kp,int j){ kf[2*j]=*(const __attribute__((address_space(3))) bf16x8*)(kp+j*2048); kf[2*j+1]=*(const __attribute__((address_space(3))) bf16x8*)(kp+j*2048+512); }
__device__ __forceinline__ s16x4 vtr(lds_cptr p){ return __builtin_bit_cast(s16x4,__builtin_amdgcn_ds_read_tr16_b64_v4i16((__attribute__((address_space(3))) v4i16_t*)p)); }
__device__ __forceinline__ float rowmax(const f32x16&p0,const f32x16&p1){
  float a=max3f(p0[0],p0[1],p1[0]),b=max3f(p0[2],p0[3],p1[1]);a=max3f(a,p1[2],p1[3]);
  #pragma unroll
  for(int r=4;r<16;r+=4){a=max3f(a,p0[r],p0[r+1]);b=max3f(b,p0[r+2],p0[r+3]);a=max3f(a,p1[r],p1[r+1]);b=max3f(b,p1[r+2],p1[r+3]);}
  const float m=max2f(a,b);
  auto rr=__builtin_amdgcn_permlane32_swap(__float_as_uint(m),__float_as_uint(m),false,false);
  return max2f(__uint_as_float(rr[0]),__uint_as_float(rr[1]));
}
__device__ __forceinline__ void pv(f32x16*o,int vb,bf16x8 pa0,bf16x8 pa1,bf16x8 pa2,bf16x8 pa3){
  #pragma unroll
  for(int d0=0;d0<2;++d0){s16x4 lo[4],hi[4];
    #pragma unroll
    for(int ks=0;ks<4;++ks){
      asm volatile("ds_read_b64_tr_b16 %0,%1 offset:%c2":"=&v"(lo[ks]):"v"(vb),"i"(d0*4096+ks*1024):"memory");
      asm volatile("ds_read_b64_tr_b16 %0,%1 offset:%c2":"=&v"(hi[ks]):"v"(vb),"i"(d0*4096+ks*1024+512):"memory");}
    asm volatile("s_waitcnt lgkmcnt(0)":::"memory");SBAR();
    #define PK(k) (bf16x8){lo[k][0],lo[k][1],lo[k][2],lo[k][3],hi[k][0],hi[k][1],hi[k][2],hi[k][3]}
    o[d0]=__builtin_amdgcn_mfma_f32_32x32x16_bf16(pa0,PK(0),o[d0],0,0,0);
    o[d0]=__builtin_amdgcn_mfma_f32_32x32x16_bf16(pa1,PK(1),o[d0],0,0,0);
    o[d0]=__builtin_amdgcn_mfma_f32_32x32x16_bf16(pa2,PK(2),o[d0],0,0,0);
    o[d0]=__builtin_amdgcn_mfma_f32_32x32x16_bf16(pa3,PK(3),o[d0],0,0,0);
    #undef PK
  }
}

#ifndef ATTN_STORE16
#define ATTN_STORE16(p,v) (*(u32x4*)(p)=(v))
#endif
template<int THRL> __device__ __forceinline__ void attn_unit(int b,int h,int qb,const bf16*Q,const bf16*__restrict__ K,const bf16*__restrict__ V,bf16*O,char*shm){
  int tid_=threadIdx.x; asm volatile("":"+v"(tid_)); const int tid=tid_,lane=tid&63,r32=lane&31,hi=lane>>5; const int wid=__builtin_amdgcn_readfirstlane(tid>>6);
  const long rowbase=(long)b*SEQ; const int q0=qb*QB;
  const bf16*Qw=Q+(rowbase+q0+wid*QBLK)*DM+h*D;
  const bf16*Kh=K+rowbase*DM+h*D,*Vh=V+rowbase*DM+h*D;
  const unsigned lds0=(unsigned)(uintptr_t)shm;
  float*wsf=(float*)(shm+LDS_WS)+wid*64;
  const bf16*ksrc=Kh+(long)lane*DM+wid*8;
  const bf16*vsrc=Vh+(long)(16*(wid&3)+(lane>>2))*DM+(wid>>2)*32+(lane&3)*8;
  const unsigned kdst=lds0+LDS_K+wid*1024, vdst=lds0+LDS_V+wid*1024;
  #define DMA_K(t,slot) glds16(ksrc+(long)(t)*KVBLK*DM,(unsigned)__builtin_amdgcn_readfirstlane(kdst+(slot)))
  #define DMA_V(t,slot) glds16(vsrc+(long)(t)*KVBLK*DM,(unsigned)__builtin_amdgcn_readfirstlane(vdst+(slot)))
  const int vb0=(int)(lds0+LDS_V)+((lane>>4)&1)*32+(lane&3)*8+(4*hi+((lane&15)>>2))*64;
  const char*Kbase=shm+LDS_K; bf16x8 kf[8];
  const lds_cptr shm3=(lds_cptr)shm; const lds_cptr kp0=shm3+LDS_K+hi*1024+r32*16; const lds_cptr vp0=shm3+LDS_V+((lane>>4)&1)*32+(lane&3)*8+(4*hi+((lane&15)>>2))*64;
  const int NT=(q0+QB)/KVBLK;
  DMA_K(0,0);DMA_V(0,0);DMA_K(1,SLOTB);
  bf16x8 qr[4];
  #pragma unroll
  for(int d0=0;d0<4;++d0)qr[d0]=*reinterpret_cast<const bf16x8*>(&Qw[(long)r32*DM+d0*16+hi*8]);
  float mhat=0.f,l_reg=0.f;f32x16 o[2];o[0]=f32x16{};o[1]=f32x16{};f32x16 negm=f32x16{};asm volatile("":"+v"(negm));
  const int qrel=wid*QBLK+r32;
  #define CMASK(P0,P1,t) do{int jb_=(t)-(NT-4); if(jb_>=0)cmask(P0,P1,jb_,qrel,hi);}while(0)
  bool resc=false;
  #define START(P0,P1) do{ const float rm=rowmax(P0,P1); resc=false; \
    { const float dl=rm; mhat=fadd_s(mhat,dl); \
      _Pragma("unroll") for(int r=0;r<16;++r){P0[r]=fsub_s(P0[r],dl);P1[r]=fsub_s(P1[r],dl);} \
      _Pragma("unroll") for(int r=0;r<16;++r)negm[r]=-mhat; asm volatile("":"+v"(negm)); } \
    _Pragma("unroll") for(int r=0;r<16;++r)P0[r]=__builtin_amdgcn_exp2f(P0[r]); }while(0)
  #define RESC() do{ if(resc){ asm volatile("s_waitcnt lgkmcnt(0)":::"memory"); \
      _Pragma("unroll") for(int d_=0;d_<2;++d_) _Pragma("unroll") for(int r=0;r<16;++r)o[d_][r]*=wsf[crow(r,hi)]; } }while(0)
  f32x16 pA0,pA1,pB0,pB1;
  int sl_prev=0,sl_cur=0,sl_next=SLOTB;
  #define ROT() do{sl_prev=sl_cur;sl_cur=sl_next;sl_next=(sl_next==(NSLOT-1)*SLOTB)?0:sl_next+SLOTB;}while(0)
  DMA_K(2,2*SLOTB);
  WAIT_BAR(3);
  qkt(pA0,pA1,Kbase,qr,negm,r32,hi);asm volatile("s_nop 15\n\ts_nop 7":"+v"(pA0),"+v"(pA1));CMASK(pA0,pA1,0);
  START(pA0,pA1);
  _Pragma("unroll") for(int r=0;r<16;++r)pA1[r]=__builtin_amdgcn_exp2f(pA1[r]);
  WAIT_BAR(0);
  DMA_K(3,0);DMA_V(1,SLOTB);
  ROT();
  kload8(kf,kp0+sl_cur);
  WAIT_BAR(2);
  s16x4 vlo[8],vhi[8]; u32x4 pw0,pw1,pw2,pw3;
  #define PKW(P,B) cvtpk_s(P[B],P[B+1])
  #define PAF(k) __builtin_bit_cast(bf16x8,pw##k)
  #define VFR(i) (bf16x8){vlo[i][0],vlo[i][1],vlo[i][2],vlo[i][3],vhi[i][0],vhi[i][1],vhi[i][2],vhi[i][3]}
  #define PIN(x) asm volatile("":"+v"(x))
  #define MX3(a,b,c) __builtin_fmaxf(__builtin_fmaxf((a),(b)),(c))
  #define GAPA(MF,A0,A1,A2,A3,W0,W1,PW) do{ MF; sacc+=A0; sacc+=A1; sacc+=A2; sacc+=A3; PIN(sacc); W0; W1; PIN(PW); SBAR(); }while(0)
  #define EX(v) __builtin_amdgcn_exp2f(v)
  #define GAPB(MF,X,B) do{ MF; X[B]=EX(X[B]); X[B+1]=EX(X[B+1]); X[B+2]=EX(X[B+2]); X[B+3]=EX(X[B+3]); PIN(X); SBAR(); }while(0)
  #define VRD(i) do{ vlo[i]=vtr(vp_+(((i)>>2)*4096+((i)&3)*1024)); vhi[i]=vtr(vp_+(((i)>>2)*4096+((i)&3)*1024+512)); }while(0)
  #define KRD(G,j) do{ if(G){ kload2(kf,kp0+sl_next,j); SBAR(); } }while(0)
  #define STEP(C0,C1,P0,P1,t,GK,GV,GL) do{ SBAR(); \
    const lds_cptr vp_=vp0+sl_prev; \
    VRD(0); SBAR(); float sacc=(P0[0]+P0[1]); \
    GAPA(C0=__builtin_amdgcn_mfma_f32_32x32x16_bf16(kf[0],qr[0],negm,0,0,0), P0[2],P0[3],P0[4],P0[5],     pw0[0]=PKW(P0,0), pw0[1]=PKW(P0,2), pw0); \
    VRD(4); SBAR(); GAPA(C1=__builtin_amdgcn_mfma_f32_32x32x16_bf16(kf[1],qr[0],negm,0,0,0), P0[6],P0[7],P0[8],P0[9],     pw0[2]=PKW(P0,4), pw0[3]=PKW(P0,6), pw0); \
    VRD(1); SBAR(); GAPA(C0=__builtin_amdgcn_mfma_f32_32x32x16_bf16(kf[2],qr[1],C0,0,0,0),   P0[10],P0[11],P0[12],P0[13], pw1[0]=PKW(P0,8), pw1[1]=PKW(P0,10), pw1); \
    VRD(5); SBAR(); GAPA(C1=__builtin_amdgcn_mfma_f32_32x32x16_bf16(kf[3],qr[1],C1,0,0,0),   P0[14],P0[15],P1[0],P1[1],   pw1[2]=PKW(P0,12),pw1[3]=PKW(P0,14), pw1); \
    VRD(2); SBAR(); GAPA(C0=__builtin_amdgcn_mfma_f32_32x32x16_bf16(kf[4],qr[2],C0,0,0,0),   P1[2],P1[3],P1[4],P1[5],     pw2[0]=PKW(P1,0), pw2[1]=PKW(P1,2), pw2); \
    VRD(6); SBAR(); GAPA(C1=__builtin_amdgcn_mfma_f32_32x32x16_bf16(kf[5],qr[2],C1,0,0,0),   P1[6],P1[7],P1[8],P1[9],     pw2[2]=PKW(P1,4), pw2[3]=PKW(P1,6), pw2); \
    VRD(3); SBAR(); GAPA(C0=__builtin_amdgcn_mfma_f32_32x32x16_bf16(kf[6],qr[3],C0,0,0,0),   P1[10],P1[11],P1[12],P1[13], pw3[0]=PKW(P1,8), pw3[1]=PKW(P1,10), pw3); \
    VRD(7); SBAR(); GAPA(C1=__builtin_amdgcn_mfma_f32_32x32x16_bf16(kf[7],qr[3],C1,0,0,0),   P1[14],P1[15],0.f,0.f,       pw3[2]=PKW(P1,12),pw3[3]=PKW(P1,14), pw3); \
    l_reg+=sacc; \
    if(GK){DMA_K((t)+3,sl_cur);} if(GV){DMA_V((t)+1,sl_next);} \
    CMASK(C0,C1,t); \
    { float a=MX3(C0[0],C0[1],C1[0]),b=MX3(C0[2],C0[3],C1[1]); a=MX3(a,C1[2],C1[3]); \
      _Pragma("unroll") for(int r=4;r<16;r+=4){a=MX3(a,C0[r],C0[r+1]);b=MX3(b,C0[r+2],C0[r+3]);a=MX3(a,C1[r],C1[r+1]);b=MX3(b,C1[r+2],C1[r+3]);} \
      float rm=__builtin_fmaxf(a,b); { auto rr=__builtin_amdgcn_permlane32_swap(__float_as_uint(rm),__float_as_uint(rm),false,false); rm=__builtin_fmaxf(__uint_as_float(rr[0]),__uint_as_float(rr[1])); } \
      resc=false; \
      if(__builtin_expect(__any(rm>(float)THRL),0)){ const float dl=__builtin_fmaxf(rm,0.f); mhat+=dl; \
        _Pragma("unroll") for(int r=0;r<16;++r){C0[r]-=dl;C1[r]-=dl;} \
        _Pragma("unroll") for(int r=0;r<16;++r)negm[r]=-mhat; asm volatile("":"+v"(negm)); \
        const float f=__builtin_amdgcn_exp2f(-dl); l_reg*=f; if(hi==0)wsf[r32]=f; resc=true; } } \
    SBAR(); \
    GAPB(o[0]=__builtin_amdgcn_mfma_f32_32x32x16_bf16(PAF(0),VFR(0),o[0],0,0,0), C0,0); \
    GAPB(o[1]=__builtin_amdgcn_mfma_f32_32x32x16_bf16(PAF(0),VFR(4),o[1],0,0,0), C0,4); \
    KRD(GL,0); GAPB(o[0]=__builtin_amdgcn_mfma_f32_32x32x16_bf16(PAF(1),VFR(1),o[0],0,0,0), C0,8); \
    KRD(GL,1); GAPB(o[1]=__builtin_amdgcn_mfma_f32_32x32x16_bf16(PAF(1),VFR(5),o[1],0,0,0), C0,12); \
    KRD(GL,2); GAPB(o[0]=__builtin_amdgcn_mfma_f32_32x32x16_bf16(PAF(2),VFR(2),o[0],0,0,0), C1,0); \
    KRD(GL,3); GAPB(o[1]=__builtin_amdgcn_mfma_f32_32x32x16_bf16(PAF(2),VFR(6),o[1],0,0,0), C1,4); \
    GAPB(o[0]=__builtin_amdgcn_mfma_f32_32x32x16_bf16(PAF(3),VFR(3),o[0],0,0,0), C1,8); \
    GAPB(o[1]=__builtin_amdgcn_mfma_f32_32x32x16_bf16(PAF(3),VFR(7),o[1],0,0,0), C1,12); \
    }while(0)
  int t=1;
  #undef CMASK
  #define CMASK(P0,P1,t) do{}while(0)
  for(;t+5<NT;t+=2){
    STEP(pB0,pB1,pA0,pA1,t,true,true,true);     WAIT_BAR(2); RESC(); ROT();
    STEP(pA0,pA1,pB0,pB1,t+1,true,true,true);   WAIT_BAR(2); RESC(); ROT();
  }
  #undef CMASK
  #define CMASK(P0,P1,t) do{int jb_=(t)-(NT-4); if(jb_>=0)cmask(P0,P1,jb_,qrel,hi);}while(0)
  #define ENDW(tt) do{ if((tt)+3<NT){WAIT_BAR(2);} else if((tt)+2<NT){WAIT_BAR(1);} else {WAIT_BAR(0);} }while(0)
  for(;t+1<NT;t+=2){
    STEP(pB0,pB1,pA0,pA1,t,(t+3<NT),(t+1<NT),(t+1<NT));       ENDW(t);   RESC(); ROT();
    STEP(pA0,pA1,pB0,pB1,t+1,(t+4<NT),(t+2<NT),(t+2<NT));     ENDW(t+1); RESC(); ROT();
  }
  STEP(pB0,pB1,pA0,pA1,NT-1,false,false,false); RESC();
  { float sacc=pB0[0]+pB0[1]; _Pragma("unroll") for(int r=2;r<16;++r)sacc+=pB0[r]; _Pragma("unroll") for(int r=0;r<16;++r)sacc+=pB1[r]; l_reg+=sacc;
    pw0=(u32x4){PKW(pB0,0),PKW(pB0,2),PKW(pB0,4),PKW(pB0,6)};pw1=(u32x4){PKW(pB0,8),PKW(pB0,10),PKW(pB0,12),PKW(pB0,14)};pw2=(u32x4){PKW(pB1,0),PKW(pB1,2),PKW(pB1,4),PKW(pB1,6)};pw3=(u32x4){PKW(pB1,8),PKW(pB1,10),PKW(pB1,12),PKW(pB1,14)};
    SBAR(); pv(o,vb0+sl_cur,PAF(0),PAF(1),PAF(2),PAF(3)); }
  #undef PKW
  #undef PAF
  #undef VFR
  #undef PIN
  #undef MX3
  #undef GAPA
  #undef GAPB
  #undef EX
  #undef VRD
  #undef KRD
  #undef STEP
  #undef ENDW
  {auto rr=__builtin_amdgcn_permlane32_swap(__float_as_uint(l_reg),__float_as_uint(l_reg),false,false);l_reg=__uint_as_float(rr[0])+__uint_as_float(rr[1]);}
  if(hi==0)wsf[32+r32]=l_reg;asm volatile("s_waitcnt lgkmcnt(0)":::"memory");
  float rli[16];
  #pragma unroll
  for(int r=0;r<16;++r)rli[r]=__builtin_amdgcn_rcpf(wsf[32+crow(r,hi)]);
  bf16*Ow=O+(rowbase+q0+wid*QBLK)*DMO+h*D;
  { bf16*stg=(bf16*)(shm+LDS_OST)+wid*2048;
    #pragma unroll
    for(int r=0;r<16;++r){const int orow=crow(r,hi);
      #pragma unroll
      for(int d0=0;d0<2;++d0)stg[orow*64+d0*32+r32]=__float2bfloat16(o[d0][r]*rli[r]);}
    asm volatile("s_waitcnt lgkmcnt(0)":::"memory");
    #pragma unroll
    for(int i=0;i<4;++i){const int row=i*8+(lane>>3),ch=lane&7; const u32x4 v=*(const u32x4*)(stg+row*64+ch*8); ATTN_STORE16(Ow+(long)row*DMO+ch*8,v);} }
  asm volatile("s_waitcnt lgkmcnt(0)\n\ts_barrier":::"memory");
  #undef DMA_K
  #undef DMA_V
  #undef CMASK
  #undef START
  #undef RESC
  #undef ROT
}
constexpr int ATTN_LDS_BYTES=LDS_BYTES;
#undef SBAR
#undef WAIT_BAR
}
#define LAS __attribute__((address_space(3)))
#define XB_TMO      128
#define XB_XCNT(j)  (256  + 64 * (j))
#define XB_XSUB(j)  (1280 + 64 * (j))
#define XB_XGEN(j)  (2304 + 64 * (j))
#define XB_TOP      3328
#define XB_TOPGEN   3392
#define XCD_BAR_WORDS 3456
#define XB_SPIN_CAP (1u << 18)

__device__ __forceinline__ unsigned xb_ld(unsigned* p)              { return __hip_atomic_load(p, __ATOMIC_RELAXED, __HIP_MEMORY_SCOPE_AGENT); }
__device__ __forceinline__ unsigned xb_add(unsigned* p, unsigned v) { return __hip_atomic_fetch_add(p, v, __ATOMIC_RELAXED, __HIP_MEMORY_SCOPE_AGENT); }
__device__ __forceinline__ unsigned xb_xcc_id() { return (unsigned)__builtin_amdgcn_s_getreg((3 << 11) | 20) & 0xFu; }
#define XB_SPIN(cond, bar) do { unsigned _sp = 0; while (cond) { __builtin_amdgcn_s_sleep(1); \
    if ((++_sp & 255u) == 0u) { if (xb_ld(&(bar)[XB_TMO])) break; if (_sp > XB_SPIN_CAP) { atomicAdd(&(bar)[XB_TMO], 1u); break; } } } } while (0)

struct XcdBarrier {
    unsigned* bar; unsigned x;
    volatile LAS unsigned* st;
};

__device__ __forceinline__ XcdBarrier xcd_barrier_post(unsigned* bar, volatile LAS unsigned* st) {
    XcdBarrier b; b.bar = bar; b.x = xb_xcc_id(); b.st = st;
    if (threadIdx.x == 0) (void)xb_add(&bar[XB_XCNT(b.x)], 1u);
    return b;
}
__device__ __forceinline__ void xcd_barrier_complete(unsigned* bar, unsigned x, unsigned& nloc, unsigned& nx) {
    const unsigned G = gridDim.x * gridDim.y * gridDim.z;
    unsigned sum, cnt, mine, sp = 0u;
    for (;;) {
        sum = 0u; cnt = 0u; mine = 0u;
#pragma unroll
        for (unsigned j = 0; j < 16; ++j) { const unsigned c = xb_ld(&bar[XB_XCNT(j)]); sum += c; cnt += (c > 0u) ? 1u : 0u; mine = (j == x) ? c : mine; }
        if (sum == G) break;
        __builtin_amdgcn_s_sleep(1);
        if ((++sp & 255u) == 0u) { if (xb_ld(&bar[XB_TMO])) break; if (sp > XB_SPIN_CAP) { atomicAdd(&bar[XB_TMO], 1u); break; } }
    }
    nloc = mine > 0u ? mine : 1u; nx = cnt > 0u ? cnt : 1u;
}

__device__ __forceinline__ void xcd_barrier(const XcdBarrier& b) {
    asm volatile("s_waitcnt vmcnt(0)" ::: "memory");
    __syncthreads();
    if (threadIdx.x == 0) {
        unsigned* bar = b.bar;
        __builtin_amdgcn_s_waitcnt(0);
        unsigned nloc = b.st[0], nx = b.st[1];
        if (nloc == 0u) { xcd_barrier_complete(bar, b.x, nloc, nx); b.st[0] = nloc; b.st[1] = nx; }
        const unsigned old = xb_add(&bar[XB_XSUB(b.x)], 1u);
        const unsigned gen = old / nloc;
        if (old + 1u == (gen + 1u) * nloc) {
            __builtin_amdgcn_fence(__ATOMIC_RELEASE, "agent");
            asm volatile("s_waitcnt vmcnt(0)" ::: "memory");
            const unsigned og = xb_add(&bar[XB_TOP], 1u);
            const unsigned tg = og / nx;
            if (og + 1u == (tg + 1u) * nx) xb_add(&bar[XB_TOPGEN], 1u);
            else XB_SPIN(xb_ld(&bar[XB_TOPGEN]) == tg, bar);
            __builtin_amdgcn_fence(__ATOMIC_ACQUIRE, "agent");
            xb_add(&bar[XB_XGEN(b.x)], 1u);
            asm volatile("s_waitcnt vmcnt(0)" ::: "memory");
        } else {
            XB_SPIN(xb_ld(&bar[XB_XGEN(b.x)]) == gen, bar);
            __builtin_amdgcn_fence(__ATOMIC_ACQUIRE, "agent");
            asm volatile("s_waitcnt vmcnt(0)" ::: "memory");
        }
    }
    __syncthreads();
}
typedef unsigned short bf16;
typedef unsigned v4u __attribute__((ext_vector_type(4)));
typedef unsigned v2u __attribute__((ext_vector_type(2)));
typedef float f32x4 __attribute__((ext_vector_type(4)));
typedef float f32x2 __attribute__((ext_vector_type(2)));
typedef short bf16x8 __attribute__((ext_vector_type(8)));

constexpr int NTOK = 32768, DMOD = 1024, SEQL = 16384, PW = 3328, DFF = 2816;
constexpr float ALPHA = 1.681792830507429f;
constexpr size_t MiB = 1u << 20;
constexpr size_t WS_WIN = 0, WS_WOUT = 7 * MiB, WS_WUP = 9 * MiB, WS_WDN = 20 * MiB, WS_WSP = 26 * MiB;
constexpr size_t WS_XN = 32 * MiB, WS_P = 96 * MiB, WS_GH = 304 * MiB, WS_CAT = 432 * MiB;
constexpr size_t WS_GATE = 96 * MiB, WS_VAL = 272 * MiB, WS_U = 96 * MiB, WS_V = 160 * MiB, WS_END = 496 * MiB;
constexpr int LDS_TOTAL = 147456;
constexpr size_t WS_CTL = 28 * MiB;
constexpr int NTHR = 512;

__device__ __forceinline__ float bflo(unsigned w) { return __uint_as_float(w << 16); }
__device__ __forceinline__ float bfhi(unsigned w) { return __uint_as_float(w & 0xffff0000u); }
__device__ __forceinline__ unsigned f2bf(float f) { unsigned u = __float_as_uint(f); return (u + 0x7fffu + ((u >> 16) & 1u)) >> 16; }
__device__ __forceinline__ unsigned pk2(float lo, float hi) { return f2bf(lo) | (f2bf(hi) << 16); }
__device__ __forceinline__ void unpack8(const v4u w, float* o) { o[0] = bflo(w.x); o[1] = bfhi(w.x); o[2] = bflo(w.y); o[3] = bfhi(w.y); o[4] = bflo(w.z); o[5] = bfhi(w.z); o[6] = bflo(w.w); o[7] = bfhi(w.w); }
__device__ __forceinline__ v4u pack8(const float* o) { v4u w; w.x = pk2(o[0], o[1]); w.y = pk2(o[2], o[3]); w.z = pk2(o[4], o[5]); w.w = pk2(o[6], o[7]); return w; }
__device__ __forceinline__ float wave_sum(float v) {
#pragma unroll
    for (int o = 1; o < 64; o <<= 1) v += __shfl_xor(v, o);
    return v;
}
__device__ __forceinline__ int opaque_tid() { int t = threadIdx.x; asm volatile("" : "+v"(t)); return t; }
#define TIDS const int tid = opaque_tid(), lane = tid & 63, wave = __builtin_amdgcn_readfirstlane(tid >> 6); (void)lane; (void)wave
#if defined(SEC_B)
#define SECT(n) do { if (tid == 0) { volatile unsigned long long* pa_ = (volatile unsigned long long*)((char*)sm + (LDS_TOTAL - 48)); \
    if ((n) == SEC_E || (n) == SEC_E2) pa_[0] += __builtin_amdgcn_s_memrealtime() - pa_[1]; if ((n) == SEC_B || (n) == SEC_B2) pa_[1] = __builtin_amdgcn_s_memrealtime(); } } while (0)
#else
#define SECT(n) do {} while (0)
#endif
__device__ __forceinline__ float sigmoidf_(float x) { return 1.f / (1.f + __expf(-x)); }
__device__ __forceinline__ float tanhf_(float x) { const float e = __expf(2.f * x); return 1.f - 2.f / (e + 1.f); }

template <bool GV = false  >
__device__ __forceinline__ void transpose_item(const float* W, int K, int N, bf16* WT, LAS float* scr, int item, int lane) {
    const int nblk = N / 32, kb = item / nblk, nb = item % nblk, k0 = 64 * kb, n0 = 32 * nb;
    const int half = N / 2, cg = GV ? (n0 >= half ? n0 - half : n0) : 0, r0 = GV ? ((cg >> 7) * 256 + (n0 >= half ? 128 : 0) + (cg & 127)) : n0;
#pragma unroll 8
    for (int i = 0; i < 32; ++i) { const int kk = 2 * i + (lane >> 5); scr[kk * 33 + (lane & 31)] = W[(size_t)(k0 + kk) * N + n0 + (lane & 31)]; }
    asm volatile("s_waitcnt lgkmcnt(0)" ::: "memory");
    const int c = lane & 7;
#pragma unroll
    for (int j = 0; j < 4; ++j) { const int n = (lane >> 3) + 8 * j; const LAS float* s = scr + (8 * c) * 33 + n;
        v4u o; o.x = pk2(s[0 * 33], s[1 * 33]); o.y = pk2(s[2 * 33], s[3 * 33]); o.z = pk2(s[4 * 33], s[5 * 33]); o.w = pk2(s[6 * 33], s[7 * 33]);
        *(v4u*)(WT + (size_t)(r0 + n) * K + k0 + 8 * c) = o; }
    asm volatile("s_waitcnt lgkmcnt(0)" ::: "memory");
}

constexpr int LD = 68, BUFF = 64 * LD;
__device__ __forceinline__ int mm_tm(int wave) { return wave < 4 ? (wave >> 1) : 3 - ((wave - 4) >> 1); }
struct KMin { const float* p; __device__ __forceinline__ f32x4 ld(int idx, int k) const { return *(const f32x4*)(p + idx * LD + k); } };
struct KMaj { const float* p; __device__ __forceinline__ f32x4 ld(int idx, int k) const { f32x4 v; v[0] = p[k * LD + idx]; v[1] = p[(k + 1) * LD + idx]; v[2] = p[(k + 2) * LD + idx]; v[3] = p[(k + 3) * LD + idx]; return v; } };
template <int KD, bool TRI  , class OA, class OB>
__device__ __forceinline__ void mm_acc_t(f32x4& c0, f32x4& c1, int wave, int lane, OA oa, OB ob) {
    const int tm = mm_tm(wave), tn0 = (wave & 1) * 2, li = lane & 15, lk = lane >> 4;
    const int kend = TRI ? 16 * (tm + 1) : KD;
    f32x4 a = oa.ld(tm * 16 + li, 4 * lk), b0 = ob.ld(tn0 * 16 + li, 4 * lk), b1 = ob.ld(tn0 * 16 + 16 + li, 4 * lk);
#pragma nounroll
    for (int kb = 0; kb < kend; kb += 16) {
        const int kn = ((kb + 16 < kend) ? kb + 16 : kb) + 4 * lk;
        const f32x4 an = oa.ld(tm * 16 + li, kn), b0n = ob.ld(tn0 * 16 + li, kn), b1n = ob.ld(tn0 * 16 + 16 + li, kn);
#pragma unroll
        for (int q = 0; q < 4; ++q) { c0 = __builtin_amdgcn_mfma_f32_16x16x4f32(a[q], b0[q], c0, 0, 0, 0); c1 = __builtin_amdgcn_mfma_f32_16x16x4f32(a[q], b1[q], c1, 0, 0, 0); }
        a = an; b0 = b0n; b1 = b1n;
    }
}
template <int KD, class OA, class OB>
__device__ __forceinline__ void mm_acc(f32x4& c0, f32x4& c1, int wave, int lane, OA oa, OB ob) { mm_acc_t<KD, false>(c0, c1, wave, lane, oa, ob); }
template <class FC>
__device__ __forceinline__ void mm_store(const f32x4& c0, const f32x4& c1, int wave, int lane, FC fc) {
    const int tm = mm_tm(wave), tn0 = (wave & 1) * 2, li = lane & 15, lk = lane >> 4;
#pragma unroll
    for (int r = 0; r < 4; ++r) { fc(tm * 16 + 4 * lk + r, tn0 * 16 + li, c0[r]); fc(tm * 16 + 4 * lk + r, tn0 * 16 + 16 + li, c1[r]); }
}

struct LsRaw { v4u cur, prv; };
__device__ __forceinline__ LsRaw ls_issue(const bf16* P, int tok0, int col0, bool seq_start, int tid) {
    const int row = tid >> 3, c8 = (tid & 7) * 8;
    const bf16* pr = P + (size_t)(tok0 + row) * PW + col0 + c8;
    LsRaw r; r.cur = *(const v4u*)pr; r.prv = (v4u){0u, 0u, 0u, 0u};
    if (!(seq_start && row == 0)) r.prv = *(const v4u*)(pr - PW);
    return r;
}
template <int ACT  >
__device__ __forceinline__ void ls_commit(float* dst, const LsRaw& r, const float* mu  , int tid) {
    const int row = tid >> 3, c8 = (tid & 7) * 8;
    float c[8], p[8]; unpack8(r.cur, c); unpack8(r.prv, p);
    const f32x4 m0 = *(const f32x4*)(mu + c8), m1 = *(const f32x4*)(mu + c8 + 4);
    const float m[8] = {m0[0], m0[1], m0[2], m0[3], m1[0], m1[1], m1[2], m1[3]};
    float x[8];
#pragma unroll
    for (int e = 0; e < 8; ++e) { x[e] = c[e] + m[e] * (p[e] - c[e]); if (ACT == 1) x[e] = tanhf_(x[e]); if (ACT == 2) x[e] = sigmoidf_(x[e]); }
    *(f32x4*)(dst + row * LD + c8) = (f32x4){x[0], x[1], x[2], x[3]}; *(f32x4*)(dst + row * LD + c8 + 4) = (f32x4){x[4], x[5], x[6], x[7]};
}
struct WRaw { f32x4 a, b; };
__device__ __forceinline__ WRaw w_issue(const float* W, int ldw, int row0, int col0, int tid) {
    const int row = tid >> 3, c8 = (tid & 7) * 8; const float* s = W + (size_t)(row0 + row) * ldw + col0 + c8;
    WRaw r; r.a = *(const f32x4*)s; r.b = *(const f32x4*)(s + 4); return r;
}
__device__ __forceinline__ void w_commit(float* dst, const WRaw& r, int tid) {
    const int row = tid >> 3, c8 = (tid & 7) * 8; *(f32x4*)(dst + row * LD + c8) = r.a; *(f32x4*)(dst + row * LD + c8 + 4) = r.b;
}
template <int K, class FA, class FB>
__device__ __forceinline__ f32x4 tile_mm(int lane, FA fa, FB fb) {
    const int li = lane & 15, lk = lane >> 4; f32x4 acc = {0.f, 0.f, 0.f, 0.f};
#pragma unroll
    for (int k0 = 0; k0 < K; k0 += 4) acc = __builtin_amdgcn_mfma_f32_16x16x4f32(fa(li, k0 + lk), fb(k0 + lk, li), acc, 0, 0, 0);
    return acc;
}
__device__ __forceinline__ void tri_inverse(float* T, const float* A, float* M, int tid, int wave, int lane) {
    for (int i = tid; i < 64 * LD; i += NTHR) T[i] = 0.f;
    __syncthreads();
    if (tid < 64) { const int d = tid >> 4, j = tid & 15; const float* Ad = A + (16 * d) * LD + 16 * d; float x[16];
#pragma unroll
        for (int t = 0; t < 16; ++t) { float acc = (t == j) ? 1.f : 0.f;
            f32x4 rw[4];
#pragma unroll
            for (int q4 = 0; q4 < 4; ++q4) if (4 * q4 < t) rw[q4] = *(const f32x4*)(Ad + t * LD + 4 * q4);
#pragma unroll
            for (int q = 0; q < t; ++q) acc += rw[q >> 2][q & 3] * x[q];
            x[t] = acc; asm volatile("" ::: "memory"); }
#pragma unroll
        for (int t = 0; t < 16; ++t) T[(16 * d + t) * LD + 16 * d + j] = x[t];
    }
    __syncthreads();
    const int li = lane & 15, lk = lane >> 4;
    if (wave < 2) { const int r0 = 16 * (2 * wave + 1), c0 = 16 * (2 * wave);
        const f32x4 acc = tile_mm<16>(lane, [=](int i, int k) { return A[(r0 + i) * LD + c0 + k]; }, [=](int k, int jj) { return T[(c0 + k) * LD + c0 + jj]; });
#pragma unroll
        for (int r = 0; r < 4; ++r) M[(r0 + 4 * lk + r) * LD + c0 + li] = acc[r]; }
    __syncthreads();
    if (wave < 2) { const int r0 = 16 * (2 * wave + 1), c0 = 16 * (2 * wave);
        const f32x4 acc = tile_mm<16>(lane, [=](int i, int k) { return T[(r0 + i) * LD + r0 + k]; }, [=](int k, int jj) { return M[(r0 + k) * LD + c0 + jj]; });
#pragma unroll
        for (int r = 0; r < 4; ++r) T[(r0 + 4 * lk + r) * LD + c0 + li] = acc[r]; }
    __syncthreads();
    if (wave < 4) { const int r0 = 32 + 16 * (wave >> 1), c0 = 16 * (wave & 1);
        const f32x4 acc = tile_mm<32>(lane, [=](int i, int k) { return A[(r0 + i) * LD + k]; }, [=](int k, int jj) { return T[k * LD + c0 + jj]; });
#pragma unroll
        for (int r = 0; r < 4; ++r) M[(r0 + 4 * lk + r) * LD + c0 + li] = acc[r]; }
    __syncthreads();
    if (wave < 4) { const int r0 = 32 + 16 * (wave >> 1), c0 = 16 * (wave & 1);
        const f32x4 acc = tile_mm<32>(lane, [=](int i, int k) { return T[(r0 + i) * LD + 32 + k]; }, [=](int k, int jj) { return M[(32 + k) * LD + c0 + jj]; });
#pragma unroll
        for (int r = 0; r < 4; ++r) T[(r0 + 4 * lk + r) * LD + c0 + li] = acc[r]; }
    __syncthreads();
}

struct RwkvW { const float *mu, *w0, *w2, *a0, *a2, *g2, *kk, *ka, *rk, *lg, *lb; };

constexpr int PK = 0, PV = 64, PXW = 128, PXA = 192, PR = 256, PXG = 320, PW0 = 448, PA0 = 512, PKK = 576, PKA = 640, PRK = 704, PLG = 768, PLB = 832, PAR_OFF = 8 * BUFF + 640;
__device__ __forceinline__ void stage_params(float* par, const RwkvW& w, int h, int tid) {
    const int seg = tid >> 6, l = tid & 63;
    const float* s1 = seg == 0 ? w.mu + 512 + h * 64 : seg == 1 ? w.mu + 1024 + h * 64 : seg == 2 ? w.mu + 1536 : seg == 3 ? w.mu + 1600 : seg == 4 ? w.mu + h * 64 : seg == 5 ? w.mu + 1664 : seg == 6 ? w.mu + 1728 : w.w0 + h * 64;
    par[seg * 64 + l] = s1[l];
    if (seg < 6) { const float* s2 = (seg == 0 ? w.a0 : seg == 1 ? w.kk : seg == 2 ? w.ka : seg == 3 ? w.rk : seg == 4 ? w.lg : w.lb) + h * 64; par[(8 + seg) * 64 + l] = s2[l]; }
}
template <bool WITH_R>
__device__ __forceinline__ unsigned rwkv_front(float* sm, const bf16* P, const RwkvW& w, int tok0, int h, bool ss, bool has_next, int tid, int wave, int lane) {
    float *B0 = sm, *B1 = sm + BUFF, *B2 = sm + 2 * BUFF, *B3 = sm + 3 * BUFF, *B4 = sm + 4 * BUFF, *B5 = sm + 5 * BUFF, *B6 = sm + 6 * BUFF, *B7 = sm + 7 * BUFF;
    float* part = sm + 8 * BUFF; float* bon = part + 512 + 64; const float* par = sm + PAR_OFF;
    unsigned touch = 0u;
    {
        const LsRaw rk = ls_issue(P, tok0, 512 + h * 64, ss, tid), rv = ls_issue(P, tok0, 1024 + h * 64, ss, tid), rxw = ls_issue(P, tok0, 1536, ss, tid), rxa = ls_issue(P, tok0, 1600, ss, tid);
        const WRaw ww = w_issue(w.w2, 512, 0, h * 64, tid), wa = w_issue(w.a2, 512, 0, h * 64, tid);
        if (has_next) { const int blk = tid & 7; const int col = blk == 0 ? 512 + h * 64 : blk == 1 ? 1024 + h * 64 : blk == 2 ? 1536 : blk == 3 ? 1600 : blk == 4 ? h * 64 : blk == 5 ? 1664 : blk == 6 ? 1728 : 1536;
            touch = *(const unsigned*)(P + (size_t)(tok0 + 64 + (tid >> 3)) * PW + col); }
        ls_commit<0>(B0, rk, par + PK, tid); ls_commit<0>(B1, rv, par + PV, tid); ls_commit<1>(B2, rxw, par + PXW, tid); ls_commit<0>(B3, rxa, par + PXA, tid);
        w_commit(B4, ww, tid); w_commit(B5, wa, tid);
    }
    LsRaw rr; if (WITH_R) rr = ls_issue(P, tok0, h * 64, ss, tid);
    __syncthreads();
    SECT(20);
    { f32x4 c0 = {0.f, 0.f, 0.f, 0.f}, c1 = c0; mm_acc<64>(c0, c1, wave, lane, KMin{B2}, KMaj{B4});
      mm_store(c0, c1, wave, lane, [=](int r, int c, float v) { const float wi = v + par[PW0 + c]; const float z = -wi; const float sp = fmaxf(z, 0.f) + __logf(1.f + __expf(-fabsf(z))); B6[r * LD + c] = -__expf(-sp - 0.5f); }); }
    { f32x4 c0 = {0.f, 0.f, 0.f, 0.f}, c1 = c0; mm_acc<64>(c0, c1, wave, lane, KMin{B3}, KMaj{B5});
      mm_store(c0, c1, wave, lane, [=](int r, int c, float v) { B7[r * LD + c] = sigmoidf_(v + par[PA0 + c]); }); }
    __syncthreads();
    SECT(21);
    if (WITH_R) ls_commit<0>(B4, rr, par + PR, tid);
    {
        const int row = tid >> 3, c8 = (tid & 7) * 8;
        float kx[8], kkv[8]; float ssq = 0.f;
#pragma unroll
        for (int e = 0; e < 8; ++e) { kx[e] = B0[row * LD + c8 + e]; kkv[e] = kx[e] * par[PKK + c8 + e]; ssq += kkv[e] * kkv[e]; }
        ssq += __shfl_xor(ssq, 1); ssq += __shfl_xor(ssq, 2); ssq += __shfl_xor(ssq, 4);
        const float inv = 1.f / fmaxf(sqrtf(ssq), 1e-12f);
        float bsum = 0.f;
#pragma unroll
        for (int e = 0; e < 8; ++e) { const float al = B7[row * LD + c8 + e]; const float kn = kkv[e] * inv; const float kad = kx[e] * (1.f + (al - 1.f) * par[PKA + c8 + e]);
            B2[row * LD + c8 + e] = -kn; B3[row * LD + c8 + e] = kn * al; B0[row * LD + c8 + e] = kad;
            if (WITH_R) bsum += B4[row * LD + c8 + e] * kad * par[PRK + c8 + e]; }
        if (WITH_R) { bsum += __shfl_xor(bsum, 1); bsum += __shfl_xor(bsum, 2); bsum += __shfl_xor(bsum, 4); if ((tid & 7) == 0) bon[row] = bsum; }
    }
    {
        const int ch = tid & 63, seg = tid >> 6; float s = 0.f;
#pragma unroll
        for (int i = 0; i < 8; ++i) s += B6[(seg * 8 + i) * LD + ch];
        part[seg * 64 + ch] = s;
    }
    __syncthreads();
    {   const int ch = tid & 63, seg = tid >> 6; float cex = 0.f;
        for (int s = 0; s < seg; ++s) cex += part[s * 64 + ch];
#pragma unroll
        for (int i = 0; i < 8; ++i) { const int t = seg * 8 + i; const float lw = B6[t * LD + ch]; B2[t * LD + ch] *= __expf(cex); cex += lw; B6[t * LD + ch] = cex; }
    }
    __syncthreads();
    return touch;
}

__device__ __forceinline__ void rwkv_phase1(float* sm, const bf16* P, const RwkvW& w, float* GH, int bx, int G) {
    float *B0 = sm, *B1 = sm + BUFF, *B2 = sm + 2 * BUFF, *B3 = sm + 3 * BUFF, *B4 = sm + 4 * BUFF, *B5 = sm + 5 * BUFF, *B6 = sm + 6 * BUFF, *B7 = sm + 7 * BUFF;
    float* gl = sm + 8 * BUFF + 512;
    int hprev = -1;
    for (int unit = (4096 * bx) / G, uend = (4096 * (bx + 1)) / G; unit < uend; ++unit) {
        TIDS;
        const int bh = unit >> 8, c = unit & 255, b = bh >> 3, h = bh & 7, tok0 = b * SEQL + c * 64;
        if (h != hprev) { __syncthreads(); stage_params(sm + PAR_OFF, w, h, tid); hprev = h; }
        __syncthreads();
        SECT(10);
        const unsigned touch = rwkv_front<false>(sm, P, w, tok0, h, c == 0, (c != 255) && (unit + 1 < uend), tid, wave, lane);
        SECT(11);
        for (int idx = tid; idx < 4096; idx += NTHR) { const int t = idx >> 6, ch = idx & 63; const float cu = B6[t * LD + ch], cl = B6[63 * LD + ch];
            const float em = __expf(-cu), eh = __expf(cl - cu), bv = B3[t * LD + ch], kv = B0[t * LD + ch];
            B4[t * LD + ch] = bv * em; B5[t * LD + ch] = kv * em; B3[t * LD + ch] = bv * eh; B0[t * LD + ch] = kv * eh; }
        if (tid < 64) gl[tid] = __expf(B6[63 * LD + tid]);
        __syncthreads();
        { f32x4 c0 = {0.f, 0.f, 0.f, 0.f}, c1 = c0; mm_acc<64>(c0, c1, wave, lane, KMin{B2}, KMin{B4}); mm_store(c0, c1, wave, lane, [=](int r, int cc, float v) { B7[r * LD + cc] = (cc < r) ? v : 0.f; }); }
        { f32x4 c0 = {0.f, 0.f, 0.f, 0.f}, c1 = c0; mm_acc<64>(c0, c1, wave, lane, KMin{B2}, KMin{B5}); mm_store(c0, c1, wave, lane, [=](int r, int cc, float v) { B6[r * LD + cc] = (cc < r) ? v : 0.f; }); }
        __syncthreads();
        { f32x4 c0 = {0.f, 0.f, 0.f, 0.f}, c1 = c0; mm_acc_t<64, true>(c0, c1, wave, lane, KMin{B6}, KMaj{B1}); mm_store(c0, c1, wave, lane, [=](int r, int cc, float v) { B4[r * LD + cc] = v; }); }
        SECT(12);
        tri_inverse(B5, B7, B6, tid, wave, lane);
        SECT(13);
        { f32x4 c0 = {0.f, 0.f, 0.f, 0.f}, c1 = c0; mm_acc_t<64, true>(c0, c1, wave, lane, KMin{B5}, KMaj{B2}); mm_store(c0, c1, wave, lane, [=](int r, int cc, float v) { B6[r * LD + cc] = v; }); }
        { f32x4 c0 = {0.f, 0.f, 0.f, 0.f}, c1 = c0; mm_acc_t<64, true>(c0, c1, wave, lane, KMin{B5}, KMaj{B4}); mm_store(c0, c1, wave, lane, [=](int r, int cc, float v) { B7[r * LD + cc] = v; }); }
        __syncthreads();
        float* Gg = GH + (size_t)unit * 8192; float* Hg = Gg + 4096;
        { f32x4 c0 = {0.f, 0.f, 0.f, 0.f}, c1 = c0; mm_acc<64>(c0, c1, wave, lane, KMaj{B6}, KMaj{B3}); mm_store(c0, c1, wave, lane, [=](int r, int cc, float v) { Gg[r * 64 + cc] = v + ((r == cc) ? gl[r] : 0.f); }); }
        { f32x4 c0 = {0.f, 0.f, 0.f, 0.f}, c1 = c0; mm_acc<64>(c0, c1, wave, lane, KMaj{B7}, KMaj{B3}); mm_acc<64>(c0, c1, wave, lane, KMaj{B1}, KMaj{B0}); mm_store(c0, c1, wave, lane, [=](int r, int cc, float v) { Hg[r * 64 + cc] = v; }); }
        SECT(14);
        asm volatile("" :: "v"(touch));
    }
}

__device__ __forceinline__ void rwkv_phase2(float* sm, float* GH, int wg) {
    TIDS;
    const int bh = wg >> 2, rb = wg & 3;
    float* Ss = sm; float* Gs = sm + 16 * LD; float* Hs = Gs + 64 * LD;
    for (int i = tid; i < 16 * LD; i += NTHR) Ss[i] = 0.f;
    float* base = GH + (size_t)(bh * 256) * 8192;
    const int grow = tid >> 3, gc8 = (tid & 7) * 8, hrow = tid >> 5, hc2 = (tid & 31) * 2;
    const size_t goff = (size_t)grow * 64 + gc8, hoff = 4096 + (size_t)(rb * 16 + hrow) * 64 + hc2;
    f32x4 ga[4], gb[4]; f32x2 hv[4];
#pragma unroll
    for (int i = 0; i < 4; ++i) { const float* u = base + (size_t)i * 8192; ga[i] = *(const f32x4*)(u + goff); gb[i] = *(const f32x4*)(u + goff + 4); hv[i] = *(const f32x2*)(u + hoff); }
    const int li = lane & 15, lk = lane >> 4;
    for (int c4 = 0; c4 < 256; c4 += 4) {
#pragma unroll
        for (int i = 0; i < 4; ++i) {
            const int c = c4 + i;
            *(f32x4*)(Gs + grow * LD + gc8) = ga[i]; *(f32x4*)(Gs + grow * LD + gc8 + 4) = gb[i]; *(f32x2*)(Hs + hrow * LD + hc2) = hv[i];
            __syncthreads();
            float* u = base + (size_t)c * 8192;
            if (c + 4 < 256) { const float* un = u + (size_t)4 * 8192; ga[i] = *(const f32x4*)(un + goff); gb[i] = *(const f32x4*)(un + goff + 4); hv[i] = *(const f32x2*)(un + hoff); }
            *(f32x2*)(u + hoff) = *(const f32x2*)(Ss + hrow * LD + hc2);
            f32x4 acc = {0.f, 0.f, 0.f, 0.f};
            if (wave < 4) {
#pragma unroll
                for (int r = 0; r < 4; ++r) acc[r] = Hs[(4 * lk + r) * LD + 16 * wave + li];
#pragma unroll 4
                for (int k0 = 0; k0 < 64; k0 += 4) acc = __builtin_amdgcn_mfma_f32_16x16x4f32(Ss[li * LD + k0 + lk], Gs[(k0 + lk) * LD + 16 * wave + li], acc, 0, 0, 0);
            }
            __syncthreads();
            if (wave < 4) {
#pragma unroll
                for (int r = 0; r < 4; ++r) Ss[(4 * lk + r) * LD + 16 * wave + li] = acc[r];
            }
        }
    }
    __syncthreads();
}

__device__ __forceinline__ void rwkv_phase3(float* sm, const bf16* P, const RwkvW& w, const float* GH, bf16* CAT, int bx, int G) {
    float *B0 = sm, *B1 = sm + BUFF, *B2 = sm + 2 * BUFF, *B3 = sm + 3 * BUFF, *B4 = sm + 4 * BUFF, *B5 = sm + 5 * BUFF, *B6 = sm + 6 * BUFF, *B7 = sm + 7 * BUFF;
    float* bon = sm + 8 * BUFF + 512 + 64;
    int hprev = -1;
    for (int unit = (4096 * bx) / G, uend = (4096 * (bx + 1)) / G; unit < uend; ++unit) {
        TIDS;
        const int bh = unit >> 8, c = unit & 255, b = bh >> 3, h = bh & 7, tok0 = b * SEQL + c * 64; const bool ss = (c == 0);
        if (h != hprev) { __syncthreads(); stage_params(sm + PAR_OFF, w, h, tid); hprev = h; }
        __syncthreads();
        SECT(0);
        const unsigned touch = rwkv_front<true>(sm, P, w, tok0, h, ss, (c != 255) && (unit + 1 < uend), tid, wave, lane);
        SECT(1);
        const WRaw s0raw = w_issue(GH + (size_t)unit * 8192 + 4096, 64, 0, 0, tid);
        const LsRaw xg0 = ls_issue(P, tok0, 1664, ss, tid), xg1 = ls_issue(P, tok0, 1728, ss, tid);
        const WRaw g2a = w_issue(w.g2, 512, 0, h * 64, tid), g2b = w_issue(w.g2, 512, 64, h * 64, tid);
        for (int idx = tid; idx < 4096; idx += NTHR) { const int t = idx >> 6, ch = idx & 63; const float cu = B6[t * LD + ch]; const float em = __expf(-cu);
            B5[t * LD + ch] = B3[t * LD + ch] * em; B0[t * LD + ch] *= em; B4[t * LD + ch] *= __expf(cu); }
        __syncthreads();
        { f32x4 c0 = {0.f, 0.f, 0.f, 0.f}, c1 = c0; mm_acc<64>(c0, c1, wave, lane, KMin{B2}, KMin{B5}); mm_store(c0, c1, wave, lane, [=](int r, int cc, float v) { B3[r * LD + cc] = (cc < r) ? v : 0.f; }); }
        { f32x4 c0 = {0.f, 0.f, 0.f, 0.f}, c1 = c0; mm_acc<64>(c0, c1, wave, lane, KMin{B2}, KMin{B0}); mm_store(c0, c1, wave, lane, [=](int r, int cc, float v) { B6[r * LD + cc] = (cc < r) ? v : 0.f; }); }
        { f32x4 c0 = {0.f, 0.f, 0.f, 0.f}, c1 = c0; mm_acc<64>(c0, c1, wave, lane, KMin{B4}, KMin{B5}); mm_store(c0, c1, wave, lane, [=](int r, int cc, float v) { B7[r * LD + cc] = (cc <= r) ? v : 0.f; }); }
        __syncthreads();
        { f32x4 c0 = {0.f, 0.f, 0.f, 0.f}, c1 = c0; mm_acc<64>(c0, c1, wave, lane, KMin{B4}, KMin{B0}); mm_store(c0, c1, wave, lane, [=](int r, int cc, float v) { B5[r * LD + cc] = (cc <= r) ? v : 0.f; }); }
        __syncthreads();
        SECT(2);
        w_commit(B0, s0raw, tid);
        __syncthreads();
        { f32x4 c0 = {0.f, 0.f, 0.f, 0.f}, c1 = c0; mm_acc<64>(c0, c1, wave, lane, KMin{B2}, KMin{B0}); mm_acc_t<64, true>(c0, c1, wave, lane, KMin{B6}, KMaj{B1}); __syncthreads();
          mm_store(c0, c1, wave, lane, [=](int r, int cc, float v) { B2[r * LD + cc] = v; }); }
        __syncthreads();
        SECT(3);
        f32x4 y0 = {0.f, 0.f, 0.f, 0.f}, y1 = y0;
        mm_acc<64>(y0, y1, wave, lane, KMin{B4}, KMin{B0}); mm_acc_t<64, true>(y0, y1, wave, lane, KMin{B5}, KMaj{B1});
        SECT(4);
        tri_inverse(B6, B3, B0, tid, wave, lane);
        SECT(5);
        { f32x4 c0 = {0.f, 0.f, 0.f, 0.f}, c1 = c0; mm_acc_t<64, true>(c0, c1, wave, lane, KMin{B6}, KMaj{B2}); mm_store(c0, c1, wave, lane, [=](int r, int cc, float v) { B4[r * LD + cc] = v; }); }
        __syncthreads();
        mm_acc_t<64, true>(y0, y1, wave, lane, KMin{B7}, KMaj{B4});
        ls_commit<2>(B3, xg0, sm + PAR_OFF + PXG, tid); ls_commit<2>(B5, xg1, sm + PAR_OFF + PXG + 64, tid); w_commit(B0, g2a, tid); w_commit(B2, g2b, tid);
        mm_store(y0, y1, wave, lane, [=](int r, int cc, float v) { B6[r * LD + cc] = v; });
        __syncthreads();
        { f32x4 c0 = {0.f, 0.f, 0.f, 0.f}, c1 = c0; mm_acc<64>(c0, c1, wave, lane, KMin{B3}, KMaj{B0}); mm_acc<64>(c0, c1, wave, lane, KMin{B5}, KMaj{B2});
        SECT(6);
          mm_store(c0, c1, wave, lane, [=](int r, int cc, float v) { B4[r * LD + cc] = v; }); }
        __syncthreads();
        {   const int row = tid >> 3, c8 = (tid & 7) * 8; float y[8], s = 0.f;
#pragma unroll
            for (int e = 0; e < 8; ++e) { y[e] = B6[row * LD + c8 + e]; s += y[e]; }
            s += __shfl_xor(s, 1); s += __shfl_xor(s, 2); s += __shfl_xor(s, 4);
            const float mu = s * (1.f / 64.f); float q = 0.f;
#pragma unroll
            for (int e = 0; e < 8; ++e) { y[e] -= mu; q += y[e] * y[e]; }
            q += __shfl_xor(q, 1); q += __shfl_xor(q, 2); q += __shfl_xor(q, 4);
            const float rs = 1.f / sqrtf(q * (1.f / 64.f) + 64e-5f); const float bn = bon[row];
            float o[8];
#pragma unroll
            for (int e = 0; e < 8; ++e) { const float yn = y[e] * rs * sm[PAR_OFF + PLG + c8 + e] + sm[PAR_OFF + PLB + c8 + e]; o[e] = (yn + bn * B1[row * LD + c8 + e]) * B4[row * LD + c8 + e]; }
            *(v4u*)(CAT + (size_t)(tok0 + row) * 1024 + h * 64 + c8) = pack8(o);
        }
        SECT(7);
        asm volatile("" :: "v"(touch));
    }
}

__device__ __forceinline__ void phase_rope(bf16* P, int bx, int G) {
    TIDS;
    constexpr float INVF[8] = {1.0f, 0.1939227432012558f, 0.03760603070259094f, 0.007292664609849453f, 0.0014142135623842478f, 0.00027424818836152554f, 5.318296098266728e-05f, 1.0313386155758053e-05f};
    for (int it = bx * NTHR + tid; it < NTOK * 16; it += G * NTHR) {
        const int tok = it >> 4, hh = it & 15, s = tok & (SEQL - 1);
        bf16* p = P + (size_t)tok * PW + 1792 + hh * 64;
        float x1[8], x2[8]; unpack8(*(const v4u*)p, x1); unpack8(*(const v4u*)(p + 8), x2);
        const float sc = (hh < 8) ? attn_body::C2 : 1.f;
        float o1[8], o2[8];
#pragma unroll
        for (int d = 0; d < 8; ++d) { const float ang = (float)s * INVF[d]; double rev = (double)ang * 0.15915494309189535; rev -= rint(rev); const float fr = (float)rev;
            const float sn = __builtin_amdgcn_sinf(fr), cs = __builtin_amdgcn_cosf(fr);
            o1[d] = (x1[d] * cs - x2[d] * sn) * sc; o2[d] = (x1[d] * sn + x2[d] * cs) * sc; }
        *(v4u*)p = pack8(o1); *(v4u*)(p + 8) = pack8(o2);
        if (hh < 8) {
#pragma unroll
            for (int q = 2; q < 8; ++q) { float x[8]; unpack8(*(const v4u*)(p + 8 * q), x);
#pragma unroll
                for (int e = 0; e < 8; ++e) x[e] *= sc;
                *(v4u*)(p + 8 * q) = pack8(x); }
        }
    }
}

__device__ __forceinline__ void phase_attn_post(const bf16* OB, bf16* CAT, const float* q1, const float* k1, const float* q2, const float* k2, const float* sg, float lam_init, int bx, int G) {
    TIDS; const int gw = bx * 8 + wave, NGW = G * 8;
    const float d1 = wave_sum(q1[lane] * k1[lane]), d2 = wave_sum(q2[lane] * k2[lane]);
    const float lam = expf(d1) - expf(d2) + lam_init;
    const int h = lane >> 4, d0 = (lane & 15) * 8, vhalf = d0 >> 6, dd = d0 & 63;
    float g[8];
#pragma unroll
    for (int e = 0; e < 8; ++e) g[e] = sg[d0 + e] * (1.f - lam_init);
    for (int tok = gw; tok < NTOK; tok += NGW) {
        const bf16* r = OB + (size_t)tok * 1024;
        float a[8], b[8]; unpack8(*(const v4u*)(r + ((h * 2 + 0) * 2 + vhalf) * 64 + dd), a); unpack8(*(const v4u*)(r + ((h * 2 + 1) * 2 + vhalf) * 64 + dd), b);
        float o[8], q = 0.f;
#pragma unroll
        for (int e = 0; e < 8; ++e) { o[e] = a[e] - lam * b[e]; q += o[e] * o[e]; }
        q += __shfl_xor(q, 1); q += __shfl_xor(q, 2); q += __shfl_xor(q, 4); q += __shfl_xor(q, 8);
        const float rs = 1.f / sqrtf(q * (1.f / 128.f) + 1e-5f);
#pragma unroll
        for (int e = 0; e < 8; ++e) o[e] = o[e] * rs * g[e];
        *(v4u*)(CAT + (size_t)tok * 1024 + 512 + h * 128 + d0) = pack8(o);
    }
}

__device__ __forceinline__ void phase_ln(float* X, bf16* XN, const float* g, const float* b, int bx, int G) {
    TIDS; const int gw = bx * 8 + wave, NGW = G * 8;
    for (int m = gw; m < NTOK; m += NGW) {
        f32x4* xr = (f32x4*)(X + (size_t)m * 1024) + lane;
        f32x4 v[4]; float s = 0.f;
#pragma unroll
        for (int j = 0; j < 4; ++j) { v[j] = xr[64 * j]; s += (v[j][0] + v[j][1]) + (v[j][2] + v[j][3]); }
        const float mean = wave_sum(s) * (1.f / 1024.f); float s2 = 0.f;
#pragma unroll
        for (int j = 0; j < 4; ++j) { v[j] = v[j] - mean; s2 += (v[j][0] * v[j][0] + v[j][1] * v[j][1]) + (v[j][2] * v[j][2] + v[j][3] * v[j][3]); }
        const float rstd = 1.f / sqrtf(wave_sum(s2) * (1.f / 1024.f) + 1e-5f);
        v2u* o8 = (v2u*)(XN + (size_t)m * 1024) + lane;
#pragma unroll
        for (int j = 0; j < 4; ++j) { const f32x4 gg = *(const f32x4*)(g + 4 * lane + 256 * j), bb = *(const f32x4*)(b + 4 * lane + 256 * j);
            const f32x4 o = v[j] * rstd * gg + bb; xr[64 * j] = o; v2u w; w.x = pk2(o[0], o[1]); w.y = pk2(o[2], o[3]); o8[64 * j] = w; }
    }
}
__device__ __forceinline__ void phase_lnv(bf16* V, const float* g, const float* b, int bx, int G) {
    TIDS; const int gw = bx * 8 + wave, NGW = G * 8;
    for (int m = gw; m < NTOK; m += NGW) {
        bf16* r = V + (size_t)m * 1024;
        float x[16]; unpack8(*(const v4u*)(r + lane * 8), x); unpack8(*(const v4u*)(r + 512 + lane * 8), x + 8);
        float s = 0.f;
#pragma unroll
        for (int e = 0; e < 16; ++e) s += x[e];
        const float mean = wave_sum(s) * (1.f / 1024.f); float s2 = 0.f;
#pragma unroll
        for (int e = 0; e < 16; ++e) { x[e] -= mean; s2 += x[e] * x[e]; }
        const float rstd = 1.f / sqrtf(wave_sum(s2) * (1.f / 1024.f) + 1e-5f);
#pragma unroll
        for (int e = 0; e < 16; ++e) { const int col = (e < 8) ? lane * 8 + e : 512 + lane * 8 + (e - 8); x[e] = x[e] * rstd * g[col] + b[col]; }
        *(v4u*)(r + lane * 8) = pack8(x); *(v4u*)(r + 512 + lane * 8) = pack8(x + 8);
    }
}

__device__ __forceinline__ void phase_conv(const bf16* GATE, bf16* VAL, const float* cw, const float* cb, int bx, int G) {
    TIDS;
    constexpr int NCG = DFF / 8, NIT = (NTOK / 64) * 2 * NCG;
    for (int it = bx * NTHR + tid; it < NIT; it += G * NTHR) {
        const int rr = it / NCG, c0 = (it % NCG) * 8, t = (rr >> 1) * 64 + (rr & 1), s = t & (SEQL - 1);
        float gg[8], g1[8], g2[8], vv[8], o[8];
        const size_t off = (size_t)t * DFF + c0;
        unpack8(*(const v4u*)(GATE + off), gg); unpack8(*(const v4u*)(VAL + off), vv);
        if (s >= 1) unpack8(*(const v4u*)(GATE + off - DFF), g1); else {
#pragma unroll
            for (int e = 0; e < 8; ++e) g1[e] = 0.f; }
        if (s >= 2) unpack8(*(const v4u*)(GATE + off - 2 * DFF), g2); else {
#pragma unroll
            for (int e = 0; e < 8; ++e) g2[e] = 0.f; }
#pragma unroll
        for (int e = 0; e < 8; ++e) { const float cv = cb[c0 + e] + cw[c0 + e] * g2[e] + cw[DFF + c0 + e] * g1[e] + cw[2 * DFF + c0 + e] * gg[e]; o[e] = cv * sigmoidf_(cv) * vv[e]; }
        *(v4u*)(VAL + off) = pack8(o);
    }
}

__device__ __forceinline__ void phase_mix(unsigned char* ldsb, bf16* U, const bf16* V, const bf16* WSP, const float* bs, int bx, int G) {
    TIDS;
    bf16* Vt = (bf16*)ldsb;
    for (int unit = bx; unit < 2048; unit += G) {
        const int cidx = unit >> 3, g = unit & 7, tok0 = cidx * 128;
        __syncthreads();
        {   const int s = tid >> 2, q = tid & 3;
#pragma unroll
            for (int i = 0; i < 4; ++i) { const v4u w = *(const v4u*)(V + (size_t)(tok0 + s) * 1024 + g * 128 + q * 32 + i * 8); const int d0 = q * 32 + i * 8;
                Vt[(d0 + 0) * 136 + s] = (bf16)(w.x & 0xffffu); Vt[(d0 + 1) * 136 + s] = (bf16)(w.x >> 16); Vt[(d0 + 2) * 136 + s] = (bf16)(w.y & 0xffffu); Vt[(d0 + 3) * 136 + s] = (bf16)(w.y >> 16);
                Vt[(d0 + 4) * 136 + s] = (bf16)(w.z & 0xffffu); Vt[(d0 + 5) * 136 + s] = (bf16)(w.z >> 16); Vt[(d0 + 6) * 136 + s] = (bf16)(w.w & 0xffffu); Vt[(d0 + 7) * 136 + s] = (bf16)(w.w >> 16); }
        }
        __syncthreads();
        f32x4 acc[8];
#pragma unroll
        for (int tn = 0; tn < 8; ++tn) acc[tn] = (f32x4){0.f, 0.f, 0.f, 0.f};
        const int li = lane & 15, lk = lane >> 4, nks = (16 * wave + 15) / 32 + 1;
        for (int ks = 0; ks < nks; ++ks) {
            const bf16x8 a = *(const bf16x8*)(WSP + (size_t)g * 16384 + (16 * wave + li) * 128 + ks * 32 + lk * 8);
#pragma unroll
            for (int tn = 0; tn < 8; ++tn) { const bf16x8 bq = *(const bf16x8*)(Vt + (16 * tn + li) * 136 + ks * 32 + lk * 8); acc[tn] = __builtin_amdgcn_mfma_f32_16x16x32_bf16(a, bq, acc[tn], 0, 0, 0); }
        }
#pragma unroll
        for (int r = 0; r < 4; ++r) { const int t = 16 * wave + 4 * lk + r; const float bias = bs[g * 128 + t];
#pragma unroll
            for (int tn = 0; tn < 8; ++tn) { bf16* up = U + (size_t)(tok0 + t) * 1024 + g * 128 + 16 * tn + li; const float u = __uint_as_float(((unsigned)*up) << 16); *up = (bf16)f2bf(u * (acc[tn][r] + bias)); } }
    }
}

#ifndef PHASE_SEL
#define PHASE_SEL 0xffffffffu
#endif
#define ON(k) (((PHASE_SEL) >> (k)) & 1u)
struct Args { const float* in[34]; float* out; unsigned char* ws; };

__global__ void __launch_bounds__(NTHR, 2) mega_fwd(Args a) {
    extern __shared__ __attribute__((aligned(16))) unsigned char lds[];
    cg::grid_group grid = cg::this_grid();
    const int G = gridDim.x, bx = blockIdx.x;
    unsigned* barw = (unsigned*)(a.ws + WS_CTL);
    volatile LAS unsigned* bst = (volatile LAS unsigned*)((LAS unsigned char*)lds + (LDS_TOTAL - 16));
    if (threadIdx.x < 2) bst[threadIdx.x] = 0u;
#if defined(SEC_B)
    if (threadIdx.x == 0) { volatile unsigned long long* pa_ = (volatile unsigned long long*)((char*)lds + (LDS_TOTAL - 48)); pa_[0] = 0ull; pa_[1] = 0ull; }
#endif
    if (bx == 0) for (int i = threadIdx.x; i < 4096 + 512; i += NTHR) barw[i] = 0u;
    __threadfence();
    grid.sync();
    const XcdBarrier xbar = xcd_barrier_post(barw, bst);
#ifdef PROBE_MASK
    unsigned long long tacc = 0, tmark = 0;
#define PB(k) do { if ((PROBE_MASK >> (k)) & 1u) tmark = __builtin_amdgcn_s_memrealtime(); } while (0)
#define PE(k) do { if ((PROBE_MASK >> (k)) & 1u) tacc += __builtin_amdgcn_s_memrealtime() - tmark; } while (0)
#else
#define PB(k) do {} while (0)
#define PE(k) do {} while (0)
#endif
    for (int layer = 0; layer < 4; ++layer) {
        const int j = layer >> 1; const bool even = (layer & 1) == 0;
        int z = 0; asm volatile("" : "+s"(z));
        unsigned char* ws = a.ws + z; float* out = a.out + z;
        LAS unsigned char* ldsl = (LAS unsigned char*)lds;
        float* sm = (float*)lds;

        PB(0);
        if (ON(0)) {
            TIDS; const int gw = bx * 8 + wave, NGW = G * 8;
            LAS float* scr = (LAS float*)(ldsl + wave * 16384);
            const float* wi = even ? a.in[1 + z] + (size_t)j * 1024 * 3328 : a.in[19 + z] + (size_t)j * 1024 * 2048;
            const int Nin = even ? 3328 : 2048;
            const float* wo = even ? a.in[18 + z] + (size_t)j * 1024 * 1024 : a.in[25 + z] + (size_t)j * 1024 * 1024;
            const float* wu = a.in[28 + z] + (size_t)layer * 1024 * 5632;
            const float* wd = a.in[31 + z] + (size_t)layer * 2816 * 1024;
            const int I_in = 16 * (Nin / 32), I_out = 16 * 32, I_up = 16 * 176, I_dn = 44 * 32, NIT = I_in + I_out + I_up + I_dn;
            for (int it = gw; it < NIT; it += NGW) {
                int r = it;
                if (r < I_in) { transpose_item(wi, 1024, Nin, ((bf16*)(ws + WS_WIN)), scr, r, lane); continue; } r -= I_in;
                if (r < I_out) { transpose_item(wo, 1024, 1024, ((bf16*)(ws + WS_WOUT)), scr, r, lane); continue; } r -= I_out;
                if (r < I_up) { transpose_item<true>(wu, 1024, 5632, ((bf16*)(ws + WS_WUP)), scr, r, lane); continue; } r -= I_up;
                transpose_item(wd, 2816, 1024, ((bf16*)(ws + WS_WDN)), scr, r, lane);
            }
            if (!even) { const float* wsrc = a.in[23 + z] + (size_t)j * 8 * 128 * 128;
                for (int i = bx * NTHR + tid; i < 8 * 128 * 128; i += G * NTHR) { const int t = (i >> 7) & 127, s = i & 127; ((bf16*)(ws + WS_WSP))[i] = (bf16)f2bf(s <= t ? wsrc[i] : 0.f); } }
            if (bx == 0 && tid < 8) __hip_atomic_store(barw + 4096 + 64 * tid, 0u, __ATOMIC_RELAXED, __HIP_MEMORY_SCOPE_AGENT);
            if (layer == 0) { const f32x4* xs = (const f32x4*)a.in[0 + z]; f32x4* xo = (f32x4*)out; v2u* xn = (v2u*)((bf16*)(ws + WS_XN));
                for (int i = bx * NTHR + tid; i < NTOK * 1024 / 4; i += G * NTHR) { const f32x4 v = xs[i]; xo[i] = v; v2u w; w.x = pk2(v[0], v[1]); w.y = pk2(v[2], v[3]); xn[i] = w; } }
        }
        xcd_barrier(xbar);
        PE(0);
        if (even) {
            PB(1);
            if (ON(1)) {   pg8::Gemm g{((bf16*)(ws + WS_XN)), ((bf16*)(ws + WS_WIN)), NTOK, 3328, 1024}; pg8::StaticOrder S; S.init(NTOK, 3328, G, bx);
                pg8::EpiBf16<0> E{((bf16*)(ws + WS_P)), 3328, nullptr, 0, 0, 1.f};
                pg8::gemm_phase<pg8::EpiBf16<0>, pg8::StaticOrder, PG8_ALIGN, PG8_SP2>(ldsl, g, S, E); }
            xcd_barrier(xbar);
            PE(1);
            PB(2);
            if (ON(2)) { RwkvW rw{a.in[2 + z] + j * 1792, a.in[3 + z] + j * 512, a.in[4 + z] + (size_t)j * 64 * 512, a.in[5 + z] + j * 512, a.in[6 + z] + (size_t)j * 64 * 512, a.in[7 + z] + (size_t)j * 128 * 512,
                     a.in[8 + z] + j * 512, a.in[9 + z] + j * 512, a.in[10 + z] + j * 512, a.in[11 + z] + j * 512, a.in[12 + z] + j * 512}; rwkv_phase1(sm, ((bf16*)(ws + WS_P)), rw, ((float*)(ws + WS_GH)), bx, G); }
            PB(3);
            if (ON(3)) phase_rope(((bf16*)(ws + WS_P)), bx, G);
            xcd_barrier(xbar);
            PE(2);
            PE(3);
            PB(5);
            PB(4);
            if (ON(4)) if (bx < 64) rwkv_phase2(sm, ((float*)(ws + WS_GH)), bx);
            PE(4);
            if (ON(5)) {
                __syncthreads();
                volatile LAS unsigned* qslot = (volatile LAS unsigned*)((LAS unsigned char*)lds + (LDS_TOTAL - 64));
                const unsigned myq = xb_xcc_id() & 7u;
                for (unsigned kq = 0; kq < 8u; ++kq) {
                    const unsigned q = (myq + kq) & 7u;
                    for (;;) {
                        if (threadIdx.x == 0) qslot[0] = __hip_atomic_fetch_add(barw + 4096 + 64 * q, 1u, __ATOMIC_RELAXED, __HIP_MEMORY_SCOPE_AGENT);
                        __syncthreads();
                        const unsigned i = qslot[0];
                        __syncthreads();
                        if (i >= 256u) break;
                        const int qb = 63 - (int)(i >> 2), bhv = (int)(4u * q + (i & 3u));
                        const int b = bhv >> 4, vh = bhv & 15, hd = vh >> 2, cm = (vh >> 1) & 1, vhalf = vh & 1;
                        const bf16* Pp = (const bf16*)(ws + WS_P);
                        const attn_body::bf16* Q = (const attn_body::bf16*)(Pp + 1792 + (hd * 2 + cm) * 64); const attn_body::bf16* K = (const attn_body::bf16*)(Pp + 2304 + (hd * 2 + cm) * 64);
                        const attn_body::bf16* Vv = (const attn_body::bf16*)(Pp + 2816 + hd * 128 + vhalf * 64); attn_body::bf16* O = (attn_body::bf16*)(((bf16*)(ws + WS_XN)) + vh * 64);
                        attn_body::attn_unit<8>(b, 0, qb, Q, K, Vv, O, (char*)lds);
                    }
                }
            }
            xcd_barrier(xbar);
            PE(5);
            PB(6);
            if (ON(6)) { RwkvW rw{a.in[2 + z] + j * 1792, a.in[3 + z] + j * 512, a.in[4 + z] + (size_t)j * 64 * 512, a.in[5 + z] + j * 512, a.in[6 + z] + (size_t)j * 64 * 512, a.in[7 + z] + (size_t)j * 128 * 512,
                     a.in[8 + z] + j * 512, a.in[9 + z] + j * 512, a.in[10 + z] + j * 512, a.in[11 + z] + j * 512, a.in[12 + z] + j * 512}; rwkv_phase3(sm, ((bf16*)(ws + WS_P)), rw, ((float*)(ws + WS_GH)), ((bf16*)(ws + WS_CAT)), bx, G); }
            PB(7);
            if (ON(7)) phase_attn_post(((bf16*)(ws + WS_XN)), ((bf16*)(ws + WS_CAT)), a.in[13 + z] + j * 64, a.in[14 + z] + j * 64, a.in[15 + z] + j * 64, a.in[16 + z] + j * 64, a.in[17 + z] + j * 128, layer == 0 ? 0.2f : 0.4707130183435842f, bx, G);
            xcd_barrier(xbar);
            PE(6);
            PE(7);
            PB(8);
            if (ON(8)) {   pg8::Gemm g{((bf16*)(ws + WS_CAT)), ((bf16*)(ws + WS_WOUT)), NTOK, 1024, 1024}; pg8::StaticOrder S; S.init(NTOK, 1024, G, bx);
                pg8::EpiResid E{out, 1024, ALPHA};
                pg8::gemm_phase<pg8::EpiResid, pg8::StaticOrder, PG8_ALIGN, PG8_SP2>(ldsl, g, S, E); }
        } else {
            PB(9);
            if (ON(9)) {   pg8::Gemm g{((bf16*)(ws + WS_XN)), ((bf16*)(ws + WS_WIN)), NTOK, 2048, 1024}; pg8::StaticOrder S; S.init(NTOK, 2048, G, bx);
                pg8::EpiBf16<1> E{((bf16*)(ws + WS_U)), 1024, a.in[20 + z] + j * 2048, 1024, (size_t)(WS_V - WS_U) / 2, 1.f};
                pg8::gemm_phase<pg8::EpiBf16<1>, pg8::StaticOrder, PG8_ALIGN, PG8_SP2>(ldsl, g, S, E); }
            xcd_barrier(xbar);
            PE(9);
            PB(10);
            if (ON(10)) phase_lnv(((bf16*)(ws + WS_V)), a.in[21 + z] + j * 1024, a.in[22 + z] + j * 1024, bx, G);
            xcd_barrier(xbar);
            PE(10);
            PB(11);
            if (ON(11)) phase_mix(lds, ((bf16*)(ws + WS_U)), ((bf16*)(ws + WS_V)), ((bf16*)(ws + WS_WSP)), a.in[24 + z] + j * 1024, bx, G);
            xcd_barrier(xbar);
            PE(11);
            PB(12);
            if (ON(12)) {   pg8::Gemm g{((bf16*)(ws + WS_U)), ((bf16*)(ws + WS_WOUT)), NTOK, 1024, 1024}; pg8::StaticOrder S; S.init(NTOK, 1024, G, bx);
                pg8::EpiResid E{out, 1024, ALPHA};
                pg8::gemm_phase<pg8::EpiResid, pg8::StaticOrder, PG8_ALIGN, PG8_SP2>(ldsl, g, S, E); }
        }
        xcd_barrier(xbar);
        if (even) PE(8); else PE(12);
        PB(13);
        if (ON(13)) phase_ln(out, ((bf16*)(ws + WS_XN)), a.in[26 + z] + layer * 1024, a.in[27 + z] + layer * 1024, bx, G);
        xcd_barrier(xbar);
        PE(13);
        PB(14);
        if (ON(14)) {   pg8::Gemm g{((bf16*)(ws + WS_XN)), ((bf16*)(ws + WS_WUP)), NTOK, 5632, 1024}; pg8::StaticOrder S; S.init(NTOK, 5632, G, bx);
            pg8::EpiConv E{((bf16*)(ws + WS_VAL)), ((bf16*)(ws + WS_GATE)), a.in[29 + z] + (size_t)layer * 3 * DFF, a.in[30 + z] + layer * DFF, DFF};
            pg8::gemm_phase<pg8::EpiConv, pg8::StaticOrder, PG8_ALIGN, PG8_SP2>(ldsl, g, S, E); }
        xcd_barrier(xbar);
        PE(14);
        PB(15);
        if (ON(15)) phase_conv(((bf16*)(ws + WS_GATE)), ((bf16*)(ws + WS_VAL)), a.in[29 + z] + (size_t)layer * 3 * DFF, a.in[30 + z] + layer * DFF, bx, G);
        xcd_barrier(xbar);
        PE(15);
        PB(16);
        if (ON(16)) {   pg8::Gemm g{((bf16*)(ws + WS_VAL)), ((bf16*)(ws + WS_WDN)), NTOK, 1024, 2816}; pg8::StaticOrder S; S.init(NTOK, 1024, G, bx);
            pg8::EpiResid E{out, 1024, ALPHA};
            pg8::gemm_phase<pg8::EpiResid, pg8::StaticOrder, PG8_ALIGN, PG8_SP2>(ldsl, g, S, E); }
        xcd_barrier(xbar);
        PE(16);
        PB(17);
#ifdef EXTRA_SYNCS
        for (int es = 0; es < EXTRA_SYNCS; ++es) xcd_barrier(xbar);
#endif
        if (ON(17)) phase_ln(out, ((bf16*)(ws + WS_XN)), a.in[32 + z] + layer * 1024, a.in[33 + z] + layer * 1024, bx, G);
        xcd_barrier(xbar);
        PE(17);
    }
#if defined(SEC_B)
    if (bx == 0 && threadIdx.x == 0) { const unsigned long long tacc2 = ((volatile unsigned long long*)((char*)lds + (LDS_TOTAL - 48)))[0]; const unsigned long long t0 = __builtin_amdgcn_s_memrealtime(); while (__builtin_amdgcn_s_memrealtime() - t0 < 4ull * tacc2) __builtin_amdgcn_s_sleep(8); }
#endif
#ifdef PROBE_MASK
    if (bx == 0 && threadIdx.x == 0) { const unsigned long long t0 = __builtin_amdgcn_s_memrealtime(); while (__builtin_amdgcn_s_memrealtime() - t0 < 4ull * tacc) __builtin_amdgcn_s_sleep(8); }
#endif
}

extern "C" void kernel_launch(void* const* d_in, const int* in_sizes, int n_in, void* d_out, int out_size, void* d_ws, size_t ws_size, hipStream_t stream) {
    static int grid = 0;
    if (grid == 0) {
        if (n_in != 34 || out_size != NTOK * 1024 || ws_size < WS_END) { fprintf(stderr, "kernel_launch: unexpected shapes (n_in %d out %d ws %zu)\n", n_in, out_size, ws_size); grid = -1; return; }
        int dev = 0, cus = 0, per_cu = 0;
        hipGetDevice(&dev); hipDeviceGetAttribute(&cus, hipDeviceAttributeMultiprocessorCount, dev);
        if (hipFuncSetAttribute((const void*)mega_fwd, hipFuncAttributeMaxDynamicSharedMemorySize, LDS_TOTAL) != hipSuccess) { fprintf(stderr, "kernel_launch: hipFuncSetAttribute failed\n"); grid = -1; return; }
        if (hipOccupancyMaxActiveBlocksPerMultiprocessor(&per_cu, (const void*)mega_fwd, NTHR, LDS_TOTAL) != hipSuccess || per_cu < 1) per_cu = 1;
        (void)hipGetLastError();
        grid = cus * per_cu;
        fprintf(stderr, "kernel_launch: grid %d (cus %d x %d)\n", grid, cus, per_cu);
    }
    if (grid < 0) return;
    Args a{};
    for (int i = 0; i < 34; ++i) a.in[i] = (const float*)d_in[i];
    a.out = (float*)d_out; a.ws = (unsigned char*)d_ws;
    void* args[] = {&a};
    hipError_t e = hipLaunchCooperativeKernel((const void*)mega_fwd, dim3(grid), dim3(NTHR), args, LDS_TOTAL, stream);
    if (e != hipSuccess) fprintf(stderr, "kernel_launch: cooperative launch failed: %s (grid %d)\n", hipGetErrorString(e), grid);
}
```
